# Optimizing an MI355X kernel written in HIP

```python
import jax, jax.numpy as jnp
from jax import lax
import numpy as np

D_MODEL = 1024
BATCH = 8
SEQ = 2048
DEPTH = 2

PLE_DIM = 256
D_FF = ((8 * D_MODEL // 3 + 255) // 256) * 256
D_MIX = D_MODEL
W_A = D_MIX // 2
GM_GROUPS = 4
GM_DH = W_A // GM_GROUPS
CHUNK = 128
W_B = D_MIX - W_A
SC_HEADS = 8
SC_WIDTH = 3
W_C = D_MIX // 2
POOL_WINDOWS = (2, 4, 8, 16)
POOL_GW = W_C // len(POOL_WINDOWS)
W_D = D_MIX - W_C
CV_HEADS = 8
CV_WIDTH = 31
N_EVEN = (DEPTH + 1) // 2
N_ODD = DEPTH // 2
IN_EVEN = 2 * W_A + 3 * W_B
IN_ODD = W_C + 2 * W_D
RMS_EPS = 1e-6
LN_EPS = 1e-5

kernel_name = "hybrid_gmlp_shortconv_pool_conformer_macaron"


def rmsnorm(x, g):
    xf = x.astype(jnp.float32)
    y = xf * lax.rsqrt(jnp.mean(xf * xf, axis=-1, keepdims=True) + RMS_EPS)
    return (y * g.astype(jnp.float32)).astype(x.dtype)


def layernorm(x, g, b):
    xf = x.astype(jnp.float32)
    mu = jnp.mean(xf, axis=-1, keepdims=True)
    xc = xf - mu
    var = jnp.mean(xc * xc, axis=-1, keepdims=True)
    y = xc * lax.rsqrt(var + LN_EPS) * g.astype(jnp.float32) + b.astype(jnp.float32)
    return y.astype(x.dtype)


def swiglu(x, w_gu, w_down):
    g, u = jnp.split(x @ w_gu, 2, axis=-1)
    return (jax.nn.silu(g) * u) @ w_down


def causal_dwconv(x, w):
    k, c = w.shape
    return lax.conv_general_dilated(
        x, w[:, None, :].astype(x.dtype), window_strides=(1,), padding=[(k - 1, 0)],
        dimension_numbers=("NWC", "WIO", "NWC"), feature_group_count=c)


def gmlp_spatial_gating(uv, ln_g, ln_b, w_s, b_s):
    u, v = jnp.split(jax.nn.gelu(uv), 2, axis=-1)
    bsz, s, _ = v.shape
    vg = layernorm(v.reshape(bsz, s, GM_GROUPS, GM_DH),
                   ln_g.reshape(GM_GROUPS, GM_DH), ln_b.reshape(GM_GROUPS, GM_DH))
    vc = vg.reshape(bsz, s // CHUNK, CHUNK, GM_GROUPS, GM_DH)
    w = jnp.tril(w_s)
    mixed = jnp.einsum("gts,bcsgd->bctgd", w, vc) + b_s.T[:, :, None]
    return u * mixed.reshape(bsz, s, W_A)


def short_conv_mixer(bg, cg, xv, w):
    return bg * causal_dwconv(cg * xv, w)


def multiscale_pool(x):
    s = x.shape[1]
    xf = x.astype(jnp.float32)
    cs = jnp.cumsum(xf, axis=1)
    cnt_base = jnp.arange(1, s + 1, dtype=jnp.float32)[None, :, None]
    outs = []
    for gi, win in enumerate(POOL_WINDOWS):
        sl = slice(gi * POOL_GW, (gi + 1) * POOL_GW)
        c = cs[:, :, sl]
        prev = jnp.pad(c[:, : s - win], ((0, 0), (win, 0), (0, 0)))
        count = jnp.minimum(cnt_base, float(win))
        outs.append((c - prev) / count - xf[:, :, sl])
    return jnp.concatenate(outs, axis=-1).astype(x.dtype)


def pool_mixer(zc, pool_w, pool_scale):
    bsz, s, _ = zc.shape
    pooled = multiscale_pool(zc).reshape(bsz, s, len(POOL_WINDOWS), POOL_GW)
    y = jnp.einsum("bsgc,gcd->bsgd", pooled, pool_w).reshape(bsz, s, W_C)
    return y * pool_scale


def conformer_conv(zd, cv_w, cv_b, ln_g, ln_b):
    a, g = jnp.split(zd, 2, axis=-1)
    h = causal_dwconv(a * jax.nn.sigmoid(g), cv_w) + cv_b
    return jax.nn.silu(layernorm(h, ln_g, ln_b))


def setup_inputs(seed: int = 0) -> dict:
    key = jax.random.key(seed)
    ks = iter(jax.random.split(key, 40))
    f32 = jnp.float32

    def nrm(shape, scale):
        return jax.random.normal(next(ks), shape, f32) * scale

    def gain(shape):
        return 1.0 + nrm(shape, 0.02)

    return {
        "x": nrm((BATCH, SEQ, D_MODEL), 1.0),
        "p": nrm((DEPTH, BATCH, SEQ, PLE_DIM), 1.0),
        "ffn1_norm": gain((DEPTH, D_MODEL)),
        "ffn1_w_gu": nrm((DEPTH, D_MODEL, 2 * D_FF), D_MODEL ** -0.5),
        "ffn1_w_down": nrm((DEPTH, D_FF, D_MODEL), D_FF ** -0.5),
        "mix_norm": gain((DEPTH, D_MODEL)),
        "ffn2_norm": gain((DEPTH, D_MODEL)),
        "ffn2_w_gu": nrm((DEPTH, D_MODEL, 2 * D_FF), D_MODEL ** -0.5),
        "ffn2_w_down": nrm((DEPTH, D_FF, D_MODEL), D_FF ** -0.5),
        "ple_norm": gain((DEPTH, D_MODEL)),
        "ple_w_gate": nrm((DEPTH, D_MODEL, D_MODEL), D_MODEL ** -0.5),
        "ple_w_up": nrm((DEPTH, PLE_DIM, D_MODEL), PLE_DIM ** -0.5),
        "ab_w_in": nrm((N_EVEN, D_MODEL, IN_EVEN), D_MODEL ** -0.5),
        "gm_ln_g": gain((N_EVEN, W_A)),
        "gm_ln_b": nrm((N_EVEN, W_A), 0.02),
        "gm_w_s": nrm((N_EVEN, GM_GROUPS, CHUNK, CHUNK), CHUNK ** -0.5),
        "gm_b_s": gain((N_EVEN, GM_GROUPS, CHUNK)),
        "sc_w": nrm((N_EVEN, SC_WIDTH, W_B), SC_WIDTH ** -0.5),
        "ab_w_out": nrm((N_EVEN, W_A + W_B, D_MODEL), (W_A + W_B) ** -0.5),
        "cd_w_in": nrm((N_ODD, D_MODEL, IN_ODD), D_MODEL ** -0.5),
        "pool_w": nrm((N_ODD, len(POOL_WINDOWS), POOL_GW, POOL_GW), POOL_GW ** -0.5),
        "pool_scale": gain((N_ODD, W_C)),
        "cv_w": nrm((N_ODD, CV_WIDTH, W_D), CV_WIDTH ** -0.5),
        "cv_b": nrm((N_ODD, W_D), 0.02),
        "cv_ln_g": gain((N_ODD, W_D)),
        "cv_ln_b": nrm((N_ODD, W_D), 0.02),
        "cd_w_out": nrm((N_ODD, W_C + W_D, D_MODEL), (W_C + W_D) ** -0.5),
        "final_norm": gain((D_MODEL,)),
    }


def reference(x, p, ffn1_norm, ffn1_w_gu, ffn1_w_down, mix_norm, ffn2_norm, ffn2_w_gu,
              ffn2_w_down, ple_norm, ple_w_gate, ple_w_up, ab_w_in, gm_ln_g, gm_ln_b,
              gm_w_s, gm_b_s, sc_w, ab_w_out, cd_w_in, pool_w, pool_scale, cv_w, cv_b,
              cv_ln_g, cv_ln_b, cd_w_out, final_norm):
    h = x
    for i in range(DEPTH):
        h = h + 0.5 * swiglu(rmsnorm(h, ffn1_norm[i]), ffn1_w_gu[i], ffn1_w_down[i])
        hn = rmsnorm(h, mix_norm[i])
        j = i // 2
        if i % 2 == 0:
            z = hn @ ab_w_in[j]
            uv = z[..., : 2 * W_A]
            bg, cg, xv = jnp.split(z[..., 2 * W_A:], 3, axis=-1)
            ya = gmlp_spatial_gating(uv, gm_ln_g[j], gm_ln_b[j], gm_w_s[j], gm_b_s[j])
            yb = short_conv_mixer(bg, cg, xv, sc_w[j])
            y = jnp.concatenate([ya, yb], axis=-1) @ ab_w_out[j]
        else:
            z = hn @ cd_w_in[j]
            yc = pool_mixer(z[..., :W_C], pool_w[j], pool_scale[j])
            yd = conformer_conv(z[..., W_C:], cv_w[j], cv_b[j], cv_ln_g[j], cv_ln_b[j])
            y = jnp.concatenate([yc, yd], axis=-1) @ cd_w_out[j]
        h = h + y
        h = h + 0.5 * swiglu(rmsnorm(h, ffn2_norm[i]), ffn2_w_gu[i], ffn2_w_down[i])
        gate = jax.nn.sigmoid(rmsnorm(h, ple_norm[i]) @ ple_w_gate[i])
        h = h + gate * (p[i] @ ple_w_up[i])
    return rmsnorm(h, final_norm)
```

```cpp
#include <hip/hip_runtime.h>
#include <cstdio>
#include <cstdint>

namespace v0 {
constexpr int D = 1024, SEQ = 2048, BATCH = 8, PLE = 256, FF = 2816;
constexpr int WA = 512, WB = 512, WC = 512, WD = 512, CHUNK = 128;
constexpr int IN_EVEN = 2560, IN_ODD = 1536;
constexpr float RMS_EPS = 1e-6f, LN_EPS = 1e-5f;

__device__ __forceinline__ float wave_sum(float v) {
#pragma unroll
    for (int o = 1; o < 64; o <<= 1) v += __shfl_xor(v, o);
    return v;
}
__device__ __forceinline__ float sigmoidf_(float x) { return 1.0f / (1.0f + expf(-x)); }
__device__ __forceinline__ float siluf_(float x) { return x * sigmoidf_(x); }
__device__ __forceinline__ float gelu_tanh(float x) {
    const float c = 0.7978845608028654f;
    return 0.5f * x * (1.0f + tanhf(c * (x + 0.044715f * x * x * x)));
}

__global__ __launch_bounds__(256) void k_rmsnorm(const float* x, const float* gain, float* y, int rows) {
    const int row = blockIdx.x * 4 + (threadIdx.x >> 6), lane = threadIdx.x & 63;
    if (row >= rows) return;
    const float4* xr = (const float4*)(x + (size_t)row * D);
    float4 v[4]; float s = 0.f;
#pragma unroll
    for (int j = 0; j < 4; ++j) { v[j] = xr[lane + 64 * j]; s += v[j].x * v[j].x + v[j].y * v[j].y + v[j].z * v[j].z + v[j].w * v[j].w; }
    s = wave_sum(s);
    const float r = 1.0f / sqrtf(s * (1.0f / D) + RMS_EPS);
    float4* yr = (float4*)(y + (size_t)row * D);
    const float4* g4 = (const float4*)gain;
#pragma unroll
    for (int j = 0; j < 4; ++j) { const float4 g = g4[lane + 64 * j]; float4 o; o.x = v[j].x * r * g.x; o.y = v[j].y * r * g.y; o.z = v[j].z * r * g.z; o.w = v[j].w * r * g.w; yr[lane + 64 * j] = o; }
}

struct GemmP { const float* A; const float* B; float* C; int M, N, K, lda, ldb, ldc; long sA1, sB1, sC1, sA2, sB2, sC2; int nb2; int tril; };
__global__ __launch_bounds__(256) void k_gemm(GemmP p) {
    __shared__ float As[16][68];
    __shared__ float Bs[16][68];
    const int z1 = blockIdx.z / p.nb2, z2 = blockIdx.z % p.nb2;
    const float* A = p.A + z1 * p.sA1 + z2 * p.sA2;
    const float* B = p.B + z1 * p.sB1 + z2 * p.sB2;
    float* C = p.C + z1 * p.sC1 + z2 * p.sC2;
    const int t = threadIdx.x, tx = t & 15, ty = t >> 4;
    const int m0 = blockIdx.y * 64, n0 = blockIdx.x * 64;
    float acc[4][4];
#pragma unroll
    for (int i = 0; i < 4; ++i)
#pragma unroll
        for (int j = 0; j < 4; ++j) acc[i][j] = 0.f;
    const int ar = t >> 2, ak = (t & 3) * 4;
    const int bk = t >> 4, bn = (t & 15) * 4;
    for (int k0 = 0; k0 < p.K; k0 += 16) {
        float4 av = *(const float4*)(A + (size_t)(m0 + ar) * p.lda + k0 + ak);
        if (p.tril) {
            const int tt = m0 + ar, ss = k0 + ak;
            if (ss + 0 > tt) av.x = 0.f; if (ss + 1 > tt) av.y = 0.f; if (ss + 2 > tt) av.z = 0.f; if (ss + 3 > tt) av.w = 0.f;
        }
        const float4 bv = *(const float4*)(B + (size_t)(k0 + bk) * p.ldb + n0 + bn);
        As[ak + 0][ar] = av.x; As[ak + 1][ar] = av.y; As[ak + 2][ar] = av.z; As[ak + 3][ar] = av.w;
        *(float4*)&Bs[bk][bn] = bv;
        __syncthreads();
#pragma unroll
        for (int k = 0; k < 16; ++k) {
            const float4 a = *(const float4*)&As[k][ty * 4];
            const float4 b = *(const float4*)&Bs[k][tx * 4];
            const float aa[4] = {a.x, a.y, a.z, a.w}, bb[4] = {b.x, b.y, b.z, b.w};
#pragma unroll
            for (int i = 0; i < 4; ++i)
#pragma unroll
                for (int j = 0; j < 4; ++j) acc[i][j] = fmaf(aa[i], bb[j], acc[i][j]);
        }
        __syncthreads();
    }
#pragma unroll
    for (int i = 0; i < 4; ++i) {
        float4 o; o.x = acc[i][0]; o.y = acc[i][1]; o.z = acc[i][2]; o.w = acc[i][3];
        *(float4*)(C + (size_t)(m0 + ty * 4 + i) * p.ldc + n0 + tx * 4) = o;
    }
}

__global__ void k_swiglu(const float* z, float* t, int rows) {
    const size_t i = (size_t)blockIdx.x * blockDim.x + threadIdx.x;
    if (i >= (size_t)rows * FF) return;
    const size_t r = i / FF, j = i % FF;
    t[i] = siluf_(z[r * (2 * FF) + j]) * z[r * (2 * FF) + FF + j];
}
__global__ void k_add_scaled(float* h, const float* y, float sc, size_t n) {
    const size_t i = (size_t)blockIdx.x * blockDim.x + threadIdx.x;
    if (i < n) h[i] += sc * y[i];
}
__global__ __launch_bounds__(256) void k_gelu_ln(const float* z, const float* ln_g, const float* ln_b, float* u, float* vg, int rows) {
    const int wid = blockIdx.x * 4 + (threadIdx.x >> 6), lane = threadIdx.x & 63;
    const int row = wid >> 2, g = wid & 3;
    if (row >= rows) return;
    const float* zr = z + (size_t)row * IN_EVEN;
    const int c0 = g * 128 + lane * 2;
    u[(size_t)row * WA + c0] = gelu_tanh(zr[c0]); u[(size_t)row * WA + c0 + 1] = gelu_tanh(zr[c0 + 1]);
    const float v0 = gelu_tanh(zr[WA + c0]), v1 = gelu_tanh(zr[WA + c0 + 1]);
    const float mu = wave_sum(v0 + v1) * (1.0f / 128.0f);
    const float d0 = v0 - mu, d1 = v1 - mu;
    const float var = wave_sum(d0 * d0 + d1 * d1) * (1.0f / 128.0f);
    const float r = 1.0f / sqrtf(var + LN_EPS);
    vg[(size_t)row * WA + c0] = d0 * r * ln_g[c0] + ln_b[c0];
    vg[(size_t)row * WA + c0 + 1] = d1 * r * ln_g[c0 + 1] + ln_b[c0 + 1];
}
__global__ void k_gate(const float* u, const float* mixed, const float* b_s, float* ycat, int rows) {
    const size_t i = (size_t)blockIdx.x * blockDim.x + threadIdx.x;
    if (i >= (size_t)rows * WA) return;
    const int r = (int)(i / WA), c = (int)(i % WA), g = c >> 7;
    ycat[(size_t)r * D + c] = u[i] * (mixed[i] + b_s[g * CHUNK + (r % CHUNK)]);
}
__global__ void k_shortconv(const float* z, const float* w, float* ycat, int rows) {
    const size_t i = (size_t)blockIdx.x * blockDim.x + threadIdx.x;
    if (i >= (size_t)rows * WB) return;
    const int r = (int)(i / WB), c = (int)(i % WB);
    float acc = 0.f;
#pragma unroll
    for (int k = 0; k < 3; ++k) {
        const int tt = r - 2 + k;
        if (tt >= 0) { const float* zr = z + (size_t)tt * IN_EVEN + 2 * WA; acc += w[k * WB + c] * (zr[WB + c] * zr[2 * WB + c]); }
    }
    ycat[(size_t)r * D + WA + c] = z[(size_t)r * IN_EVEN + 2 * WA + c] * acc;
}
__global__ void k_pool(const float* z, float* pooled, int rows) {
    const size_t i = (size_t)blockIdx.x * blockDim.x + threadIdx.x;
    if (i >= (size_t)rows * WC) return;
    const int r = (int)(i / WC), c = (int)(i % WC), win = 2 << (c >> 7);
    const int cnt = (r + 1 < win) ? (r + 1) : win;
    float s = 0.f;
    for (int k = 0; k < cnt; ++k) s += z[(size_t)(r - k) * IN_ODD + c];
    pooled[i] = s / (float)cnt - z[(size_t)r * IN_ODD + c];
}
__global__ void k_colscale_to(const float* src, const float* sc, float* ycat, int rows) {
    const size_t i = (size_t)blockIdx.x * blockDim.x + threadIdx.x;
    if (i >= (size_t)rows * WC) return;
    const int r = (int)(i / WC), c = (int)(i % WC);
    ycat[(size_t)r * D + c] = src[i] * sc[c];
}
__global__ void k_glu(const float* z, float* s, int rows) {
    const size_t i = (size_t)blockIdx.x * blockDim.x + threadIdx.x;
    if (i >= (size_t)rows * WD) return;
    const int r = (int)(i / WD), c = (int)(i % WD);
    s[i] = z[(size_t)r * IN_ODD + WC + c] * sigmoidf_(z[(size_t)r * IN_ODD + WC + WD + c]);
}
__global__ __launch_bounds__(512) void k_conv_ln_silu(const float* s, const float* cw, const float* cb, const float* ln_g, const float* ln_b, float* ycat, int rows) {
    __shared__ float red[8];
    __shared__ float red2[8];
    const int r = blockIdx.x, c = threadIdx.x;
    float acc = cb[c];
    for (int k = 0; k < 31; ++k) { const int tt = r - 30 + k; if (tt >= 0) acc += cw[k * WD + c] * s[(size_t)tt * WD + c]; }
    float ws = wave_sum(acc);
    if ((c & 63) == 0) red[c >> 6] = ws;
    __syncthreads();
    float mu = 0.f;
#pragma unroll
    for (int i = 0; i < 8; ++i) mu += red[i];
    mu *= (1.0f / 512.0f);
    const float d = acc - mu;
    float wq = wave_sum(d * d);
    if ((c & 63) == 0) red2[c >> 6] = wq;
    __syncthreads();
    float var = 0.f;
#pragma unroll
    for (int i = 0; i < 8; ++i) var += red2[i];
    var *= (1.0f / 512.0f);
    const float y = d * (1.0f / sqrtf(var + LN_EPS)) * ln_g[c] + ln_b[c];
    ycat[(size_t)r * D + WC + c] = siluf_(y);
}
__global__ void k_ple(float* h, const float* gz, const float* pu, size_t n) {
    const size_t i = (size_t)blockIdx.x * blockDim.x + threadIdx.x;
    if (i < n) h[i] += sigmoidf_(gz[i]) * pu[i];
}

struct In {
    const float *x, *p, *ffn1_norm, *ffn1_w_gu, *ffn1_w_down, *mix_norm, *ffn2_norm, *ffn2_w_gu, *ffn2_w_down, *ple_norm, *ple_w_gate, *ple_w_up,
        *ab_w_in, *gm_ln_g, *gm_ln_b, *gm_w_s, *gm_b_s, *sc_w, *ab_w_out, *cd_w_in, *pool_w, *pool_scale, *cv_w, *cv_b, *cv_ln_g, *cv_ln_b, *cd_w_out, *final_norm;
};

static void gemm(hipStream_t st, const float* A, const float* B, float* C, int M, int N, int K, int lda, int ldb, int ldc,
                 int nb1 = 1, long sA1 = 0, long sB1 = 0, long sC1 = 0, int nb2 = 1, long sA2 = 0, long sB2 = 0, long sC2 = 0, int tril = 0) {
    GemmP p{A, B, C, M, N, K, lda, ldb, ldc, sA1, sB1, sC1, sA2, sB2, sC2, nb2, tril};
    hipLaunchKernelGGL(k_gemm, dim3(N / 64, M / 64, nb1 * nb2), dim3(256), 0, st, p);
}
static inline unsigned nblk(size_t n, int b) { return (unsigned)((n + b - 1) / b); }

static void forward_slab(hipStream_t st, const In& in, const float* p_slab0, const float* p_slab1, float* h, float* out, float* tmp, int S) {
    float* xn = tmp;
    float* z = xn + (size_t)S * D;
    float* t = z + (size_t)S * 2 * FF;
    float* y = t + (size_t)S * FF;
    float* ycat = y + (size_t)S * D;
    float* gz = ycat + (size_t)S * D;
    float* b0 = gz + (size_t)S * D;
    float* b1 = b0 + (size_t)S * 512; float* b2 = b1 + (size_t)S * 512; float* b3 = b2 + (size_t)S * 512;
    const size_t nh = (size_t)S * D;
    for (int i = 0; i < 2; ++i) {
        hipLaunchKernelGGL(k_rmsnorm, dim3(S / 4), dim3(256), 0, st, h, in.ffn1_norm + i * D, xn, S);
        gemm(st, xn, in.ffn1_w_gu + (size_t)i * D * 2 * FF, z, S, 2 * FF, D, D, 2 * FF, 2 * FF);
        hipLaunchKernelGGL(k_swiglu, dim3(nblk((size_t)S * FF, 256)), dim3(256), 0, st, z, t, S);
        gemm(st, t, in.ffn1_w_down + (size_t)i * FF * D, y, S, D, FF, FF, D, D);
        hipLaunchKernelGGL(k_add_scaled, dim3(nblk(nh, 256)), dim3(256), 0, st, h, y, 0.5f, nh);
        hipLaunchKernelGGL(k_rmsnorm, dim3(S / 4), dim3(256), 0, st, h, in.mix_norm + i * D, xn, S);
        if (i == 0) {
            gemm(st, xn, in.ab_w_in, z, S, IN_EVEN, D, D, IN_EVEN, IN_EVEN);
            float *u = b0, *vg = b1, *mixed = b2;
            hipLaunchKernelGGL(k_gelu_ln, dim3(S), dim3(256), 0, st, z, in.gm_ln_g, in.gm_ln_b, u, vg, S);
            gemm(st, in.gm_w_s, vg, mixed, CHUNK, 128, CHUNK, CHUNK, WA, WA, S / CHUNK, 0, (long)CHUNK * WA, (long)CHUNK * WA, 4, (long)CHUNK * CHUNK, 128, 128, 1);
            hipLaunchKernelGGL(k_gate, dim3(nblk((size_t)S * WA, 256)), dim3(256), 0, st, u, mixed, in.gm_b_s, ycat, S);
            hipLaunchKernelGGL(k_shortconv, dim3(nblk((size_t)S * WB, 256)), dim3(256), 0, st, z, in.sc_w, ycat, S);
            gemm(st, ycat, in.ab_w_out, y, S, D, D, D, D, D);
        } else {
            gemm(st, xn, in.cd_w_in, z, S, IN_ODD, D, D, IN_ODD, IN_ODD);
            float *pooled = b0, *ycr = b1, *sg = b2;
            hipLaunchKernelGGL(k_pool, dim3(nblk((size_t)S * WC, 256)), dim3(256), 0, st, z, pooled, S);
            gemm(st, pooled, in.pool_w, ycr, S, 128, 128, WC, 128, WC, 4, 128, 128L * 128, 128);
            hipLaunchKernelGGL(k_colscale_to, dim3(nblk((size_t)S * WC, 256)), dim3(256), 0, st, ycr, in.pool_scale, ycat, S);
            hipLaunchKernelGGL(k_glu, dim3(nblk((size_t)S * WD, 256)), dim3(256), 0, st, z, sg, S);
            hipLaunchKernelGGL(k_conv_ln_silu, dim3(S), dim3(512), 0, st, sg, in.cv_w, in.cv_b, in.cv_ln_g, in.cv_ln_b, ycat, S);
            gemm(st, ycat, in.cd_w_out, y, S, D, D, D, D, D);
        }
        hipLaunchKernelGGL(k_add_scaled, dim3(nblk(nh, 256)), dim3(256), 0, st, h, y, 1.0f, nh);
        hipLaunchKernelGGL(k_rmsnorm, dim3(S / 4), dim3(256), 0, st, h, in.ffn2_norm + i * D, xn, S);
        gemm(st, xn, in.ffn2_w_gu + (size_t)i * D * 2 * FF, z, S, 2 * FF, D, D, 2 * FF, 2 * FF);
        hipLaunchKernelGGL(k_swiglu, dim3(nblk((size_t)S * FF, 256)), dim3(256), 0, st, z, t, S);
        gemm(st, t, in.ffn2_w_down + (size_t)i * FF * D, y, S, D, FF, FF, D, D);
        hipLaunchKernelGGL(k_add_scaled, dim3(nblk(nh, 256)), dim3(256), 0, st, h, y, 0.5f, nh);
        hipLaunchKernelGGL(k_rmsnorm, dim3(S / 4), dim3(256), 0, st, h, in.ple_norm + i * D, xn, S);
        gemm(st, xn, in.ple_w_gate + (size_t)i * D * D, gz, S, D, D, D, D, D);
        gemm(st, i == 0 ? p_slab0 : p_slab1, in.ple_w_up + (size_t)i * PLE * D, y, S, D, PLE, PLE, D, D);
        hipLaunchKernelGGL(k_ple, dim3(nblk(nh, 256)), dim3(256), 0, st, h, gz, y, nh);
    }
    hipLaunchKernelGGL(k_rmsnorm, dim3(S / 4), dim3(256), 0, st, h, in.final_norm, out, S);
}
}

extern "C" void kernel_launch(void* const* d_in, const int* in_sizes, int n_in, void* d_out, int out_size, void* d_ws, size_t ws_size, hipStream_t stream) {
    using namespace v0;
    if (n_in != 28 || out_size != BATCH * SEQ * D) { fprintf(stderr, "kernel_launch: unexpected shapes (n_in %d out %d)\n", n_in, out_size); return; }
    In in;
    const float** f = (const float**)&in;
    for (int i = 0; i < 28; ++i) f[i] = (const float*)d_in[i];
    float* out = (float*)d_out;
    float* tmp = (float*)d_ws;
    const size_t need = (size_t)SEQ * (2 * FF + FF + 4 * D + 4 * 512) * sizeof(float);
    if (ws_size < need) { fprintf(stderr, "kernel_launch: workspace too small (%zu < %zu)\n", ws_size, need); return; }
    hipMemcpyAsync(out, in.x, (size_t)BATCH * SEQ * D * sizeof(float), hipMemcpyDeviceToDevice, stream);
    for (int b = 0; b < BATCH; ++b) {
        float* h = out + (size_t)b * SEQ * D;
        const float* p0 = in.p + ((size_t)0 * BATCH + b) * SEQ * PLE;
        const float* p1 = in.p + ((size_t)1 * BATCH + b) * SEQ * PLE;
        forward_slab(stream, in, p0, p1, h, h, tmp, SEQ);
    }
}
```

```cpp
#include <hip/hip_runtime.h>
#include <hip/hip_cooperative_groups.h>
#include <cstdio>
#include <cstdint>
namespace cg = cooperative_groups;

#ifndef DBG
#define DBG 0
#endif
#ifndef GP_SP2
#define GP_SP2 false
#endif
#ifndef GP_ALIGN
#define GP_ALIGN false
#endif
#ifndef DBG_THR
#define DBG_THR 0.03f
#endif

namespace pg8 {
#define PG8_LAS __attribute__((address_space(3)))
typedef unsigned short bf16_t;
typedef short bf16x8 __attribute__((ext_vector_type(8)));
typedef float f32x4 __attribute__((ext_vector_type(4)));
typedef unsigned u32x4 __attribute__((ext_vector_type(4)));
typedef unsigned u32x2 __attribute__((ext_vector_type(2)));
constexpr int BM = 256, BK = 64, HALF = 128, HTB = HALF * BK * 2  , STAGE_BYTES = 8 * HTB, NXCD = 8, WGM = 8;

__host__ __device__ __forceinline__ int lds_byte(int r, int c) { const int st = (r >> 4) * 2 + (c >> 5), rr = r & 15, cc = c & 31, ob = rr * 64 + cc * 2; return st * 1024 + (ob ^ (((ob >> 9) & 1) << 5)); }
__host__ __device__ __forceinline__ void stage_rc(int b, int& R, int& C) { const int st = b / 1024, sb = b % 1024, swz = sb ^ (((sb >> 9) & 1) << 5); R = (st >> 1) * 16 + swz / 64; C = (st & 1) * 32 + (swz % 64) / 2; }
__host__ __device__ __forceinline__ int perm32(int rho) { const int n = rho >> 4, i = rho & 15; return 8 * (i >> 2) + 4 * n + (i & 3); }

struct Unit { int pm, pn; };
struct Gemm { const bf16_t* A; const bf16_t* Bt; int M, N, K; };

struct StaticOrder {
    int nM, nN, nwg, G, c;
    __host__ __device__ void init(int M, int N, int G_, int c_) { nM = M / BM; nN = N / BM; nwg = nM * nN; G = G_; c = c_; }
    __host__ __device__ bool next(int i, Unit& u) const {
        const long L = (long)i * G + c; if (L >= nwg) return false;
        int wgid = (int)L; { const int q = nwg / NXCD, r = nwg % NXCD, xcd = wgid % NXCD, off = wgid / NXCD; wgid = (xcd < r ? xcd * (q + 1) : r * (q + 1) + (xcd - r) * q) + off; }
        const int nig = WGM * nN, gid = wgid / nig, fm = gid * WGM, gsz = (nM - fm) < WGM ? (nM - fm) : WGM;
        u.pm = fm + ((wgid % nig) % gsz); u.pn = (wgid % nig) / gsz; return true;
    }
    __device__ __forceinline__ void a_ready(const Unit&) const {}
    __device__ __forceinline__ void done(const Unit&) const {}
};

__device__ __forceinline__ unsigned cvt_pk_bf16(float lo, float hi) { unsigned r; asm volatile("v_cvt_pk_bf16_f32 %0, %1, %2" : "=v"(r) : "v"(lo), "v"(hi)); return r; }
__device__ __forceinline__ float bf_lo(unsigned w) { return __uint_as_float(w << 16); }
__device__ __forceinline__ float bf_hi(unsigned w) { return __uint_as_float(w & 0xffff0000u); }
__device__ __forceinline__ float fsigmoid(float x) { return __builtin_amdgcn_rcpf(1.0f + __builtin_amdgcn_exp2f(-1.4426950408889634f * x)); }
__device__ __forceinline__ float fsilu(float x) { return x * fsigmoid(x); }
__device__ __forceinline__ float fgelu_tanh(float x) { return x * fsigmoid(1.5957691216057308f * (x + 0.044715f * x * x * x)); }
__device__ __forceinline__ float rstd_of(float ss) { return __builtin_amdgcn_rsqf(ss * (1.0f / 1024.0f) + 1e-6f); }
__device__ __forceinline__ u32x4 pack8(const f32x4& a, const f32x4& b) { u32x4 w; w.x = cvt_pk_bf16(a[0], a[1]); w.y = cvt_pk_bf16(a[2], a[3]); w.z = cvt_pk_bf16(b[0], b[1]); w.w = cvt_pk_bf16(b[2], b[3]); return w; }

constexpr int DM = 1024, DFF = 2816;

struct EpiSwiglu {
    static constexpr bool PERM = true, AFTER_DRAIN = false;
    bf16_t* T; const float* rowss;
    __device__ __forceinline__ void operator()(const f32x4 (&acc)[2][2][4][2], const Unit& u, int wr, int wc, int fr, int fq) const {
        const int row0 = u.pm * BM + wr * 64 + fr, col0 = u.pn * 128 + wc * 32 + 8 * fq;
        float rs[2][4];
#pragma unroll
        for (int ai = 0; ai < 2; ++ai)
#pragma unroll
            for (int m = 0; m < 4; ++m) rs[ai][m] = rstd_of(rowss[row0 + ai * HALF + m * 16]);
#pragma unroll
        for (int ai = 0; ai < 2; ++ai)
#pragma unroll
            for (int m = 0; m < 4; ++m) {
                const int r = row0 + ai * HALF + m * 16; const float s = rs[ai][m];
                f32x4 t0, t1;
#pragma unroll
                for (int j = 0; j < 4; ++j) { t0[j] = fsilu(acc[ai][0][m][0][j] * s) * (acc[ai][1][m][0][j] * s); t1[j] = fsilu(acc[ai][0][m][1][j] * s) * (acc[ai][1][m][1][j] * s); }
                *(u32x4*)(T + (size_t)r * DFF + col0) = pack8(t0, t1);
            }
    }
};
struct EpiRes {
    static constexpr bool PERM = true, AFTER_DRAIN = false;
    const float* base; float* out; bf16_t* hb; float* rowss_out; float scale;
    __device__ __forceinline__ void operator()(const f32x4 (&acc)[2][2][4][2], const Unit& u, int wr, int wc, int fr, int fq) const {
        const int row0 = u.pm * BM + wr * 64 + fr, col0 = u.pn * BM + wc * 32 + 8 * fq;
#pragma unroll
        for (int ai = 0; ai < 2; ++ai)
#pragma unroll
            for (int m = 0; m < 4; ++m) {
                const int r = row0 + ai * HALF + m * 16; const size_t off = (size_t)r * DM + col0;
                const f32x4 b00 = *(const f32x4*)(base + off), b01 = *(const f32x4*)(base + off + 4), b10 = *(const f32x4*)(base + off + HALF), b11 = *(const f32x4*)(base + off + HALF + 4);
                const f32x4 o00 = b00 + acc[ai][0][m][0] * scale, o01 = b01 + acc[ai][0][m][1] * scale, o10 = b10 + acc[ai][1][m][0] * scale, o11 = b11 + acc[ai][1][m][1] * scale;
                *(f32x4*)(out + off) = o00; *(f32x4*)(out + off + 4) = o01; *(f32x4*)(out + off + HALF) = o10; *(f32x4*)(out + off + HALF + 4) = o11;
                *(u32x4*)(hb + off) = pack8(o00, o01); *(u32x4*)(hb + off + HALF) = pack8(o10, o11);
                float ss = 0.f;
#pragma unroll
                for (int j = 0; j < 4; ++j) ss += o00[j] * o00[j] + o01[j] * o01[j] + o10[j] * o10[j] + o11[j] * o11[j];
                ss += __shfl_xor(ss, 16); ss += __shfl_xor(ss, 32);
                if (fq == 0) atomicAdd(rowss_out + r, ss);
                asm volatile("" ::: "memory");
            }
    }
};
struct EpiPle {
    static constexpr bool PERM = true, AFTER_DRAIN = false;
    const float* rowss_in; const bf16_t* PU; float* h; bf16_t* hb; float* rowss_out;
    __device__ __forceinline__ void operator()(const f32x4 (&acc)[2][2][4][2], const Unit& u, int wr, int wc, int fr, int fq) const {
        const int row0 = u.pm * BM + wr * 64 + fr, col0 = u.pn * BM + wc * 32 + 8 * fq;
#pragma unroll
        for (int ai = 0; ai < 2; ++ai)
#pragma unroll
            for (int m = 0; m < 4; ++m) {
                const int r = row0 + ai * HALF + m * 16; const size_t off = (size_t)r * DM + col0;
                const float s = rstd_of(rowss_in[r]);
                const u32x4 p0 = *(const u32x4*)(PU + off), p1 = *(const u32x4*)(PU + off + HALF);
                const f32x4 b00 = *(const f32x4*)(h + off), b01 = *(const f32x4*)(h + off + 4), b10 = *(const f32x4*)(h + off + HALF), b11 = *(const f32x4*)(h + off + HALF + 4);
                const f32x4 q00 = {bf_lo(p0.x), bf_hi(p0.x), bf_lo(p0.y), bf_hi(p0.y)}, q01 = {bf_lo(p0.z), bf_hi(p0.z), bf_lo(p0.w), bf_hi(p0.w)};
                const f32x4 q10 = {bf_lo(p1.x), bf_hi(p1.x), bf_lo(p1.y), bf_hi(p1.y)}, q11 = {bf_lo(p1.z), bf_hi(p1.z), bf_lo(p1.w), bf_hi(p1.w)};
                f32x4 o00, o01, o10, o11;
#pragma unroll
                for (int j = 0; j < 4; ++j) {
                    o00[j] = b00[j] + fsigmoid(acc[ai][0][m][0][j] * s) * q00[j]; o01[j] = b01[j] + fsigmoid(acc[ai][0][m][1][j] * s) * q01[j];
                    o10[j] = b10[j] + fsigmoid(acc[ai][1][m][0][j] * s) * q10[j]; o11[j] = b11[j] + fsigmoid(acc[ai][1][m][1][j] * s) * q11[j]; }
                *(f32x4*)(h + off) = o00; *(f32x4*)(h + off + 4) = o01; *(f32x4*)(h + off + HALF) = o10; *(f32x4*)(h + off + HALF + 4) = o11;
                if (hb) {
                    *(u32x4*)(hb + off) = pack8(o00, o01); *(u32x4*)(hb + off + HALF) = pack8(o10, o11);
                    float ss = 0.f;
#pragma unroll
                    for (int j = 0; j < 4; ++j) ss += o00[j] * o00[j] + o01[j] * o01[j] + o10[j] * o10[j] + o11[j] * o11[j];
                    ss += __shfl_xor(ss, 16); ss += __shfl_xor(ss, 32);
                    if (fq == 0) atomicAdd(rowss_out + r, ss);
                }
                asm volatile("" ::: "memory");
            }
    }
};
struct EpiPlain {
    static constexpr bool PERM = true, AFTER_DRAIN = false;
    bf16_t* O;
    __device__ __forceinline__ void operator()(const f32x4 (&acc)[2][2][4][2], const Unit& u, int wr, int wc, int fr, int fq) const {
        const int row0 = u.pm * BM + wr * 64 + fr, col0 = u.pn * BM + wc * 32 + 8 * fq;
#pragma unroll
        for (int ai = 0; ai < 2; ++ai)
#pragma unroll
            for (int m = 0; m < 4; ++m) {
                const size_t off = (size_t)(row0 + ai * HALF + m * 16) * DM + col0;
                *(u32x4*)(O + off) = pack8(acc[ai][0][m][0], acc[ai][0][m][1]); *(u32x4*)(O + off + HALF) = pack8(acc[ai][1][m][0], acc[ai][1][m][1]);
            }
    }
};
struct EpiMix0 {
    static constexpr bool PERM = true, AFTER_DRAIN = false;
    const float* rowss; bf16_t *UV, *Q, *BG;
    __device__ __forceinline__ void operator()(const f32x4 (&acc)[2][2][4][2], const Unit& u, int wr, int wc, int fr, int fq) const {
        const int row0 = u.pm * BM + wr * 64 + fr, cw = wc * 32 + 8 * fq;
#pragma unroll
        for (int ai = 0; ai < 2; ++ai)
#pragma unroll
            for (int m = 0; m < 4; ++m) {
                const int r = row0 + ai * HALF + m * 16; const float s = rstd_of(rowss[r]);
                if (u.pn < 4) {
                    f32x4 a0, a1, b0, b1;
#pragma unroll
                    for (int j = 0; j < 4; ++j) { a0[j] = fgelu_tanh(acc[ai][0][m][0][j] * s); a1[j] = fgelu_tanh(acc[ai][0][m][1][j] * s); b0[j] = fgelu_tanh(acc[ai][1][m][0][j] * s); b1[j] = fgelu_tanh(acc[ai][1][m][1][j] * s); }
                    bf16_t* p = UV + (size_t)r * 1024 + u.pn * 256 + cw; *(u32x4*)p = pack8(a0, a1); *(u32x4*)(p + HALF) = pack8(b0, b1);
                } else if (u.pn < 8) {
                    const float s2 = s * s; f32x4 q0 = acc[ai][0][m][0] * acc[ai][1][m][0] * s2, q1 = acc[ai][0][m][1] * acc[ai][1][m][1] * s2;
                    *(u32x4*)(Q + (size_t)r * 512 + (u.pn - 4) * 128 + cw) = pack8(q0, q1);
                } else {
                    bf16_t* p = BG + (size_t)r * 512 + (u.pn - 8) * 256 + cw;
                    *(u32x4*)p = pack8(acc[ai][0][m][0] * s, acc[ai][0][m][1] * s); *(u32x4*)(p + HALF) = pack8(acc[ai][1][m][0] * s, acc[ai][1][m][1] * s);
                }
            }
    }
};
struct EpiMix1 {
    static constexpr bool PERM = true, AFTER_DRAIN = false;
    const float* rowss; bf16_t *ZC, *S;
    __device__ __forceinline__ void operator()(const f32x4 (&acc)[2][2][4][2], const Unit& u, int wr, int wc, int fr, int fq) const {
        const int row0 = u.pm * BM + wr * 64 + fr, cw = wc * 32 + 8 * fq;
#pragma unroll
        for (int ai = 0; ai < 2; ++ai)
#pragma unroll
            for (int m = 0; m < 4; ++m) {
                const int r = row0 + ai * HALF + m * 16; const float s = rstd_of(rowss[r]);
                if (u.pn < 2) {
                    bf16_t* p = ZC + (size_t)r * 512 + u.pn * 256 + cw;
                    *(u32x4*)p = pack8(acc[ai][0][m][0] * s, acc[ai][0][m][1] * s); *(u32x4*)(p + HALF) = pack8(acc[ai][1][m][0] * s, acc[ai][1][m][1] * s);
                } else {
                    f32x4 q0, q1;
#pragma unroll
                    for (int j = 0; j < 4; ++j) { q0[j] = acc[ai][0][m][0][j] * s * fsigmoid(acc[ai][1][m][0][j] * s); q1[j] = acc[ai][0][m][1][j] * s * fsigmoid(acc[ai][1][m][1][j] * s); }
                    *(u32x4*)(S + (size_t)r * 512 + (u.pn - 2) * 128 + cw) = pack8(q0, q1);
                }
            }
    }
};

template <class Epi, class Sched, bool ALIGN_EPI = false, bool SP2 = false>
__device__ __forceinline__ void gemm_phase(PG8_LAS unsigned char* lds, const Gemm g, const Sched& S, const Epi& E) {
    int tid_ = threadIdx.x; asm volatile("" : "+v"(tid_));
    const int tid = tid_, wid = __builtin_amdgcn_readfirstlane(tid >> 6), lane = tid & 63, wr = wid >> 2, wc = wid & 3, fr = lane & 15, fq = lane >> 4;
    const int K = g.K, nt = K / BK;
    unsigned voffA[2], voffB[2];
#pragma unroll
    for (int i = 0; i < 2; ++i) { int R, C; stage_rc(tid * 16 + i * 8192, R, C); const int Rb = Epi::PERM ? ((R & ~31) + perm32(R & 31)) : R;
        voffA[i] = (unsigned)(R * K + C) * 2u; voffB[i] = (unsigned)(Rb * K + C) * 2u; }
    const size_t kstep = (size_t)(BK * 2);
    const size_t hstep = (size_t)HALF * K * 2;
    const size_t tstep = 2 * hstep;
    const unsigned ldsw = (unsigned)wid * 1024u;
    const int aoff = lds_byte(wr * 64 + fr, fq * 8), boff = lds_byte(wc * 32 + fr, fq * 8);
#define PG8_SA(b, h) (((b) * 2 + (h)) * HTB)
#define PG8_SB(b, h) ((4 + (b) * 2 + (h)) * HTB)
#define PG8_STAGE(bufoff, gbase, voff) do { _Pragma("unroll") for (int _i = 0; _i < 2; ++_i) \
        __builtin_amdgcn_global_load_lds((const unsigned*)((const char*)(gbase) + (voff)[_i]), (PG8_LAS unsigned*)(lds + (bufoff) + ldsw + _i * 8192), 16, 0, 0); } while (0)
#define PG8_LDA(dst, b, h) do { _Pragma("unroll") for (int m = 0; m < 4; ++m) _Pragma("unroll") for (int k = 0; k < 2; ++k) dst[m][k] = *(const PG8_LAS bf16x8*)(lds + PG8_SA(b, h) + aoff + m * 2048 + k * 1024); } while (0)
#define PG8_LDB(dst, b, h) do { _Pragma("unroll") for (int n = 0; n < 2; ++n) _Pragma("unroll") for (int k = 0; k < 2; ++k) dst[n][k] = *(const PG8_LAS bf16x8*)(lds + PG8_SB(b, h) + boff + n * 2048 + k * 1024); } while (0)
#define PG8_MMA(ai, bj, At, Bt) do { __builtin_amdgcn_s_setprio(1); _Pragma("unroll") for (int m = 0; m < 4; ++m) _Pragma("unroll") for (int n = 0; n < 2; ++n) _Pragma("unroll") for (int k = 0; k < 2; ++k) \
        acc[ai][bj][m][n] = __builtin_amdgcn_mfma_f32_16x16x32_bf16(Bt[n][k], At[m][k], acc[ai][bj][m][n], 0, 0, 0); __builtin_amdgcn_s_setprio(0); } while (0)
#define PG8_WAIT_V(n) asm volatile("s_waitcnt vmcnt(" #n ")" ::: "memory")
#define PG8_WAIT_L(n) asm volatile("s_waitcnt lgkmcnt(" #n ")" ::: "memory")
#define PG8_BAR __builtin_amdgcn_s_barrier()
#define PG8_SCHED __builtin_amdgcn_sched_barrier(0)
    Unit cur, nxt; int ui = 0;
    if (!S.next(0, cur)) return;
    f32x4 acc[2][2][4][2];
#pragma unroll
    for (int a = 0; a < 2; ++a)
#pragma unroll
        for (int b = 0; b < 2; ++b)
#pragma unroll
            for (int m = 0; m < 4; ++m)
#pragma unroll
                for (int n = 0; n < 2; ++n) acc[a][b][m][n] = (f32x4){0.f, 0.f, 0.f, 0.f};
    bf16x8 At[4][2], B0[2][2], B1[2][2];
    const char* cA = (const char*)g.A + (size_t)cur.pm * tstep; const char* cB = (const char*)g.Bt + (size_t)cur.pn * tstep;
    S.a_ready(cur);
    if constexpr (SP2) {
        PG8_STAGE(PG8_SB(0, 0), cB, voffB); PG8_STAGE(PG8_SB(0, 1), cB + hstep, voffB); PG8_STAGE(PG8_SA(0, 0), cA, voffA); PG8_STAGE(PG8_SA(0, 1), cA + hstep, voffA);
        if (wr == 1) PG8_BAR;
        PG8_WAIT_V(2); PG8_BAR;
        PG8_STAGE(PG8_SB(1, 0), cB + kstep, voffB); PG8_STAGE(PG8_SA(1, 0), cA + kstep, voffA); PG8_STAGE(PG8_SB(1, 1), cB + hstep + kstep, voffB);
        PG8_WAIT_V(6); PG8_BAR;
    } else {
        PG8_STAGE(PG8_SB(0, 0), cB, voffB); PG8_STAGE(PG8_SA(0, 0), cA, voffA); PG8_STAGE(PG8_SB(0, 1), cB + hstep, voffB); PG8_STAGE(PG8_SA(0, 1), cA + hstep, voffA);
        if (wr == 1) PG8_BAR;
        PG8_WAIT_V(4); PG8_BAR;
        PG8_STAGE(PG8_SB(1, 0), cB + kstep, voffB); PG8_STAGE(PG8_SA(1, 0), cA + kstep, voffA); PG8_STAGE(PG8_SB(1, 1), cB + hstep + kstep, voffB);
        PG8_WAIT_V(6); PG8_BAR;
    }
    for (;;) {
        const bool has_next = S.next(ui + 1, nxt);
        const char* nA = has_next ? (const char*)g.A + (size_t)nxt.pm * tstep : cA; const char* nB = has_next ? (const char*)g.Bt + (size_t)nxt.pn * tstep : cB;
        for (int t = 0; t < nt; t += 2) {
            const bool last = (t == nt - 2);
            const char* a1 = cA + (size_t)(t + 1) * kstep;
            const char* a2 = last ? nA : cA + (size_t)(t + 2) * kstep; const char* b2 = last ? nB : cB + (size_t)(t + 2) * kstep;
            const char* a3 = a2 + kstep; const char* b3 = b2 + kstep;
            if (last && has_next) S.a_ready(nxt);
            if constexpr (SP2) {
            PG8_LDB(B0, 0, 0); PG8_LDB(B1, 0, 1); PG8_SCHED; PG8_LDA(At, 0, 0); PG8_STAGE(PG8_SA(1, 1), a1 + hstep, voffA);
            PG8_WAIT_V(8); PG8_WAIT_L(0); PG8_BAR; PG8_MMA(0, 0, At, B0); PG8_MMA(0, 1, At, B1); PG8_BAR; PG8_SCHED;
            PG8_LDA(At, 0, 1); PG8_STAGE(PG8_SB(0, 0), b2, voffB); PG8_STAGE(PG8_SB(0, 1), b2 + hstep, voffB); PG8_STAGE(PG8_SA(0, 0), a2, voffA);
            PG8_WAIT_V(8); PG8_WAIT_L(0); PG8_BAR; PG8_MMA(1, 0, At, B0); PG8_MMA(1, 1, At, B1); PG8_BAR; PG8_SCHED;
            PG8_LDB(B0, 1, 0); PG8_LDB(B1, 1, 1); PG8_SCHED; PG8_LDA(At, 1, 0); PG8_STAGE(PG8_SA(0, 1), a2 + hstep, voffA);
            PG8_WAIT_V(8); PG8_WAIT_L(0); PG8_BAR; PG8_MMA(0, 0, At, B0); PG8_MMA(0, 1, At, B1); PG8_BAR; PG8_SCHED;
            PG8_LDA(At, 1, 1); PG8_STAGE(PG8_SB(1, 0), b3, voffB); PG8_STAGE(PG8_SB(1, 1), b3 + hstep, voffB); PG8_STAGE(PG8_SA(1, 0), a3, voffA);
            PG8_WAIT_V(8); PG8_WAIT_L(0); PG8_BAR; PG8_MMA(1, 0, At, B0); PG8_MMA(1, 1, At, B1); PG8_BAR; PG8_SCHED;
            } else {
            PG8_LDB(B0, 0, 0); PG8_SCHED; PG8_LDA(At, 0, 0); PG8_STAGE(PG8_SA(1, 1), a1 + hstep, voffA);
            PG8_WAIT_L(8); PG8_BAR; PG8_WAIT_L(0); PG8_MMA(0, 0, At, B0); PG8_BAR; PG8_SCHED;
            PG8_LDB(B1, 0, 1); PG8_STAGE(PG8_SB(0, 0), b2, voffB);
            PG8_BAR; PG8_WAIT_L(0); PG8_MMA(0, 1, At, B1); PG8_BAR;
            PG8_LDA(At, 0, 1); PG8_STAGE(PG8_SA(0, 0), a2, voffA);
            PG8_BAR; PG8_WAIT_L(0); PG8_MMA(1, 0, At, B0); PG8_BAR; PG8_SCHED;
            PG8_STAGE(PG8_SB(0, 1), b2 + hstep, voffB);
            PG8_WAIT_V(6); PG8_BAR; PG8_MMA(1, 1, At, B1); PG8_BAR;
            PG8_LDB(B0, 1, 0); PG8_SCHED; PG8_LDA(At, 1, 0); PG8_STAGE(PG8_SA(0, 1), a2 + hstep, voffA);
            PG8_WAIT_L(8); PG8_BAR; PG8_WAIT_L(0); PG8_MMA(0, 0, At, B0); PG8_BAR; PG8_SCHED;
            PG8_LDB(B1, 1, 1); PG8_STAGE(PG8_SB(1, 0), b3, voffB);
            PG8_BAR; PG8_WAIT_L(0); PG8_MMA(0, 1, At, B1); PG8_BAR;
            PG8_LDA(At, 1, 1); PG8_STAGE(PG8_SA(1, 0), a3, voffA);
            PG8_BAR; PG8_WAIT_L(0); PG8_MMA(1, 0, At, B0); PG8_BAR; PG8_SCHED;
            PG8_STAGE(PG8_SB(1, 1), b3 + hstep, voffB);
            PG8_WAIT_V(6); PG8_BAR; PG8_MMA(1, 1, At, B1); PG8_BAR;
            }
        }
        if constexpr (ALIGN_EPI) { if (wr == 0) PG8_BAR; }
        if constexpr (!Epi::AFTER_DRAIN) { E(acc, cur, wr, wc, fr, fq); S.done(cur); }
        if (!has_next) break;
#pragma unroll
        for (int a = 0; a < 2; ++a)
#pragma unroll
            for (int b = 0; b < 2; ++b)
#pragma unroll
                for (int m = 0; m < 4; ++m)
#pragma unroll
                    for (int n = 0; n < 2; ++n) acc[a][b][m][n] = (f32x4){0.f, 0.f, 0.f, 0.f};
        cur = nxt; cA = nA; cB = nB; ++ui;
        if constexpr (ALIGN_EPI) { if (wr == 1) PG8_BAR; }
    }
    PG8_WAIT_V(0);
    if constexpr (!ALIGN_EPI) { if (wr == 0) PG8_BAR; }
    PG8_BAR;
    if constexpr (Epi::AFTER_DRAIN) { E.fused(acc, cur, wr, wc, fr, fq, lds, wid, lane); S.done(cur); }
#undef PG8_SA
#undef PG8_SB
#undef PG8_STAGE
#undef PG8_LDA
#undef PG8_LDB
#undef PG8_MMA
#undef PG8_WAIT_V
#undef PG8_WAIT_L
#undef PG8_BAR
#undef PG8_SCHED
}
}

namespace mk {
using pg8::bf16_t; using pg8::bf16x8; using pg8::f32x4; using pg8::u32x4; using pg8::u32x2; using pg8::cvt_pk_bf16; using pg8::bf_lo; using pg8::bf_hi;
#define LAS __attribute__((address_space(3)))
#define LDS_WAIT() asm volatile("s_waitcnt lgkmcnt(0)" ::: "memory")
constexpr int M = 16384, D = 1024, FF = 2816, SEQ = 2048, PLE = 256;
constexpr int NWAVES = 8, NTHREADS = 512;
constexpr int LDS_BYTES = 147456;
constexpr size_t MiB = 1u << 20, HM = 512u * 1024u;
constexpr size_t WS_CTL = 0, CTL_BYTES = 2 * MiB;
constexpr size_t WS_DBG = 64 * 1024;
constexpr size_t WS_ROWSS = 1 * MiB;
constexpr size_t WS_W = 2 * MiB;
constexpr size_t W_GU1 = 0, W_D1 = 22 * HM, W_GU2 = 33 * HM, W_D2 = 55 * HM, W_GATE = 66 * HM, W_UP = 70 * HM, W_OUT = 71 * HM, W_IN = 75 * HM, WL_STRIDE = 85 * HM;
constexpr size_t WS_WTRIL = WS_W + 2 * WL_STRIDE;
constexpr size_t WS_HB = 88 * MiB;
constexpr size_t WS_T = 120 * MiB;
constexpr size_t WS_Y = 208 * MiB;
constexpr size_t WS_PB = 240 * MiB;
constexpr size_t WS_END = 256 * MiB;
constexpr size_t WS_SNAP = 256 * MiB;
constexpr int DBG_NT = 384;
static_assert(WS_WTRIL + 131072 <= WS_HB && WS_T + (size_t)M * FF * 2 <= WS_Y, "ws map");

struct Args { const float* in[28]; float* out; unsigned char* ws; int dbg; int pad; };
enum { I_X = 0, I_P, I_FFN1_NORM, I_FFN1_WGU, I_FFN1_WD, I_MIX_NORM, I_FFN2_NORM, I_FFN2_WGU, I_FFN2_WD, I_PLE_NORM, I_PLE_WG, I_PLE_WU, I_AB_WIN, I_GM_LNG, I_GM_LNB, I_GM_WS, I_GM_BS,
       I_SC_W, I_AB_WOUT, I_CD_WIN, I_POOL_W, I_POOL_SCALE, I_CV_W, I_CV_B, I_CV_LNG, I_CV_LNB, I_CD_WOUT, I_FINAL_NORM };

typedef const __attribute__((address_space(4))) unsigned char* kargp_t;
__device__ __forceinline__ kargp_t kargs() { kargp_t p = (kargp_t)__builtin_amdgcn_kernarg_segment_ptr(); asm volatile("" : "+s"(p)); return p; }
#define KIN(i) (*(const float* const __attribute__((address_space(4)))*)(kargs() + 8 * (i)))
#define KOUT (*(float* const __attribute__((address_space(4)))*)(kargs() + 8 * 28))
#define KWS (*(unsigned char* const __attribute__((address_space(4)))*)(kargs() + 8 * 29))
__device__ __forceinline__ int opaque_tid() { int t = threadIdx.x; asm volatile("" : "+v"(t)); return t; }
__device__ __forceinline__ float wave_sum(float v) {
#pragma unroll
    for (int o = 1; o < 64; o <<= 1) v += __shfl_xor(v, o);
    return v;
}
__device__ __forceinline__ void unpack8(const u32x4& w, float (&f)[8]) { f[0] = bf_lo(w.x); f[1] = bf_hi(w.x); f[2] = bf_lo(w.y); f[3] = bf_hi(w.y); f[4] = bf_lo(w.z); f[5] = bf_hi(w.z); f[6] = bf_lo(w.w); f[7] = bf_hi(w.w); }
__device__ __forceinline__ u32x4 pack8f(const float (&f)[8]) { u32x4 w; w.x = cvt_pk_bf16(f[0], f[1]); w.y = cvt_pk_bf16(f[2], f[3]); w.z = cvt_pk_bf16(f[4], f[5]); w.w = cvt_pk_bf16(f[6], f[7]); return w; }

__device__ __forceinline__ void tr_item(const float* W, int ldsrc, int srccol0, const float* gain, bf16_t* dstblk, int lddst, int k0, LAS float* scr, int lane) {
#pragma unroll 8
    for (int i = 0; i < 32; ++i) { const int kk = 2 * i + (lane >> 5); float v = W[(size_t)(k0 + kk) * ldsrc + srccol0 + (lane & 31)]; if (gain) v *= gain[k0 + kk]; scr[kk * 33 + (lane & 31)] = v; }
    LDS_WAIT(); asm volatile("" ::: "memory");
    const int c = lane & 7;
#pragma unroll
    for (int j = 0; j < 4; ++j) { const int n = (lane >> 3) + 8 * j; const LAS float* s = scr + (8 * c) * 33 + n;
        u32x4 o; o.x = cvt_pk_bf16(s[0 * 33], s[1 * 33]); o.y = cvt_pk_bf16(s[2 * 33], s[3 * 33]); o.z = cvt_pk_bf16(s[4 * 33], s[5 * 33]); o.w = cvt_pk_bf16(s[6 * 33], s[7 * 33]);
        *(u32x4*)(dstblk + (size_t)n * lddst + k0 + 8 * c) = o; }
    LDS_WAIT(); asm volatile("" ::: "memory");
}
__device__ __forceinline__ int map_col(int map, int R) {
    if (map == 0) return R;
    if (map == 1) { const int pn = R >> 8, w = R & 255; return w < 128 ? 128 * pn + w : 2816 + 128 * pn + (w - 128); }
    if (map == 2) { if (R < 1024) return R; if (R < 2048) { const int t = (R - 1024) >> 8, w = (R - 1024) & 255; return w < 128 ? 1536 + 128 * t + w : 2048 + 128 * t + (w - 128); } return 1024 + (R - 2048); }
    if (R < 512) return R; { const int t = (R - 512) >> 8, w = (R - 512) & 255; return w < 128 ? 512 + 128 * t + w : 1024 + 128 * t + (w - 128); }
}
__device__ __forceinline__ void prep_phase(LAS unsigned char* lds, int vcu, int G) {
    const int tid = opaque_tid(), lane = tid & 63, wave = __builtin_amdgcn_readfirstlane(tid >> 6);
    LAS float* scr = (LAS float*)(lds + wave * 16384);
    unsigned char* ws = KWS;
    const int gw = vcu * NWAVES + wave, NGW = G * NWAVES;
    constexpr int J_GU = 16 * 176, J_D = 44 * 32, J_GATE = 16 * 32, J_UP = 4 * 32, J_L = 2 * J_GU + 2 * J_D + J_GATE + J_UP;
    constexpr int J_OUT0 = 16 * 32, J_OUT1 = 8 * 32, J_IN0 = 16 * 80, J_IN1 = 16 * 48, NITEMS = 2 * J_L + J_OUT0 + J_OUT1 + J_IN0 + J_IN1;
    for (int it = gw; it < NITEMS; it += NGW) {
        int r = it; const float* src; const float* gain = nullptr; bf16_t* dst; int ldsrc, lddst, nblk, map = 0;
        if (r < 2 * J_L) {
            const int L = r / J_L; r -= L * J_L; unsigned char* wl = ws + WS_W + (size_t)L * WL_STRIDE;
            if (r < J_GU) { src = KIN(I_FFN1_WGU) + (size_t)L * D * 2 * FF; gain = KIN(I_FFN1_NORM) + L * D; dst = (bf16_t*)(wl + W_GU1); ldsrc = 2 * FF; lddst = D; nblk = 176; map = 1; }
            else if ((r -= J_GU) < J_D) { src = KIN(I_FFN1_WD) + (size_t)L * FF * D; dst = (bf16_t*)(wl + W_D1); ldsrc = D; lddst = FF; nblk = 32; }
            else if ((r -= J_D) < J_GU) { src = KIN(I_FFN2_WGU) + (size_t)L * D * 2 * FF; gain = KIN(I_FFN2_NORM) + L * D; dst = (bf16_t*)(wl + W_GU2); ldsrc = 2 * FF; lddst = D; nblk = 176; map = 1; }
            else if ((r -= J_GU) < J_D) { src = KIN(I_FFN2_WD) + (size_t)L * FF * D; dst = (bf16_t*)(wl + W_D2); ldsrc = D; lddst = FF; nblk = 32; }
            else if ((r -= J_D) < J_GATE) { src = KIN(I_PLE_WG) + (size_t)L * D * D; gain = KIN(I_PLE_NORM) + L * D; dst = (bf16_t*)(wl + W_GATE); ldsrc = D; lddst = D; nblk = 32; }
            else { r -= J_GATE; src = KIN(I_PLE_WU) + (size_t)L * PLE * D; dst = (bf16_t*)(wl + W_UP); ldsrc = D; lddst = PLE; nblk = 32; }
        } else {
            r -= 2 * J_L;
            if (r < J_OUT0) { src = KIN(I_AB_WOUT); dst = (bf16_t*)(ws + WS_W + W_OUT); ldsrc = D; lddst = D; nblk = 32; }
            else if ((r -= J_OUT0) < J_OUT1) { src = KIN(I_CD_WOUT) + (size_t)512 * D; dst = (bf16_t*)(ws + WS_W + WL_STRIDE + W_OUT) + 512; ldsrc = D; lddst = D; nblk = 32; }
            else if ((r -= J_OUT1) < J_IN0) { src = KIN(I_AB_WIN); gain = KIN(I_MIX_NORM); dst = (bf16_t*)(ws + WS_W + W_IN); ldsrc = 2560; lddst = D; nblk = 80; map = 2; }
            else { r -= J_IN0; src = KIN(I_CD_WIN); gain = KIN(I_MIX_NORM) + D; dst = (bf16_t*)(ws + WS_W + WL_STRIDE + W_IN); ldsrc = 1536; lddst = D; nblk = 48; map = 3; }
        }
        const int kb = r / nblk, nb = r - kb * nblk, R = 32 * nb;
        tr_item(src, ldsrc, map_col(map, R), gain, dst + (size_t)R * lddst, lddst, 64 * kb, scr, lane);
    }
    {
        const float* x = KIN(I_X); bf16_t* hb = (bf16_t*)(ws + WS_HB); float* rowss0 = (float*)(ws + WS_ROWSS);
        for (int row = gw; row < M; row += NGW) {
            const f32x4* xr = (const f32x4*)(x + (size_t)row * D) + lane; u32x2* o = (u32x2*)(hb + (size_t)row * D) + lane; float ss = 0.f;
#pragma unroll
            for (int j = 0; j < 4; ++j) { const f32x4 v = xr[64 * j]; ss += v[0] * v[0] + v[1] * v[1] + v[2] * v[2] + v[3] * v[3]; u32x2 w; w.x = cvt_pk_bf16(v[0], v[1]); w.y = cvt_pk_bf16(v[2], v[3]); o[64 * j] = w; }
            ss = wave_sum(ss);
            if (lane == 0) rowss0[row] = ss;
        }
    }
    const int gt = gw * 64 + lane, NGT = NGW * 64;
    {
        const float* p = KIN(I_P); bf16_t* pb = (bf16_t*)(ws + WS_PB);
        for (int t = gt; t < 2 * M * PLE / 8; t += NGT) { const f32x4 v0 = *(const f32x4*)(p + (size_t)t * 8), v1 = *(const f32x4*)(p + (size_t)t * 8 + 4); *(u32x4*)(pb + (size_t)t * 8) = pg8::pack8(v0, v1); }
    }
    {
        const float* w = KIN(I_GM_WS); bf16_t* wt = (bf16_t*)(ws + WS_WTRIL);
        for (int t = gt; t < 4 * 128 * 128 / 8; t += NGT) { const int e0 = t * 8, tt = (e0 >> 7) & 127, s0 = e0 & 127; float f[8];
#pragma unroll
            for (int j = 0; j < 8; ++j) f[j] = (s0 + j <= tt) ? w[e0 + j] : 0.f;
            *(u32x4*)(wt + e0) = pack8f(f); }
    }
    {
        const float* pw = KIN(I_POOL_W); const float* sc = KIN(I_POOL_SCALE); const float* wo = KIN(I_CD_WOUT); bf16_t* dst = (bf16_t*)(ws + WS_W + WL_STRIDE + W_OUT);
        for (int t = gt; t < 4 * 16 * 1024; t += NGT) { const int n = t & 1023, c8 = (t >> 10) & 15, g = t >> 14; float acc[8];
#pragma unroll
            for (int e = 0; e < 8; ++e) acc[e] = 0.f;
            const float* pwr = pw + ((size_t)g * 128 + c8 * 8) * 128;
            for (int d = 0; d < 128; ++d) { const float wv = wo[(size_t)(128 * g + d) * D + n] * sc[128 * g + d];
#pragma unroll
                for (int e = 0; e < 8; ++e) acc[e] = fmaf(pwr[e * 128 + d], wv, acc[e]); }
            *(u32x4*)(dst + (size_t)n * D + 128 * g + 8 * c8) = pack8f(acc); }
    }
}

__device__ __forceinline__ void mix0_phase(LAS unsigned char* lds, int vcu, int G) {
    const int tid = opaque_tid(), lane = tid & 63, wave = __builtin_amdgcn_readfirstlane(tid >> 6);
    unsigned char* ws = KWS;
    const bf16_t* UV = (const bf16_t*)(ws + WS_T); const bf16_t* Q = UV + (size_t)M * 1024; const bf16_t* BG = Q + (size_t)M * 512;
    bf16_t* Y = (bf16_t*)(ws + WS_Y); const bf16_t* Wtril = (const bf16_t*)(ws + WS_WTRIL);
    LAS bf16_t* vgT = (LAS bf16_t*)lds;
    const int fr = lane & 15, fq = lane >> 4;
    for (int item = vcu; item < 512; item += G) {
        const int c = item >> 2, g = item & 3;
        {
            const int tok = tid >> 2, qt = tid & 3;
            const u32x4* src = (const u32x4*)(UV + (size_t)(c * 128 + tok) * 1024 + 512 + g * 128 + qt * 32);
            float v[32];
#pragma unroll
            for (int j = 0; j < 4; ++j) { const u32x4 w = src[j]; float f[8]; unpack8(w, f);
#pragma unroll
                for (int e = 0; e < 8; ++e) v[8 * j + e] = f[e]; }
            float s = 0.f;
#pragma unroll
            for (int i = 0; i < 32; ++i) s += v[i];
            s += __shfl_xor(s, 1); s += __shfl_xor(s, 2);
            const float mean = s * (1.0f / 128.0f); float q = 0.f;
#pragma unroll
            for (int i = 0; i < 32; ++i) { v[i] -= mean; q += v[i] * v[i]; }
            q += __shfl_xor(q, 1); q += __shfl_xor(q, 2);
            const float rstd = __builtin_amdgcn_rsqf(q * (1.0f / 128.0f) + 1e-5f);
            const float* lg = KIN(I_GM_LNG) + g * 128 + qt * 32; const float* lb = KIN(I_GM_LNB) + g * 128 + qt * 32;
#pragma unroll
            for (int i = 0; i < 32; ++i) { const float val = v[i] * rstd * lg[i] + lb[i]; vgT[(qt * 32 + i) * 136 + tok] = (bf16_t)(cvt_pk_bf16(val, 0.f) & 0xffffu); }
        }
        __syncthreads();
        {
            f32x4 acc[8];
#pragma unroll
            for (int nt = 0; nt < 8; ++nt) acc[nt] = (f32x4){0.f, 0.f, 0.f, 0.f};
            const int nks = ((16 * wave + 15) >> 5) + 1;
            const bf16_t* wrow = Wtril + (size_t)g * 16384 + (16 * wave + fr) * 128 + 8 * fq;
            for (int ks = 0; ks < nks; ++ks) {
                const bf16x8 wf = *(const bf16x8*)(wrow + 32 * ks);
#pragma unroll
                for (int nt = 0; nt < 8; ++nt) { const bf16x8 vf = *(const LAS bf16x8*)(vgT + (16 * nt + fr) * 136 + 32 * ks + 8 * fq);
                    acc[nt] = __builtin_amdgcn_mfma_f32_16x16x32_bf16(vf, wf, acc[nt], 0, 0, 0); }
            }
            const int t = 16 * wave + fr; const size_t row = (size_t)c * 128 + t; const float bias = KIN(I_GM_BS)[g * 128 + t];
#pragma unroll
            for (int nt = 0; nt < 8; ++nt) { const int d = 16 * nt + 4 * fq; const u32x2 uu = *(const u32x2*)(UV + row * 1024 + g * 128 + d);
                u32x2 o; o.x = cvt_pk_bf16(bf_lo(uu.x) * (acc[nt][0] + bias), bf_hi(uu.x) * (acc[nt][1] + bias)); o.y = cvt_pk_bf16(bf_lo(uu.y) * (acc[nt][2] + bias), bf_hi(uu.y) * (acc[nt][3] + bias));
                *(u32x2*)(Y + row * 1024 + g * 128 + d) = o; }
        }
        __syncthreads();
    }
    for (int wi = vcu * NWAVES + wave; wi < M / 8; wi += G * NWAVES) {
        const int r0 = wi * 8, pos0 = r0 & (SEQ - 1);
        const float* sw = KIN(I_SC_W) + 8 * lane; float w0[8], w1[8], w2[8];
#pragma unroll
        for (int e = 0; e < 8; ++e) { w0[e] = sw[e]; w1[e] = sw[512 + e]; w2[e] = sw[1024 + e]; }
        float qm2[8], qm1[8];
#pragma unroll
        for (int e = 0; e < 8; ++e) { qm2[e] = 0.f; qm1[e] = 0.f; }
        if (pos0 != 0) { unpack8(*(const u32x4*)(Q + (size_t)(r0 - 2) * 512 + 8 * lane), qm2); unpack8(*(const u32x4*)(Q + (size_t)(r0 - 1) * 512 + 8 * lane), qm1); }
#pragma unroll
        for (int t = 0; t < 8; ++t) { float qv[8], bg[8], y[8]; unpack8(*(const u32x4*)(Q + (size_t)(r0 + t) * 512 + 8 * lane), qv); unpack8(*(const u32x4*)(BG + (size_t)(r0 + t) * 512 + 8 * lane), bg);
#pragma unroll
            for (int e = 0; e < 8; ++e) { y[e] = bg[e] * (w0[e] * qm2[e] + w1[e] * qm1[e] + w2[e] * qv[e]); qm2[e] = qm1[e]; qm1[e] = qv[e]; }
            *(u32x4*)(Y + (size_t)(r0 + t) * 1024 + 512 + 8 * lane) = pack8f(y); }
    }
}

__device__ __forceinline__ void mix1_phase(LAS unsigned char* lds, int vcu, int G) {
    const int tid = opaque_tid(), lane = tid & 63, wave = __builtin_amdgcn_readfirstlane(tid >> 6);
    unsigned char* ws = KWS;
    const bf16_t* ZC = (const bf16_t*)(ws + WS_T); const bf16_t* S = ZC + (size_t)M * 512; bf16_t* Y = (bf16_t*)(ws + WS_Y);
    for (int r = vcu * NWAVES + wave; r < M; r += G * NWAVES) {
        const int pos = r & (SEQ - 1), win = 2 << (lane >> 4), cnt = (pos + 1 < win) ? pos + 1 : win;
        float sum[8], x0[8];
        unpack8(*(const u32x4*)(ZC + (size_t)r * 512 + 8 * lane), x0);
#pragma unroll
        for (int e = 0; e < 8; ++e) sum[e] = x0[e];
        for (int k = 1; k < 16; ++k) { if (k < cnt) { float f[8]; unpack8(*(const u32x4*)(ZC + (size_t)(r - k) * 512 + 8 * lane), f);
#pragma unroll
                for (int e = 0; e < 8; ++e) sum[e] += f[e]; } }
        const float inv = 1.0f / (float)cnt; float y[8];
#pragma unroll
        for (int e = 0; e < 8; ++e) y[e] = sum[e] * inv - x0[e];
        *(u32x4*)(Y + (size_t)r * 1024 + 8 * lane) = pack8f(y);
    }
    LAS unsigned char* sl = lds;
    LAS float* hbuf = (LAS float*)(lds + 62 * 1024);
    const int cp = tid & 255, half = tid >> 8;
    float cw[31][2];
#pragma unroll
    for (int k = 0; k < 31; ++k) { cw[k][0] = KIN(I_CV_W)[k * 512 + 2 * cp]; cw[k][1] = KIN(I_CV_W)[k * 512 + 2 * cp + 1]; }
    const float cb0 = KIN(I_CV_B)[2 * cp], cb1 = KIN(I_CV_B)[2 * cp + 1];
    for (int item = vcu; item < M / 32; item += G) {
        const int t0 = item * 32, pos0 = t0 & (SEQ - 1);
#pragma unroll
        for (int ps = 0; ps < 8; ++ps) { const int row = ps * 8 + (tid >> 6);
            if (row < 62) { u32x4 v = (u32x4){0u, 0u, 0u, 0u}; if (pos0 - 30 + row >= 0) v = *(const u32x4*)(S + (size_t)(t0 - 30 + row) * 512 + 8 * (tid & 63));
                *(LAS u32x4*)(sl + row * 1024 + (tid & 63) * 16) = v; } }
        __syncthreads();
#pragma unroll
        for (int run = 0; run < 2; ++run) {
            const int tl = half * 16 + run * 8;
            float acc[8][2];
#pragma unroll
            for (int o = 0; o < 8; ++o) { acc[o][0] = cb0; acc[o][1] = cb1; }
#pragma unroll
            for (int i = 0; i < 38; ++i) { const unsigned w = *(const LAS unsigned*)(sl + (tl + i) * 1024 + cp * 4); const float x0 = bf_lo(w), x1 = bf_hi(w);
#pragma unroll
                for (int o = 0; o < 8; ++o) { const int k = i - o; if (k >= 0 && k < 31) { acc[o][0] = fmaf(cw[k][0], x0, acc[o][0]); acc[o][1] = fmaf(cw[k][1], x1, acc[o][1]); } } }
#pragma unroll
            for (int o = 0; o < 8; ++o) { typedef float f32x2v __attribute__((ext_vector_type(2))); *(LAS f32x2v*)(hbuf + (tl + o) * 512 + 2 * cp) = (f32x2v){acc[o][0], acc[o][1]}; }
        }
        __syncthreads();
#pragma unroll
        for (int tt = 0; tt < 4; ++tt) { const int tl = wave * 4 + tt; const LAS f32x4* hp = (const LAS f32x4*)(hbuf + tl * 512 + 8 * lane); const f32x4 h0 = hp[0], h1 = hp[1];
            float s = (h0[0] + h0[1]) + (h0[2] + h0[3]) + (h1[0] + h1[1]) + (h1[2] + h1[3]); s = wave_sum(s);
            const float mean = s * (1.0f / 512.0f); const f32x4 d0 = h0 - mean, d1 = h1 - mean;
            float q = (d0[0] * d0[0] + d0[1] * d0[1]) + (d0[2] * d0[2] + d0[3] * d0[3]) + (d1[0] * d1[0] + d1[1] * d1[1]) + (d1[2] * d1[2] + d1[3] * d1[3]); q = wave_sum(q);
            const float rstd = __builtin_amdgcn_rsqf(q * (1.0f / 512.0f) + 1e-5f);
            const f32x4 g0 = *(const f32x4*)(KIN(I_CV_LNG) + 8 * lane), g1 = *(const f32x4*)(KIN(I_CV_LNG) + 8 * lane + 4), b0 = *(const f32x4*)(KIN(I_CV_LNB) + 8 * lane), b1 = *(const f32x4*)(KIN(I_CV_LNB) + 8 * lane + 4);
            float y[8];
#pragma unroll
            for (int e = 0; e < 4; ++e) { y[e] = pg8::fsilu(d0[e] * rstd * g0[e] + b0[e]); y[4 + e] = pg8::fsilu(d1[e] * rstd * g1[e] + b1[e]); }
            *(u32x4*)(Y + (size_t)(t0 + tl) * 1024 + 512 + 8 * lane) = pack8f(y); }
        __syncthreads();
    }
}

__device__ __forceinline__ void final_phase(int vcu, int G) {
    const int tid = opaque_tid(), lane = tid & 63, wave = __builtin_amdgcn_readfirstlane(tid >> 6);
    const int gw = vcu * NWAVES + wave, NGW = G * NWAVES; const f32x4* g4 = (const f32x4*)KIN(I_FINAL_NORM) + lane;
    for (int row = gw; row < M; row += NGW) { f32x4* xr = (f32x4*)(KOUT + (size_t)row * D) + lane; f32x4 v[4]; float ss = 0.f;
#pragma unroll
        for (int j = 0; j < 4; ++j) { v[j] = xr[64 * j]; ss += v[j][0] * v[j][0] + v[j][1] * v[j][1] + v[j][2] * v[j][2] + v[j][3] * v[j][3]; }
        ss = wave_sum(ss); const float r = pg8::rstd_of(ss);
#pragma unroll
        for (int j = 0; j < 4; ++j) xr[64 * j] = v[j] * r * g4[64 * j]; }
}

#if DBG
__device__ __forceinline__ void dbg_compare(int cp, int vcu, int G) {
    const int tid = opaque_tid(), lane = tid & 63, wave = __builtin_amdgcn_readfirstlane(tid >> 6);
    const bf16_t* snap = (const bf16_t*)(KWS + WS_SNAP) + (size_t)cp * DBG_NT * D; float* res = (float*)(KWS + WS_DBG);
    for (int row = vcu * NWAVES + wave; row < DBG_NT; row += G * NWAVES) { float e2 = 0.f, r2 = 0.f;
        for (int j = 0; j < 16; ++j) { const int c = lane + 64 * j; const float hv = KOUT[(size_t)row * D + c]; const float sv = __uint_as_float((unsigned)snap[(size_t)row * D + c] << 16); e2 += (hv - sv) * (hv - sv); r2 += sv * sv; }
        e2 = wave_sum(e2); r2 = wave_sum(r2);
        if (lane == 0) { atomicAdd(res + 2 * cp, e2); atomicAdd(res + 2 * cp + 1, r2); } }
}
#endif

__global__ void __launch_bounds__(NTHREADS, 2) mk_fwd(Args a) {
    extern __shared__ __attribute__((aligned(16))) unsigned char lds_raw[];
    LAS unsigned char* lds = (LAS unsigned char*)lds_raw;
    cg::grid_group grid = cg::this_grid();
    const int G = gridDim.x, bx = blockIdx.x;
    const int vcu = (G % 8 == 0) ? (bx % 8) * (G / 8) + bx / 8 : bx;
    unsigned char* ws = KWS;
    bf16_t* HB = (bf16_t*)(ws + WS_HB); bf16_t* T = (bf16_t*)(ws + WS_T); bf16_t* Y = (bf16_t*)(ws + WS_Y);
    float* rowss = (float*)(ws + WS_ROWSS);
#define GRID_SYNC() grid.sync()
#if DBG
    int dcp = 0;
#define DBG_CP() do { dbg_compare(dcp, vcu, G); ++dcp; GRID_SYNC(); } while (0)
#else
#define DBG_CP() do { } while (0)
#endif

    prep_phase(lds, vcu, G);
    __syncthreads();
    GRID_SYNC();

    int cur = 0;
#pragma unroll 1
    for (int L = 0; L < 2; ++L) {
        unsigned char* wl = ws + WS_W + (size_t)L * WL_STRIDE;
        {
            pg8::Gemm g{HB, (const bf16_t*)(wl + W_GU1), M, 2 * FF, D}; pg8::StaticOrder S; S.init(M, 2 * FF, G, bx);
            pg8::EpiSwiglu E{T, rowss + (size_t)cur * M};
            pg8::gemm_phase<pg8::EpiSwiglu, pg8::StaticOrder, GP_ALIGN, GP_SP2>(lds, g, S, E);
        }
        GRID_SYNC();
        {
            pg8::Gemm g{T, (const bf16_t*)(wl + W_D1), M, D, FF}; pg8::StaticOrder S; S.init(M, D, G, bx);
            pg8::EpiRes E{L == 0 ? KIN(I_X) : KOUT, KOUT, HB, rowss + (size_t)(cur + 1) * M, 0.5f};
            pg8::gemm_phase<pg8::EpiRes, pg8::StaticOrder, GP_ALIGN, GP_SP2>(lds, g, S, E);
        }
        ++cur;
        GRID_SYNC();
        DBG_CP();
        if (L == 0) {
            pg8::Gemm g{HB, (const bf16_t*)(wl + W_IN), M, 2560, D}; pg8::StaticOrder S; S.init(M, 2560, G, bx);
            pg8::EpiMix0 E{rowss + (size_t)cur * M, T, T + (size_t)M * 1024, T + (size_t)M * 1536};
            pg8::gemm_phase<pg8::EpiMix0, pg8::StaticOrder, GP_ALIGN, GP_SP2>(lds, g, S, E);
        } else {
            pg8::Gemm g{HB, (const bf16_t*)(wl + W_IN), M, 1536, D}; pg8::StaticOrder S; S.init(M, 1536, G, bx);
            pg8::EpiMix1 E{rowss + (size_t)cur * M, T, T + (size_t)M * 512};
            pg8::gemm_phase<pg8::EpiMix1, pg8::StaticOrder, GP_ALIGN, GP_SP2>(lds, g, S, E);
        }
        GRID_SYNC();
        if (L == 0) mix0_phase(lds, vcu, G); else mix1_phase(lds, vcu, G);
        GRID_SYNC();
        {
            pg8::Gemm g{Y, (const bf16_t*)(wl + W_OUT), M, D, D}; pg8::StaticOrder S; S.init(M, D, G, bx);
            pg8::EpiRes E{KOUT, KOUT, HB, rowss + (size_t)(cur + 1) * M, 1.0f};
            pg8::gemm_phase<pg8::EpiRes, pg8::StaticOrder, GP_ALIGN, GP_SP2>(lds, g, S, E);
        }
        ++cur;
        GRID_SYNC();
        DBG_CP();
        {
            pg8::Gemm g{HB, (const bf16_t*)(wl + W_GU2), M, 2 * FF, D}; pg8::StaticOrder S; S.init(M, 2 * FF, G, bx);
            pg8::EpiSwiglu E{T, rowss + (size_t)cur * M};
            pg8::gemm_phase<pg8::EpiSwiglu, pg8::StaticOrder, GP_ALIGN, GP_SP2>(lds, g, S, E);
            pg8::Gemm g2{(const bf16_t*)(ws + WS_PB) + (size_t)L * M * PLE, (const bf16_t*)(wl + W_UP), M, D, PLE}; pg8::StaticOrder S2; S2.init(M, D, G, bx);
            pg8::EpiPlain E2{Y};
            pg8::gemm_phase<pg8::EpiPlain, pg8::StaticOrder, GP_ALIGN, GP_SP2>(lds, g2, S2, E2);
        }
        GRID_SYNC();
        {
            pg8::Gemm g{T, (const bf16_t*)(wl + W_D2), M, D, FF}; pg8::StaticOrder S; S.init(M, D, G, bx);
            pg8::EpiRes E{KOUT, KOUT, HB, rowss + (size_t)(cur + 1) * M, 0.5f};
            pg8::gemm_phase<pg8::EpiRes, pg8::StaticOrder, GP_ALIGN, GP_SP2>(lds, g, S, E);
        }
        ++cur;
        GRID_SYNC();
        DBG_CP();
        {
            pg8::Gemm g{HB, (const bf16_t*)(wl + W_GATE), M, D, D}; pg8::StaticOrder S; S.init(M, D, G, bx);
            pg8::EpiPle E{rowss + (size_t)cur * M, Y, KOUT, L == 0 ? HB : nullptr, L == 0 ? rowss + (size_t)(cur + 1) * M : nullptr};
            pg8::gemm_phase<pg8::EpiPle, pg8::StaticOrder, GP_ALIGN, GP_SP2>(lds, g, S, E);
        }
        ++cur;
        GRID_SYNC();
        DBG_CP();
    }
    final_phase(vcu, G);
}
}
#if DBG
namespace v0 {
constexpr int D = 1024, SEQ = 2048, BATCH = 8, PLE = 256, FF = 2816;
constexpr int WA = 512, WB = 512, WC = 512, WD = 512, CHUNK = 128;
constexpr int IN_EVEN = 2560, IN_ODD = 1536;
constexpr float RMS_EPS = 1e-6f, LN_EPS = 1e-5f;

__device__ __forceinline__ float wave_sum(float v) {
#pragma unroll
    for (int o = 1; o < 64; o <<= 1) v += __shfl_xor(v, o);
    return v;
}
__device__ __forceinline__ float sigmoidf_(float x) { return 1.0f / (1.0f + expf(-x)); }
__device__ __forceinline__ float siluf_(float x) { return x * sigmoidf_(x); }
__device__ __forceinline__ float gelu_tanh(float x) {
    const float c = 0.7978845608028654f;
    return 0.5f * x * (1.0f + tanhf(c * (x + 0.044715f * x * x * x)));
}

__global__ __launch_bounds__(256) void k_rmsnorm(const float* x, const float* gain, float* y, int rows) {
    const int row = blockIdx.x * 4 + (threadIdx.x >> 6), lane = threadIdx.x & 63;
    if (row >= rows) return;
    const float4* xr = (const float4*)(x + (size_t)row * D);
    float4 v[4]; float s = 0.f;
#pragma unroll
    for (int j = 0; j < 4; ++j) { v[j] = xr[lane + 64 * j]; s += v[j].x * v[j].x + v[j].y * v[j].y + v[j].z * v[j].z + v[j].w * v[j].w; }
    s = wave_sum(s);
    const float r = 1.0f / sqrtf(s * (1.0f / D) + RMS_EPS);
    float4* yr = (float4*)(y + (size_t)row * D);
    const float4* g4 = (const float4*)gain;
#pragma unroll
    for (int j = 0; j < 4; ++j) { const float4 g = g4[lane + 64 * j]; float4 o; o.x = v[j].x * r * g.x; o.y = v[j].y * r * g.y; o.z = v[j].z * r * g.z; o.w = v[j].w * r * g.w; yr[lane + 64 * j] = o; }
}

struct GemmP { const float* A; const float* B; float* C; int M, N, K, lda, ldb, ldc; long sA1, sB1, sC1, sA2, sB2, sC2; int nb2; int tril; };
__global__ __launch_bounds__(256) void k_gemm(GemmP p) {
    __shared__ float As[16][68];
    __shared__ float Bs[16][68];
    const int z1 = blockIdx.z / p.nb2, z2 = blockIdx.z % p.nb2;
    const float* A = p.A + z1 * p.sA1 + z2 * p.sA2;
    const float* B = p.B + z1 * p.sB1 + z2 * p.sB2;
    float* C = p.C + z1 * p.sC1 + z2 * p.sC2;
    const int t = threadIdx.x, tx = t & 15, ty = t >> 4;
    const int m0 = blockIdx.y * 64, n0 = blockIdx.x * 64;
    float acc[4][4];
#pragma unroll
    for (int i = 0; i < 4; ++i)
#pragma unroll
        for (int j = 0; j < 4; ++j) acc[i][j] = 0.f;
    const int ar = t >> 2, ak = (t & 3) * 4;
    const int bk = t >> 4, bn = (t & 15) * 4;
    for (int k0 = 0; k0 < p.K; k0 += 16) {
        float4 av = *(const float4*)(A + (size_t)(m0 + ar) * p.lda + k0 + ak);
        if (p.tril) {
            const int tt = m0 + ar, ss = k0 + ak;
            if (ss + 0 > tt) av.x = 0.f; if (ss + 1 > tt) av.y = 0.f; if (ss + 2 > tt) av.z = 0.f; if (ss + 3 > tt) av.w = 0.f;
        }
        const float4 bv = *(const float4*)(B + (size_t)(k0 + bk) * p.ldb + n0 + bn);
        As[ak + 0][ar] = av.x; As[ak + 1][ar] = av.y; As[ak + 2][ar] = av.z; As[ak + 3][ar] = av.w;
        *(float4*)&Bs[bk][bn] = bv;
        __syncthreads();
#pragma unroll
        for (int k = 0; k < 16; ++k) {
            const float4 a = *(const float4*)&As[k][ty * 4];
            const float4 b = *(const float4*)&Bs[k][tx * 4];
            const float aa[4] = {a.x, a.y, a.z, a.w}, bb[4] = {b.x, b.y, b.z, b.w};
#pragma unroll
            for (int i = 0; i < 4; ++i)
#pragma unroll
                for (int j = 0; j < 4; ++j) acc[i][j] = fmaf(aa[i], bb[j], acc[i][j]);
        }
        __syncthreads();
    }
#pragma unroll
    for (int i = 0; i < 4; ++i) {
        float4 o; o.x = acc[i][0]; o.y = acc[i][1]; o.z = acc[i][2]; o.w = acc[i][3];
        *(float4*)(C + (size_t)(m0 + ty * 4 + i) * p.ldc + n0 + tx * 4) = o;
    }
}

__global__ void k_swiglu(const float* z, float* t, int rows) {
    const size_t i = (size_t)blockIdx.x * blockDim.x + threadIdx.x;
    if (i >= (size_t)rows * FF) return;
    const size_t r = i / FF, j = i % FF;
    t[i] = siluf_(z[r * (2 * FF) + j]) * z[r * (2 * FF) + FF + j];
}
__global__ void k_add_scaled(float* h, const float* y, float sc, size_t n) {
    const size_t i = (size_t)blockIdx.x * blockDim.x + threadIdx.x;
    if (i < n) h[i] += sc * y[i];
}
__global__ __launch_bounds__(256) void k_gelu_ln(const float* z, const float* ln_g, const float* ln_b, float* u, float* vg, int rows) {
    const int wid = blockIdx.x * 4 + (threadIdx.x >> 6), lane = threadIdx.x & 63;
    const int row = wid >> 2, g = wid & 3;
    if (row >= rows) return;
    const float* zr = z + (size_t)row * IN_EVEN;
    const int c0 = g * 128 + lane * 2;
    u[(size_t)row * WA + c0] = gelu_tanh(zr[c0]); u[(size_t)row * WA + c0 + 1] = gelu_tanh(zr[c0 + 1]);
    const float v0 = gelu_tanh(zr[WA + c0]), v1 = gelu_tanh(zr[WA + c0 + 1]);
    const float mu = wave_sum(v0 + v1) * (1.0f / 128.0f);
    const float d0 = v0 - mu, d1 = v1 - mu;
    const float var = wave_sum(d0 * d0 + d1 * d1) * (1.0f / 128.0f);
    const float r = 1.0f / sqrtf(var + LN_EPS);
    vg[(size_t)row * WA + c0] = d0 * r * ln_g[c0] + ln_b[c0];
    vg[(size_t)row * WA + c0 + 1] = d1 * r * ln_g[c0 + 1] + ln_b[c0 + 1];
}
__global__ void k_gate(const float* u, const float* mixed, const float* b_s, float* ycat, int rows) {
    const size_t i = (size_t)blockIdx.x * blockDim.x + threadIdx.x;
    if (i >= (size_t)rows * WA) return;
    const int r = (int)(i / WA), c = (int)(i % WA), g = c >> 7;
    ycat[(size_t)r * D + c] = u[i] * (mixed[i] + b_s[g * CHUNK + (r % CHUNK)]);
}
__global__ void k_shortconv(const float* z, const float* w, float* ycat, int rows) {
    const size_t i = (size_t)blockIdx.x * blockDim.x + threadIdx.x;
    if (i >= (size_t)rows * WB) return;
    const int r = (int)(i / WB), c = (int)(i % WB);
    float acc = 0.f;
#pragma unroll
    for (int k = 0; k < 3; ++k) {
        const int tt = r - 2 + k;
        if (tt >= 0) { const float* zr = z + (size_t)tt * IN_EVEN + 2 * WA; acc += w[k * WB + c] * (zr[WB + c] * zr[2 * WB + c]); }
    }
    ycat[(size_t)r * D + WA + c] = z[(size_t)r * IN_EVEN + 2 * WA + c] * acc;
}
__global__ void k_pool(const float* z, float* pooled, int rows) {
    const size_t i = (size_t)blockIdx.x * blockDim.x + threadIdx.x;
    if (i >= (size_t)rows * WC) return;
    const int r = (int)(i / WC), c = (int)(i % WC), win = 2 << (c >> 7);
    const int cnt = (r + 1 < win) ? (r + 1) : win;
    float s = 0.f;
    for (int k = 0; k < cnt; ++k) s += z[(size_t)(r - k) * IN_ODD + c];
    pooled[i] = s / (float)cnt - z[(size_t)r * IN_ODD + c];
}
__global__ void k_colscale_to(const float* src, const float* sc, float* ycat, int rows) {
    const size_t i = (size_t)blockIdx.x * blockDim.x + threadIdx.x;
    if (i >= (size_t)rows * WC) return;
    const int r = (int)(i / WC), c = (int)(i % WC);
    ycat[(size_t)r * D + c] = src[i] * sc[c];
}
__global__ void k_glu(const float* z, float* s, int rows) {
    const size_t i = (size_t)blockIdx.x * blockDim.x + threadIdx.x;
    if (i >= (size_t)rows * WD) return;
    const int r = (int)(i / WD), c = (int)(i % WD);
    s[i] = z[(size_t)r * IN_ODD + WC + c] * sigmoidf_(z[(size_t)r * IN_ODD + WC + WD + c]);
}
__global__ __launch_bounds__(512) void k_conv_ln_silu(const float* s, const float* cw, const float* cb, const float* ln_g, const float* ln_b, float* ycat, int rows) {
    __shared__ float red[8];
    __shared__ float red2[8];
    const int r = blockIdx.x, c = threadIdx.x;
    float acc = cb[c];
    for (int k = 0; k < 31; ++k) { const int tt = r - 30 + k; if (tt >= 0) acc += cw[k * WD + c] * s[(size_t)tt * WD + c]; }
    float ws = wave_sum(acc);
    if ((c & 63) == 0) red[c >> 6] = ws;
    __syncthreads();
    float mu = 0.f;
#pragma unroll
    for (int i = 0; i < 8; ++i) mu += red[i];
    mu *= (1.0f / 512.0f);
    const float d = acc - mu;
    float wq = wave_sum(d * d);
    if ((c & 63) == 0) red2[c >> 6] = wq;
    __syncthreads();
    float var = 0.f;
#pragma unroll
    for (int i = 0; i < 8; ++i) var += red2[i];
    var *= (1.0f / 512.0f);
    const float y = d * (1.0f / sqrtf(var + LN_EPS)) * ln_g[c] + ln_b[c];
    ycat[(size_t)r * D + WC + c] = siluf_(y);
}
__global__ void k_ple(float* h, const float* gz, const float* pu, size_t n) {
    const size_t i = (size_t)blockIdx.x * blockDim.x + threadIdx.x;
    if (i < n) h[i] += sigmoidf_(gz[i]) * pu[i];
}


static unsigned short* g_snap = nullptr; static int g_snap_i = 0;
__global__ void k_snap(const float* h, unsigned short* o, size_t n) { const size_t i = (size_t)blockIdx.x * blockDim.x + threadIdx.x; if (i < n) { unsigned u = __float_as_uint(h[i]); u += 0x7fffu + ((u >> 16) & 1u); o[i] = (unsigned short)(u >> 16); } }
static void snap_hook(hipStream_t st, const float* h, int S) { if (!g_snap) return; const size_t n = (size_t)S * 1024; hipLaunchKernelGGL(k_snap, dim3((unsigned)((n + 255) / 256)), dim3(256), 0, st, h, g_snap + (size_t)g_snap_i * n, n); ++g_snap_i; }
struct In {
    const float *x, *p, *ffn1_norm, *ffn1_w_gu, *ffn1_w_down, *mix_norm, *ffn2_norm, *ffn2_w_gu, *ffn2_w_down, *ple_norm, *ple_w_gate, *ple_w_up,
        *ab_w_in, *gm_ln_g, *gm_ln_b, *gm_w_s, *gm_b_s, *sc_w, *ab_w_out, *cd_w_in, *pool_w, *pool_scale, *cv_w, *cv_b, *cv_ln_g, *cv_ln_b, *cd_w_out, *final_norm;
};

static void gemm(hipStream_t st, const float* A, const float* B, float* C, int M, int N, int K, int lda, int ldb, int ldc,
                 int nb1 = 1, long sA1 = 0, long sB1 = 0, long sC1 = 0, int nb2 = 1, long sA2 = 0, long sB2 = 0, long sC2 = 0, int tril = 0) {
    GemmP p{A, B, C, M, N, K, lda, ldb, ldc, sA1, sB1, sC1, sA2, sB2, sC2, nb2, tril};
    hipLaunchKernelGGL(k_gemm, dim3(N / 64, M / 64, nb1 * nb2), dim3(256), 0, st, p);
}
static inline unsigned nblk(size_t n, int b) { return (unsigned)((n + b - 1) / b); }

static void forward_slab(hipStream_t st, const In& in, const float* p_slab0, const float* p_slab1, float* h, float* out, float* tmp, int S) {
    float* xn = tmp;
    float* z = xn + (size_t)S * D;
    float* t = z + (size_t)S * 2 * FF;
    float* y = t + (size_t)S * FF;
    float* ycat = y + (size_t)S * D;
    float* gz = ycat + (size_t)S * D;
    float* b0 = gz + (size_t)S * D;
    float* b1 = b0 + (size_t)S * 512; float* b2 = b1 + (size_t)S * 512; float* b3 = b2 + (size_t)S * 512;
    const size_t nh = (size_t)S * D;
    for (int i = 0; i < 2; ++i) {
        hipLaunchKernelGGL(k_rmsnorm, dim3(S / 4), dim3(256), 0, st, h, in.ffn1_norm + i * D, xn, S);
        gemm(st, xn, in.ffn1_w_gu + (size_t)i * D * 2 * FF, z, S, 2 * FF, D, D, 2 * FF, 2 * FF);
        hipLaunchKernelGGL(k_swiglu, dim3(nblk((size_t)S * FF, 256)), dim3(256), 0, st, z, t, S);
        gemm(st, t, in.ffn1_w_down + (size_t)i * FF * D, y, S, D, FF, FF, D, D);
        hipLaunchKernelGGL(k_add_scaled, dim3(nblk(nh, 256)), dim3(256), 0, st, h, y, 0.5f, nh);
        snap_hook(st, h, S);
        hipLaunchKernelGGL(k_rmsnorm, dim3(S / 4), dim3(256), 0, st, h, in.mix_norm + i * D, xn, S);
        if (i == 0) {
            gemm(st, xn, in.ab_w_in, z, S, IN_EVEN, D, D, IN_EVEN, IN_EVEN);
            float *u = b0, *vg = b1, *mixed = b2;
            hipLaunchKernelGGL(k_gelu_ln, dim3(S), dim3(256), 0, st, z, in.gm_ln_g, in.gm_ln_b, u, vg, S);
            gemm(st, in.gm_w_s, vg, mixed, CHUNK, 128, CHUNK, CHUNK, WA, WA, S / CHUNK, 0, (long)CHUNK * WA, (long)CHUNK * WA, 4, (long)CHUNK * CHUNK, 128, 128, 1);
            hipLaunchKernelGGL(k_gate, dim3(nblk((size_t)S * WA, 256)), dim3(256), 0, st, u, mixed, in.gm_b_s, ycat, S);
            hipLaunchKernelGGL(k_shortconv, dim3(nblk((size_t)S * WB, 256)), dim3(256), 0, st, z, in.sc_w, ycat, S);
            gemm(st, ycat, in.ab_w_out, y, S, D, D, D, D, D);
        } else {
            gemm(st, xn, in.cd_w_in, z, S, IN_ODD, D, D, IN_ODD, IN_ODD);
            float *pooled = b0, *ycr = b1, *sg = b2;
            hipLaunchKernelGGL(k_pool, dim3(nblk((size_t)S * WC, 256)), dim3(256), 0, st, z, pooled, S);
            gemm(st, pooled, in.pool_w, ycr, S, 128, 128, WC, 128, WC, 4, 128, 128L * 128, 128);
            hipLaunchKernelGGL(k_colscale_to, dim3(nblk((size_t)S * WC, 256)), dim3(256), 0, st, ycr, in.pool_scale, ycat, S);
            hipLaunchKernelGGL(k_glu, dim3(nblk((size_t)S * WD, 256)), dim3(256), 0, st, z, sg, S);
            hipLaunchKernelGGL(k_conv_ln_silu, dim3(S), dim3(512), 0, st, sg, in.cv_w, in.cv_b, in.cv_ln_g, in.cv_ln_b, ycat, S);
            gemm(st, ycat, in.cd_w_out, y, S, D, D, D, D, D);
        }
        hipLaunchKernelGGL(k_add_scaled, dim3(nblk(nh, 256)), dim3(256), 0, st, h, y, 1.0f, nh);
        snap_hook(st, h, S);
        hipLaunchKernelGGL(k_rmsnorm, dim3(S / 4), dim3(256), 0, st, h, in.ffn2_norm + i * D, xn, S);
        gemm(st, xn, in.ffn2_w_gu + (size_t)i * D * 2 * FF, z, S, 2 * FF, D, D, 2 * FF, 2 * FF);
        hipLaunchKernelGGL(k_swiglu, dim3(nblk((size_t)S * FF, 256)), dim3(256), 0, st, z, t, S);
        gemm(st, t, in.ffn2_w_down + (size_t)i * FF * D, y, S, D, FF, FF, D, D);
        hipLaunchKernelGGL(k_add_scaled, dim3(nblk(nh, 256)), dim3(256), 0, st, h, y, 0.5f, nh);
        snap_hook(st, h, S);
        hipLaunchKernelGGL(k_rmsnorm, dim3(S / 4), dim3(256), 0, st, h, in.ple_norm + i * D, xn, S);
        gemm(st, xn, in.ple_w_gate + (size_t)i * D * D, gz, S, D, D, D, D, D);
        gemm(st, i == 0 ? p_slab0 : p_slab1, in.ple_w_up + (size_t)i * PLE * D, y, S, D, PLE, PLE, D, D);
        hipLaunchKernelGGL(k_ple, dim3(nblk(nh, 256)), dim3(256), 0, st, h, gz, y, nh);
        snap_hook(st, h, S);
    }
    hipLaunchKernelGGL(k_rmsnorm, dim3(S / 4), dim3(256), 0, st, h, in.final_norm, out, S);
}
}
#endif

#if DBG
__global__ void k_dbg_report(const float* res, float* out) {
    if (threadIdx.x != 0 || blockIdx.x != 0) return;
    for (int cp = 0; cp < 8; ++cp) { const float e2 = res[2 * cp], r2 = res[2 * cp + 1]; const float rel = sqrtf(e2 / fmaxf(r2, 1e-30f));
        if (!(rel < DBG_THR)) { int d = (int)(rel * 10.0f); if (d > 9 || !(rel == rel)) d = 9; if (d < 0) d = 0; out[0] = 1000.0f * (float)(cp + 1) + 100.0f * (float)d; return; } }
}
#endif

extern "C" void kernel_launch(void* const* d_in, const int* in_sizes, int n_in, void* d_out, int out_size, void* d_ws, size_t ws_size, hipStream_t stream) {
    using namespace mk;
    static int grid = 0;
    if (grid == 0) {
        const size_t need = DBG ? WS_SNAP + (size_t)8 * DBG_NT * D * 2 : WS_END;
        if (n_in != 28 || in_sizes[0] != M * D || out_size != M * D || ws_size < need) { fprintf(stderr, "kernel_launch: unexpected problem (n_in %d, in0 %d, out %d, ws %zu < %zu); nothing launched\n", n_in, n_in > 0 ? in_sizes[0] : -1, out_size, ws_size, need); grid = -1; return; }
        int dev = 0, cus = 0, per_cu = 0;
        if (hipGetDevice(&dev) != hipSuccess || hipDeviceGetAttribute(&cus, hipDeviceAttributeMultiprocessorCount, dev) != hipSuccess) { grid = -1; return; }
        if (hipFuncSetAttribute((const void*)mk_fwd, hipFuncAttributeMaxDynamicSharedMemorySize, LDS_BYTES) != hipSuccess) { fprintf(stderr, "kernel_launch: hipFuncSetAttribute failed\n"); grid = -1; return; }
        if (hipOccupancyMaxActiveBlocksPerMultiprocessor(&per_cu, (const void*)mk_fwd, NTHREADS, LDS_BYTES) != hipSuccess || per_cu < 1) { fprintf(stderr, "kernel_launch: occupancy query failed (%d)\n", per_cu); (void)hipGetLastError(); grid = -1; return; }
        grid = cus * 1;
        fprintf(stderr, "kernel_launch: grid %d (cus %d, occupancy %d/CU), ws %zu\n", grid, cus, per_cu, ws_size);
    }
    if (grid < 0) return;
    (void)hipMemsetAsync((char*)d_ws + WS_CTL, 0, CTL_BYTES, stream);
    Args a{};
    for (int i = 0; i < 28; ++i) a.in[i] = (const float*)d_in[i];
    a.out = (float*)d_out; a.ws = (unsigned char*)d_ws; a.dbg = DBG; a.pad = 0;
#if DBG
    {
        v0::In in; const float** f = (const float**)&in; for (int i = 0; i < 28; ++i) f[i] = (const float*)d_in[i];
        float* href = (float*)((char*)d_ws + WS_Y); float* tmp = (float*)((char*)d_ws + WS_T);
        (void)hipMemcpyAsync(href, in.x, (size_t)DBG_NT * D * sizeof(float), hipMemcpyDeviceToDevice, stream);
        v0::g_snap = (unsigned short*)((char*)d_ws + WS_SNAP); v0::g_snap_i = 0;
        v0::forward_slab(stream, in, in.p, in.p + (size_t)v0::BATCH * v0::SEQ * v0::PLE, href, href, tmp, DBG_NT);
    }
#endif
    void* args[] = {&a};
    const hipError_t e = hipLaunchCooperativeKernel((const void*)mk_fwd, dim3(grid), dim3(NTHREADS), args, LDS_BYTES, stream);
    if (e != hipSuccess) fprintf(stderr, "kernel_launch: cooperative launch failed: %s (grid %d)\n", hipGetErrorString(e), grid);
#if DBG
    hipLaunchKernelGGL(k_dbg_report, dim3(1), dim3(64), 0, stream, (const float*)((char*)d_ws + WS_DBG), (float*)d_out);
#endif
}
```

```cpp
#include <hip/hip_runtime.h>
#include <hip/hip_cooperative_groups.h>
#include <cstdio>
#include <cstdint>
namespace cg = cooperative_groups;

#ifndef DBG
#define DBG 0
#endif
#ifndef GP_SP2
#define GP_SP2 true
#endif
#ifndef GP_ALIGN
#define GP_ALIGN true
#endif
#ifndef DBG_THR
#define DBG_THR 0.03f
#endif

namespace pg8 {
#define PG8_LAS __attribute__((address_space(3)))
typedef unsigned short bf16_t;
typedef short bf16x8 __attribute__((ext_vector_type(8)));
typedef float f32x4 __attribute__((ext_vector_type(4)));
typedef unsigned u32x4 __attribute__((ext_vector_type(4)));
typedef unsigned u32x2 __attribute__((ext_vector_type(2)));
constexpr int BM = 256, BK = 64, HALF = 128, HTB = HALF * BK * 2  , STAGE_BYTES = 8 * HTB, NXCD = 8, WGM = 8;

__host__ __device__ __forceinline__ int lds_byte(int r, int c) { const int st = (r >> 4) * 2 + (c >> 5), rr = r & 15, cc = c & 31, ob = rr * 64 + cc * 2; return st * 1024 + (ob ^ (((ob >> 9) & 1) << 5)); }
__host__ __device__ __forceinline__ void stage_rc(int b, int& R, int& C) { const int st = b / 1024, sb = b % 1024, swz = sb ^ (((sb >> 9) & 1) << 5); R = (st >> 1) * 16 + swz / 64; C = (st & 1) * 32 + (swz % 64) / 2; }
__host__ __device__ __forceinline__ int perm32(int rho) { const int n = rho >> 4, i = rho & 15; return 8 * (i >> 2) + 4 * n + (i & 3); }

struct Unit { int pm, pn; };
struct Gemm { const bf16_t* A; const bf16_t* Bt; int M, N, K; };

struct StaticOrder {
    int nM, nN, nwg, G, c;
    __host__ __device__ void init(int M, int N, int G_, int c_) { nM = M / BM; nN = N / BM; nwg = nM * nN; G = G_; c = c_; }
    __host__ __device__ bool next(int i, Unit& u) const {
        const long L = (long)i * G + c; if (L >= nwg) return false;
        int wgid = (int)L; { const int q = nwg / NXCD, r = nwg % NXCD, xcd = wgid % NXCD, off = wgid / NXCD; wgid = (xcd < r ? xcd * (q + 1) : r * (q + 1) + (xcd - r) * q) + off; }
        const int nig = WGM * nN, gid = wgid / nig, fm = gid * WGM, gsz = (nM - fm) < WGM ? (nM - fm) : WGM;
        u.pm = fm + ((wgid % nig) % gsz); u.pn = (wgid % nig) / gsz; return true;
    }
    __device__ __forceinline__ void a_ready(const Unit&) const {}
    __device__ __forceinline__ void done(const Unit&) const {}
};

__device__ __forceinline__ unsigned cvt_pk_bf16(float lo, float hi) { unsigned r; asm volatile("v_cvt_pk_bf16_f32 %0, %1, %2" : "=v"(r) : "v"(lo), "v"(hi)); return r; }
__device__ __forceinline__ float bf_lo(unsigned w) { return __uint_as_float(w << 16); }
__device__ __forceinline__ float bf_hi(unsigned w) { return __uint_as_float(w & 0xffff0000u); }
__device__ __forceinline__ float fsigmoid(float x) { return __builtin_amdgcn_rcpf(1.0f + __builtin_amdgcn_exp2f(-1.4426950408889634f * x)); }
__device__ __forceinline__ float fsilu(float x) { return x * fsigmoid(x); }
__device__ __forceinline__ float fgelu_tanh(float x) { return x * fsigmoid(1.5957691216057308f * (x + 0.044715f * x * x * x)); }
__device__ __forceinline__ float rstd_of(float ss) { return __builtin_amdgcn_rsqf(ss * (1.0f / 1024.0f) + 1e-6f); }
__device__ __forceinline__ u32x4 pack8(const f32x4& a, const f32x4& b) { u32x4 w; w.x = cvt_pk_bf16(a[0], a[1]); w.y = cvt_pk_bf16(a[2], a[3]); w.z = cvt_pk_bf16(b[0], b[1]); w.w = cvt_pk_bf16(b[2], b[3]); return w; }

constexpr int DM = 1024, DFF = 2816;

struct EpiSwiglu {
    static constexpr bool PERM = true, AFTER_DRAIN = false;
    bf16_t* T; const float* rowss;
    __device__ __forceinline__ void operator()(const f32x4 (&acc)[2][2][4][2], const Unit& u, int wr, int wc, int fr, int fq) const {
        const int row0 = u.pm * BM + wr * 64 + fr, col0 = u.pn * 128 + wc * 32 + 8 * fq;
        float rs[2][4];
#pragma unroll
        for (int ai = 0; ai < 2; ++ai)
#pragma unroll
            for (int m = 0; m < 4; ++m) rs[ai][m] = rstd_of(rowss[row0 + ai * HALF + m * 16]);
#pragma unroll
        for (int ai = 0; ai < 2; ++ai)
#pragma unroll
            for (int m = 0; m < 4; ++m) {
                const int r = row0 + ai * HALF + m * 16; const float s = rs[ai][m];
                f32x4 t0, t1;
#pragma unroll
                for (int j = 0; j < 4; ++j) { t0[j] = fsilu(acc[ai][0][m][0][j] * s) * (acc[ai][1][m][0][j] * s); t1[j] = fsilu(acc[ai][0][m][1][j] * s) * (acc[ai][1][m][1][j] * s); }
                *(u32x4*)(T + (size_t)r * DFF + col0) = pack8(t0, t1);
            }
    }
};
struct EpiRes {
    static constexpr bool PERM = true, AFTER_DRAIN = false;
    const float* base; float* out; bf16_t* hb; float* rowss_out; float scale;
    __device__ __forceinline__ void operator()(const f32x4 (&acc)[2][2][4][2], const Unit& u, int wr, int wc, int fr, int fq) const {
        const int row0 = u.pm * BM + wr * 64 + fr, col0 = u.pn * BM + wc * 32 + 8 * fq;
#pragma unroll
        for (int ai = 0; ai < 2; ++ai)
#pragma unroll
            for (int m = 0; m < 4; ++m) {
                const int r = row0 + ai * HALF + m * 16; const size_t off = (size_t)r * DM + col0;
                const f32x4 b00 = *(const f32x4*)(base + off), b01 = *(const f32x4*)(base + off + 4), b10 = *(const f32x4*)(base + off + HALF), b11 = *(const f32x4*)(base + off + HALF + 4);
                const f32x4 o00 = b00 + acc[ai][0][m][0] * scale, o01 = b01 + acc[ai][0][m][1] * scale, o10 = b10 + acc[ai][1][m][0] * scale, o11 = b11 + acc[ai][1][m][1] * scale;
                *(f32x4*)(out + off) = o00; *(f32x4*)(out + off + 4) = o01; *(f32x4*)(out + off + HALF) = o10; *(f32x4*)(out + off + HALF + 4) = o11;
                *(u32x4*)(hb + off) = pack8(o00, o01); *(u32x4*)(hb + off + HALF) = pack8(o10, o11);
                float ss = 0.f;
#pragma unroll
                for (int j = 0; j < 4; ++j) ss += o00[j] * o00[j] + o01[j] * o01[j] + o10[j] * o10[j] + o11[j] * o11[j];
                ss += __shfl_xor(ss, 16); ss += __shfl_xor(ss, 32);
                if (fq == 0) atomicAdd(rowss_out + r, ss);
                asm volatile("" ::: "memory");
            }
    }
};
struct EpiPle {
    static constexpr bool PERM = true, AFTER_DRAIN = false;
    const float* rowss_in; const bf16_t* PU; float* h; bf16_t* hb; float* rowss_out;
    __device__ __forceinline__ void operator()(const f32x4 (&acc)[2][2][4][2], const Unit& u, int wr, int wc, int fr, int fq) const {
        const int row0 = u.pm * BM + wr * 64 + fr, col0 = u.pn * BM + wc * 32 + 8 * fq;
#pragma unroll
        for (int ai = 0; ai < 2; ++ai)
#pragma unroll
            for (int m = 0; m < 4; ++m) {
                const int r = row0 + ai * HALF + m * 16; const size_t off = (size_t)r * DM + col0;
                const float s = rstd_of(rowss_in[r]);
                const u32x4 p0 = *(const u32x4*)(PU + off), p1 = *(const u32x4*)(PU + off + HALF);
                const f32x4 b00 = *(const f32x4*)(h + off), b01 = *(const f32x4*)(h + off + 4), b10 = *(const f32x4*)(h + off + HALF), b11 = *(const f32x4*)(h + off + HALF + 4);
                const f32x4 q00 = {bf_lo(p0.x), bf_hi(p0.x), bf_lo(p0.y), bf_hi(p0.y)}, q01 = {bf_lo(p0.z), bf_hi(p0.z), bf_lo(p0.w), bf_hi(p0.w)};
                const f32x4 q10 = {bf_lo(p1.x), bf_hi(p1.x), bf_lo(p1.y), bf_hi(p1.y)}, q11 = {bf_lo(p1.z), bf_hi(p1.z), bf_lo(p1.w), bf_hi(p1.w)};
                f32x4 o00, o01, o10, o11;
#pragma unroll
                for (int j = 0; j < 4; ++j) {
                    o00[j] = b00[j] + fsigmoid(acc[ai][0][m][0][j] * s) * q00[j]; o01[j] = b01[j] + fsigmoid(acc[ai][0][m][1][j] * s) * q01[j];
                    o10[j] = b10[j] + fsigmoid(acc[ai][1][m][0][j] * s) * q10[j]; o11[j] = b11[j] + fsigmoid(acc[ai][1][m][1][j] * s) * q11[j]; }
                *(f32x4*)(h + off) = o00; *(f32x4*)(h + off + 4) = o01; *(f32x4*)(h + off + HALF) = o10; *(f32x4*)(h + off + HALF + 4) = o11;
                if (hb) {
                    *(u32x4*)(hb + off) = pack8(o00, o01); *(u32x4*)(hb + off + HALF) = pack8(o10, o11);
                    float ss = 0.f;
#pragma unroll
                    for (int j = 0; j < 4; ++j) ss += o00[j] * o00[j] + o01[j] * o01[j] + o10[j] * o10[j] + o11[j] * o11[j];
                    ss += __shfl_xor(ss, 16); ss += __shfl_xor(ss, 32);
                    if (fq == 0) atomicAdd(rowss_out + r, ss);
                }
                asm volatile("" ::: "memory");
            }
    }
};
struct EpiPlain {
    static constexpr bool PERM = true, AFTER_DRAIN = false;
    bf16_t* O;
    __device__ __forceinline__ void operator()(const f32x4 (&acc)[2][2][4][2], const Unit& u, int wr, int wc, int fr, int fq) const {
        const int row0 = u.pm * BM + wr * 64 + fr, col0 = u.pn * BM + wc * 32 + 8 * fq;
#pragma unroll
        for (int ai = 0; ai < 2; ++ai)
#pragma unroll
            for (int m = 0; m < 4; ++m) {
                const size_t off = (size_t)(row0 + ai * HALF + m * 16) * DM + col0;
                *(u32x4*)(O + off) = pack8(acc[ai][0][m][0], acc[ai][0][m][1]); *(u32x4*)(O + off + HALF) = pack8(acc[ai][1][m][0], acc[ai][1][m][1]);
            }
    }
};
struct EpiMix0 {
    static constexpr bool PERM = true, AFTER_DRAIN = false;
    const float* rowss; bf16_t *UV, *Q, *BG;
    __device__ __forceinline__ void operator()(const f32x4 (&acc)[2][2][4][2], const Unit& u, int wr, int wc, int fr, int fq) const {
        const int row0 = u.pm * BM + wr * 64 + fr, cw = wc * 32 + 8 * fq;
#pragma unroll
        for (int ai = 0; ai < 2; ++ai)
#pragma unroll
            for (int m = 0; m < 4; ++m) {
                const int r = row0 + ai * HALF + m * 16; const float s = rstd_of(rowss[r]);
                if (u.pn < 4) {
                    f32x4 a0, a1, b0, b1;
#pragma unroll
                    for (int j = 0; j < 4; ++j) { a0[j] = fgelu_tanh(acc[ai][0][m][0][j] * s); a1[j] = fgelu_tanh(acc[ai][0][m][1][j] * s); b0[j] = fgelu_tanh(acc[ai][1][m][0][j] * s); b1[j] = fgelu_tanh(acc[ai][1][m][1][j] * s); }
                    bf16_t* p = UV + (size_t)r * 1024 + u.pn * 256 + cw; *(u32x4*)p = pack8(a0, a1); *(u32x4*)(p + HALF) = pack8(b0, b1);
                } else if (u.pn < 8) {
                    const float s2 = s * s; f32x4 q0 = acc[ai][0][m][0] * acc[ai][1][m][0] * s2, q1 = acc[ai][0][m][1] * acc[ai][1][m][1] * s2;
                    *(u32x4*)(Q + (size_t)r * 512 + (u.pn - 4) * 128 + cw) = pack8(q0, q1);
                } else {
                    bf16_t* p = BG + (size_t)r * 512 + (u.pn - 8) * 256 + cw;
                    *(u32x4*)p = pack8(acc[ai][0][m][0] * s, acc[ai][0][m][1] * s); *(u32x4*)(p + HALF) = pack8(acc[ai][1][m][0] * s, acc[ai][1][m][1] * s);
                }
            }
    }
};
struct EpiMix1 {
    static constexpr bool PERM = true, AFTER_DRAIN = false;
    const float* rowss; bf16_t *ZC, *S;
    __device__ __forceinline__ void operator()(const f32x4 (&acc)[2][2][4][2], const Unit& u, int wr, int wc, int fr, int fq) const {
        const int row0 = u.pm * BM + wr * 64 + fr, cw = wc * 32 + 8 * fq;
#pragma unroll
        for (int ai = 0; ai < 2; ++ai)
#pragma unroll
            for (int m = 0; m < 4; ++m) {
                const int r = row0 + ai * HALF + m * 16; const float s = rstd_of(rowss[r]);
                if (u.pn < 2) {
                    bf16_t* p = ZC + (size_t)r * 512 + u.pn * 256 + cw;
                    *(u32x4*)p = pack8(acc[ai][0][m][0] * s, acc[ai][0][m][1] * s); *(u32x4*)(p + HALF) = pack8(acc[ai][1][m][0] * s, acc[ai][1][m][1] * s);
                } else {
                    f32x4 q0, q1;
#pragma unroll
                    for (int j = 0; j < 4; ++j) { q0[j] = acc[ai][0][m][0][j] * s * fsigmoid(acc[ai][1][m][0][j] * s); q1[j] = acc[ai][0][m][1][j] * s * fsigmoid(acc[ai][1][m][1][j] * s); }
                    *(u32x4*)(S + (size_t)r * 512 + (u.pn - 2) * 128 + cw) = pack8(q0, q1);
                }
            }
    }
};

template <class Epi, class Sched, bool ALIGN_EPI = false, bool SP2 = false>
__device__ __forceinline__ void gemm_phase(PG8_LAS unsigned char* lds, const Gemm g, const Sched& S, const Epi& E, const int wave_s  ) {
    int tid_; asm volatile("v_mbcnt_lo_u32_b32 %0, -1, 0\n\tv_mbcnt_hi_u32_b32 %0, -1, %0" : "=v"(tid_)); tid_ |= wave_s << 6;
    const int tid = tid_, wid = wave_s, lane = tid & 63, wr = wid >> 2, wc = wid & 3, fr = lane & 15, fq = lane >> 4;
    const int K = g.K, nt = K / BK;
    unsigned voffA[2], voffB[2];
#pragma unroll
    for (int i = 0; i < 2; ++i) { int R, C; stage_rc(tid * 16 + i * 8192, R, C); const int Rb = Epi::PERM ? ((R & ~31) + perm32(R & 31)) : R;
        voffA[i] = (unsigned)(R * K + C) * 2u; voffB[i] = (unsigned)(Rb * K + C) * 2u; }
    const size_t kstep = (size_t)(BK * 2);
    const size_t hstep = (size_t)HALF * K * 2;
    const size_t tstep = 2 * hstep;
    const unsigned ldsw = (unsigned)wid * 1024u;
    const int aoff = lds_byte(wr * 64 + fr, fq * 8), boff = lds_byte(wc * 32 + fr, fq * 8);
#define PG8_SA(b, h) (((b) * 2 + (h)) * HTB)
#define PG8_SB(b, h) ((4 + (b) * 2 + (h)) * HTB)
#define PG8_STAGE(bufoff, gbase, voff) do { _Pragma("unroll") for (int _i = 0; _i < 2; ++_i) \
        __builtin_amdgcn_global_load_lds((const unsigned*)((const char*)(gbase) + (voff)[_i]), (PG8_LAS unsigned*)(lds + (bufoff) + ldsw + _i * 8192), 16, 0, 0); } while (0)
#define PG8_LDA(dst, b, h) do { _Pragma("unroll") for (int m = 0; m < 4; ++m) _Pragma("unroll") for (int k = 0; k < 2; ++k) dst[m][k] = *(const PG8_LAS bf16x8*)(lds + PG8_SA(b, h) + aoff + m * 2048 + k * 1024); } while (0)
#define PG8_LDB(dst, b, h) do { _Pragma("unroll") for (int n = 0; n < 2; ++n) _Pragma("unroll") for (int k = 0; k < 2; ++k) dst[n][k] = *(const PG8_LAS bf16x8*)(lds + PG8_SB(b, h) + boff + n * 2048 + k * 1024); } while (0)
#define PG8_MMA(ai, bj, At, Bt) do { __builtin_amdgcn_s_setprio(1); _Pragma("unroll") for (int m = 0; m < 4; ++m) _Pragma("unroll") for (int n = 0; n < 2; ++n) _Pragma("unroll") for (int k = 0; k < 2; ++k) \
        acc[ai][bj][m][n] = __builtin_amdgcn_mfma_f32_16x16x32_bf16(Bt[n][k], At[m][k], acc[ai][bj][m][n], 0, 0, 0); __builtin_amdgcn_s_setprio(0); } while (0)
#define PG8_WAIT_V(n) asm volatile("s_waitcnt vmcnt(" #n ")" ::: "memory")
#define PG8_WAIT_L(n) asm volatile("s_waitcnt lgkmcnt(" #n ")" ::: "memory")
#define PG8_BAR __builtin_amdgcn_s_barrier()
#define PG8_SCHED __builtin_amdgcn_sched_barrier(0)
    Unit cur, nxt; int ui = 0;
    if (!S.next(0, cur)) return;
    f32x4 acc[2][2][4][2];
#pragma unroll
    for (int a = 0; a < 2; ++a)
#pragma unroll
        for (int b = 0; b < 2; ++b)
#pragma unroll
            for (int m = 0; m < 4; ++m)
#pragma unroll
                for (int n = 0; n < 2; ++n) acc[a][b][m][n] = (f32x4){0.f, 0.f, 0.f, 0.f};
    bf16x8 At[4][2], B0[2][2], B1[2][2];
    const char* cA = (const char*)g.A + (size_t)cur.pm * tstep; const char* cB = (const char*)g.Bt + (size_t)cur.pn * tstep;
    S.a_ready(cur);
    if constexpr (SP2) {
        PG8_STAGE(PG8_SB(0, 0), cB, voffB); PG8_STAGE(PG8_SB(0, 1), cB + hstep, voffB); PG8_STAGE(PG8_SA(0, 0), cA, voffA); PG8_STAGE(PG8_SA(0, 1), cA + hstep, voffA);
        if (wr == 1) PG8_BAR;
        PG8_WAIT_V(2); PG8_BAR;
        PG8_STAGE(PG8_SB(1, 0), cB + kstep, voffB); PG8_STAGE(PG8_SA(1, 0), cA + kstep, voffA); PG8_STAGE(PG8_SB(1, 1), cB + hstep + kstep, voffB);
        PG8_WAIT_V(6); PG8_BAR;
    } else {
        PG8_STAGE(PG8_SB(0, 0), cB, voffB); PG8_STAGE(PG8_SA(0, 0), cA, voffA); PG8_STAGE(PG8_SB(0, 1), cB + hstep, voffB); PG8_STAGE(PG8_SA(0, 1), cA + hstep, voffA);
        if (wr == 1) PG8_BAR;
        PG8_WAIT_V(4); PG8_BAR;
        PG8_STAGE(PG8_SB(1, 0), cB + kstep, voffB); PG8_STAGE(PG8_SA(1, 0), cA + kstep, voffA); PG8_STAGE(PG8_SB(1, 1), cB + hstep + kstep, voffB);
        PG8_WAIT_V(6); PG8_BAR;
    }
    for (;;) {
        const bool has_next = S.next(ui + 1, nxt);
        const char* nA = has_next ? (const char*)g.A + (size_t)nxt.pm * tstep : cA; const char* nB = has_next ? (const char*)g.Bt + (size_t)nxt.pn * tstep : cB;
        for (int t = 0; t < nt; t += 2) {
            const bool last = (t == nt - 2);
            const char* a1 = cA + (size_t)(t + 1) * kstep;
            const char* a2 = last ? nA : cA + (size_t)(t + 2) * kstep; const char* b2 = last ? nB : cB + (size_t)(t + 2) * kstep;
            const char* a3 = a2 + kstep; const char* b3 = b2 + kstep;
            if (last && has_next) S.a_ready(nxt);
            if constexpr (SP2) {
            PG8_LDB(B0, 0, 0); PG8_LDB(B1, 0, 1); PG8_SCHED; PG8_LDA(At, 0, 0); PG8_STAGE(PG8_SA(1, 1), a1 + hstep, voffA);
            PG8_WAIT_V(8); PG8_WAIT_L(0); PG8_BAR; PG8_MMA(0, 0, At, B0); PG8_MMA(0, 1, At, B1); PG8_BAR; PG8_SCHED;
            PG8_LDA(At, 0, 1); PG8_STAGE(PG8_SB(0, 0), b2, voffB); PG8_STAGE(PG8_SB(0, 1), b2 + hstep, voffB); PG8_STAGE(PG8_SA(0, 0), a2, voffA);
            PG8_WAIT_V(8); PG8_WAIT_L(0); PG8_BAR; PG8_MMA(1, 0, At, B0); PG8_MMA(1, 1, At, B1); PG8_BAR; PG8_SCHED;
            PG8_LDB(B0, 1, 0); PG8_LDB(B1, 1, 1); PG8_SCHED; PG8_LDA(At, 1, 0); PG8_STAGE(PG8_SA(0, 1), a2 + hstep, voffA);
            PG8_WAIT_V(8); PG8_WAIT_L(0); PG8_BAR; PG8_MMA(0, 0, At, B0); PG8_MMA(0, 1, At, B1); PG8_BAR; PG8_SCHED;
            PG8_LDA(At, 1, 1); PG8_STAGE(PG8_SB(1, 0), b3, voffB); PG8_STAGE(PG8_SB(1, 1), b3 + hstep, voffB); PG8_STAGE(PG8_SA(1, 0), a3, voffA);
            PG8_WAIT_V(8); PG8_WAIT_L(0); PG8_BAR; PG8_MMA(1, 0, At, B0); PG8_MMA(1, 1, At, B1); PG8_BAR; PG8_SCHED;
            } else {
            PG8_LDB(B0, 0, 0); PG8_SCHED; PG8_LDA(At, 0, 0); PG8_STAGE(PG8_SA(1, 1), a1 + hstep, voffA);
            PG8_WAIT_L(8); PG8_BAR; PG8_WAIT_L(0); PG8_MMA(0, 0, At, B0); PG8_BAR; PG8_SCHED;
            PG8_LDB(B1, 0, 1); PG8_STAGE(PG8_SB(0, 0), b2, voffB);
            PG8_BAR; PG8_WAIT_L(0); PG8_MMA(0, 1, At, B1); PG8_BAR;
            PG8_LDA(At, 0, 1); PG8_STAGE(PG8_SA(0, 0), a2, voffA);
            PG8_BAR; PG8_WAIT_L(0); PG8_MMA(1, 0, At, B0); PG8_BAR; PG8_SCHED;
            PG8_STAGE(PG8_SB(0, 1), b2 + hstep, voffB);
            PG8_WAIT_V(6); PG8_BAR; PG8_MMA(1, 1, At, B1); PG8_BAR;
            PG8_LDB(B0, 1, 0); PG8_SCHED; PG8_LDA(At, 1, 0); PG8_STAGE(PG8_SA(0, 1), a2 + hstep, voffA);
            PG8_WAIT_L(8); PG8_BAR; PG8_WAIT_L(0); PG8_MMA(0, 0, At, B0); PG8_BAR; PG8_SCHED;
            PG8_LDB(B1, 1, 1); PG8_STAGE(PG8_SB(1, 0), b3, voffB);
            PG8_BAR; PG8_WAIT_L(0); PG8_MMA(0, 1, At, B1); PG8_BAR;
            PG8_LDA(At, 1, 1); PG8_STAGE(PG8_SA(1, 0), a3, voffA);
            PG8_BAR; PG8_WAIT_L(0); PG8_MMA(1, 0, At, B0); PG8_BAR; PG8_SCHED;
            PG8_STAGE(PG8_SB(1, 1), b3 + hstep, voffB);
            PG8_WAIT_V(6); PG8_BAR; PG8_MMA(1, 1, At, B1); PG8_BAR;
            }
        }
        if constexpr (ALIGN_EPI) { if (wr == 0) PG8_BAR; }
        if constexpr (!Epi::AFTER_DRAIN) { E(acc, cur, wr, wc, fr, fq); S.done(cur); }
        if (!has_next) break;
#pragma unroll
        for (int a = 0; a < 2; ++a)
#pragma unroll
            for (int b = 0; b < 2; ++b)
#pragma unroll
                for (int m = 0; m < 4; ++m)
#pragma unroll
                    for (int n = 0; n < 2; ++n) acc[a][b][m][n] = (f32x4){0.f, 0.f, 0.f, 0.f};
        cur = nxt; cA = nA; cB = nB; ++ui;
        if constexpr (ALIGN_EPI) { if (wr == 1) PG8_BAR; }
    }
    PG8_WAIT_V(0);
    if constexpr (!ALIGN_EPI) { if (wr == 0) PG8_BAR; }
    PG8_BAR;
    if constexpr (Epi::AFTER_DRAIN) { E.fused(acc, cur, wr, wc, fr, fq, lds, wid, lane); S.done(cur); }
#undef PG8_SA
#undef PG8_SB
#undef PG8_STAGE
#undef PG8_LDA
#undef PG8_LDB
#undef PG8_MMA
#undef PG8_WAIT_V
#undef PG8_WAIT_L
#undef PG8_BAR
#undef PG8_SCHED
}
}

namespace mk {
using pg8::bf16_t; using pg8::bf16x8; using pg8::f32x4; using pg8::u32x4; using pg8::u32x2; using pg8::cvt_pk_bf16; using pg8::bf_lo; using pg8::bf_hi;
#define LAS __attribute__((address_space(3)))
#define LDS_WAIT() asm volatile("s_waitcnt lgkmcnt(0)" ::: "memory")
constexpr int M = 16384, D = 1024, FF = 2816, SEQ = 2048, PLE = 256;
constexpr int NWAVES = 8, NTHREADS = 512;
constexpr int LDS_BYTES = 147456;
constexpr size_t MiB = 1u << 20, HM = 512u * 1024u;
constexpr size_t WS_CTL = 0, CTL_BYTES = 2 * MiB;
constexpr size_t WS_BAR = 4096;
constexpr int LDSCTL_OFF = 131072;
constexpr size_t WS_DBG = 64 * 1024;
constexpr size_t WS_ROWSS = 1 * MiB;
constexpr size_t WS_W = 2 * MiB;
constexpr size_t W_GU1 = 0, W_D1 = 22 * HM, W_GU2 = 33 * HM, W_D2 = 55 * HM, W_GATE = 66 * HM, W_UP = 70 * HM, W_OUT = 71 * HM, W_IN = 75 * HM, WL_STRIDE = 85 * HM;
constexpr size_t WS_WTRIL = WS_W + 2 * WL_STRIDE;
constexpr size_t WS_HB = 88 * MiB;
constexpr size_t WS_T = 120 * MiB;
constexpr size_t WS_Y = 208 * MiB;
constexpr size_t WS_PB = 240 * MiB;
constexpr size_t WS_END = 256 * MiB;
constexpr size_t WS_SNAP = 256 * MiB;
constexpr int DBG_NT = 384;
static_assert(WS_WTRIL + 131072 <= WS_HB && WS_T + (size_t)M * FF * 2 <= WS_Y, "ws map");

struct Args { const float* in[28]; float* out; unsigned char* ws; int dbg; int pad; };
enum { I_X = 0, I_P, I_FFN1_NORM, I_FFN1_WGU, I_FFN1_WD, I_MIX_NORM, I_FFN2_NORM, I_FFN2_WGU, I_FFN2_WD, I_PLE_NORM, I_PLE_WG, I_PLE_WU, I_AB_WIN, I_GM_LNG, I_GM_LNB, I_GM_WS, I_GM_BS,
       I_SC_W, I_AB_WOUT, I_CD_WIN, I_POOL_W, I_POOL_SCALE, I_CV_W, I_CV_B, I_CV_LNG, I_CV_LNB, I_CD_WOUT, I_FINAL_NORM };

typedef const __attribute__((address_space(4))) unsigned char* kargp_t;
__device__ __forceinline__ kargp_t kargs() { kargp_t p = (kargp_t)__builtin_amdgcn_kernarg_segment_ptr(); asm volatile("" : "+s"(p)); return p; }
#define KIN(i) (*(const float* const __attribute__((address_space(4)))*)(kargs() + 8 * (i)))
#define KOUT (*(float* const __attribute__((address_space(4)))*)(kargs() + 8 * 28))
#define KWS (*(unsigned char* const __attribute__((address_space(4)))*)(kargs() + 8 * 29))
__device__ __forceinline__ int lane_id() { int l; asm volatile("v_mbcnt_lo_u32_b32 %0, -1, 0\n\tv_mbcnt_hi_u32_b32 %0, -1, %0" : "=v"(l)); return l; }
__device__ __forceinline__ int opaque_tid(int wave_s) { int t = (wave_s << 6) | lane_id(); asm volatile("" : "+v"(t)); return t; }
__device__ __forceinline__ float wave_sum(float v) {
#pragma unroll
    for (int o = 1; o < 64; o <<= 1) v += __shfl_xor(v, o);
    return v;
}
__device__ __forceinline__ void unpack8(const u32x4& w, float (&f)[8]) { f[0] = bf_lo(w.x); f[1] = bf_hi(w.x); f[2] = bf_lo(w.y); f[3] = bf_hi(w.y); f[4] = bf_lo(w.z); f[5] = bf_hi(w.z); f[6] = bf_lo(w.w); f[7] = bf_hi(w.w); }
__device__ __forceinline__ u32x4 pack8f(const float (&f)[8]) { u32x4 w; w.x = cvt_pk_bf16(f[0], f[1]); w.y = cvt_pk_bf16(f[2], f[3]); w.z = cvt_pk_bf16(f[4], f[5]); w.w = cvt_pk_bf16(f[6], f[7]); return w; }

__device__ __forceinline__ unsigned long long rt() { return __builtin_amdgcn_s_memrealtime(); }
#define XB_TMO      128
#define XB_XCNT(j)  (256  + 64 * (j))
#define XB_XSUB(j)  (1280 + 64 * (j))
#define XB_XGEN(j)  (2304 + 64 * (j))
#define XB_TOP      3328
#define XB_TOPGEN   3392
#define XCD_BAR_WORDS 3456
#define XB_SPIN_CAP (1u << 18)

__device__ __forceinline__ unsigned xb_ld(unsigned* p)              { return __hip_atomic_load(p, __ATOMIC_RELAXED, __HIP_MEMORY_SCOPE_AGENT); }
__device__ __forceinline__ unsigned xb_add(unsigned* p, unsigned v) { return __hip_atomic_fetch_add(p, v, __ATOMIC_RELAXED, __HIP_MEMORY_SCOPE_AGENT); }
__device__ __forceinline__ unsigned xb_xcc_id() { return (unsigned)__builtin_amdgcn_s_getreg((3 << 11) | 20) & 0xFu; }
#define XB_SPIN(cond, bar) do { unsigned _sp = 0; while (cond) { __builtin_amdgcn_s_sleep(1); \
    if ((++_sp & 255u) == 0u) { if (xb_ld(&(bar)[XB_TMO])) break; if (_sp > XB_SPIN_CAP) { atomicAdd(&(bar)[XB_TMO], 1u); break; } } } } while (0)

struct XcdBarrier {
    unsigned* bar; unsigned x;
    volatile LAS unsigned* st;
};

__device__ __forceinline__ XcdBarrier xcd_barrier_post(unsigned* bar, volatile LAS unsigned* st, const bool tid0) {
    XcdBarrier b; b.bar = bar; b.x = xb_xcc_id(); b.st = st;
    if (tid0) (void)xb_add(&bar[XB_XCNT(b.x)], 1u);
    return b;
}
__device__ __forceinline__ void xcd_barrier_complete(unsigned* bar, unsigned x, unsigned& nloc, unsigned& nx) {
    const unsigned G = gridDim.x * gridDim.y * gridDim.z;
    unsigned sum, cnt, mine, sp = 0u;
    for (;;) {
        sum = 0u; cnt = 0u; mine = 0u;
#pragma unroll
        for (unsigned j = 0; j < 16; ++j) { const unsigned c = xb_ld(&bar[XB_XCNT(j)]); sum += c; cnt += (c > 0u) ? 1u : 0u; mine = (j == x) ? c : mine; }
        if (sum == G) break;
        __builtin_amdgcn_s_sleep(1);
        if ((++sp & 255u) == 0u) { if (xb_ld(&bar[XB_TMO])) break; if (sp > XB_SPIN_CAP) { atomicAdd(&bar[XB_TMO], 1u); break; } }
    }
    nloc = mine > 0u ? mine : 1u; nx = cnt > 0u ? cnt : 1u;
}

__device__ __forceinline__ void xcd_barrier(const XcdBarrier& b, const int wave_s) {
    asm volatile("s_waitcnt vmcnt(0)" ::: "memory");
    __syncthreads();
    if (wave_s == 0 && lane_id() == 0) {
        unsigned* bar = b.bar;
        __builtin_amdgcn_s_waitcnt(0);
        unsigned nloc = b.st[0], nx = b.st[1];
        if (nloc == 0u) { xcd_barrier_complete(bar, b.x, nloc, nx); b.st[0] = nloc; b.st[1] = nx; }
        const unsigned old = xb_add(&bar[XB_XSUB(b.x)], 1u);
        const unsigned gen = old / nloc;
        if (old + 1u == (gen + 1u) * nloc) {
            __builtin_amdgcn_fence(__ATOMIC_RELEASE, "agent");
            asm volatile("s_waitcnt vmcnt(0)" ::: "memory");
            const unsigned og = xb_add(&bar[XB_TOP], 1u);
            const unsigned tg = og / nx;
            if (og + 1u == (tg + 1u) * nx) xb_add(&bar[XB_TOPGEN], 1u);
            else XB_SPIN(xb_ld(&bar[XB_TOPGEN]) == tg, bar);
            __builtin_amdgcn_fence(__ATOMIC_ACQUIRE, "agent");
            xb_add(&bar[XB_XGEN(b.x)], 1u);
            asm volatile("s_waitcnt vmcnt(0)" ::: "memory");
        } else {
            XB_SPIN(xb_ld(&bar[XB_XGEN(b.x)]) == gen, bar);
            __builtin_amdgcn_fence(__ATOMIC_ACQUIRE, "agent");
            asm volatile("s_waitcnt vmcnt(0)" ::: "memory");
        }
    }
    __syncthreads();
}

__device__ __forceinline__ void tr_item(const float* W, int ldsrc, int srccol0, const float* gain, bf16_t* dstblk, int lddst, int k0, LAS float* scr, int lane) {
#pragma unroll 8
    for (int i = 0; i < 32; ++i) { const int kk = 2 * i + (lane >> 5); float v = W[(size_t)(k0 + kk) * ldsrc + srccol0 + (lane & 31)]; if (gain) v *= gain[k0 + kk]; scr[kk * 33 + (lane & 31)] = v; }
    LDS_WAIT(); asm volatile("" ::: "memory");
    const int c = lane & 7;
#pragma unroll
    for (int j = 0; j < 4; ++j) { const int n = (lane >> 3) + 8 * j; const LAS float* s = scr + (8 * c) * 33 + n;
        u32x4 o; o.x = cvt_pk_bf16(s[0 * 33], s[1 * 33]); o.y = cvt_pk_bf16(s[2 * 33], s[3 * 33]); o.z = cvt_pk_bf16(s[4 * 33], s[5 * 33]); o.w = cvt_pk_bf16(s[6 * 33], s[7 * 33]);
        *(u32x4*)(dstblk + (size_t)n * lddst + k0 + 8 * c) = o; }
    LDS_WAIT(); asm volatile("" ::: "memory");
}
__device__ __forceinline__ int map_col(int map, int R) {
    if (map == 0) return R;
    if (map == 1) { const int pn = R >> 8, w = R & 255; return w < 128 ? 128 * pn + w : 2816 + 128 * pn + (w - 128); }
    if (map == 2) { if (R < 1024) return R; if (R < 2048) { const int t = (R - 1024) >> 8, w = (R - 1024) & 255; return w < 128 ? 1536 + 128 * t + w : 2048 + 128 * t + (w - 128); } return 1024 + (R - 2048); }
    if (R < 512) return R; { const int t = (R - 512) >> 8, w = (R - 512) & 255; return w < 128 ? 512 + 128 * t + w : 1024 + 128 * t + (w - 128); }
}
__device__ __forceinline__ void prep_phase(LAS unsigned char* lds, int vcu, int G, int wave) {
    asm volatile("" : "+s"(vcu), "+s"(G), "+s"(wave));
    const int tid = opaque_tid(wave), lane = tid & 63;
    LAS float* scr = (LAS float*)(lds + wave * 16384);
    unsigned char* ws = KWS;
    const int gw = vcu * NWAVES + wave, NGW = G * NWAVES;
    constexpr int J_GU = 16 * 176, J_D = 44 * 32, J_GATE = 16 * 32, J_UP = 4 * 32, J_L = 2 * J_GU + 2 * J_D + J_GATE + J_UP;
    constexpr int J_OUT0 = 16 * 32, J_OUT1 = 8 * 32, J_IN0 = 16 * 80, J_IN1 = 16 * 48, NITEMS = 2 * J_L + J_OUT0 + J_OUT1 + J_IN0 + J_IN1;
    for (int it = gw; it < NITEMS; it += NGW) {
        int r = it; const float* src; const float* gain = nullptr; bf16_t* dst; int ldsrc, lddst, nblk, map = 0;
        if (r < 2 * J_L) {
            const int L = r / J_L; r -= L * J_L; unsigned char* wl = ws + WS_W + (size_t)L * WL_STRIDE;
            if (r < J_GU) { src = KIN(I_FFN1_WGU) + (size_t)L * D * 2 * FF; gain = KIN(I_FFN1_NORM) + L * D; dst = (bf16_t*)(wl + W_GU1); ldsrc = 2 * FF; lddst = D; nblk = 176; map = 1; }
            else if ((r -= J_GU) < J_D) { src = KIN(I_FFN1_WD) + (size_t)L * FF * D; dst = (bf16_t*)(wl + W_D1); ldsrc = D; lddst = FF; nblk = 32; }
            else if ((r -= J_D) < J_GU) { src = KIN(I_FFN2_WGU) + (size_t)L * D * 2 * FF; gain = KIN(I_FFN2_NORM) + L * D; dst = (bf16_t*)(wl + W_GU2); ldsrc = 2 * FF; lddst = D; nblk = 176; map = 1; }
            else if ((r -= J_GU) < J_D) { src = KIN(I_FFN2_WD) + (size_t)L * FF * D; dst = (bf16_t*)(wl + W_D2); ldsrc = D; lddst = FF; nblk = 32; }
            else if ((r -= J_D) < J_GATE) { src = KIN(I_PLE_WG) + (size_t)L * D * D; gain = KIN(I_PLE_NORM) + L * D; dst = (bf16_t*)(wl + W_GATE); ldsrc = D; lddst = D; nblk = 32; }
            else { r -= J_GATE; src = KIN(I_PLE_WU) + (size_t)L * PLE * D; dst = (bf16_t*)(wl + W_UP); ldsrc = D; lddst = PLE; nblk = 32; }
        } else {
            r -= 2 * J_L;
            if (r < J_OUT0) { src = KIN(I_AB_WOUT); dst = (bf16_t*)(ws + WS_W + W_OUT); ldsrc = D; lddst = D; nblk = 32; }
            else if ((r -= J_OUT0) < J_OUT1) { src = KIN(I_CD_WOUT) + (size_t)512 * D; dst = (bf16_t*)(ws + WS_W + WL_STRIDE + W_OUT) + 512; ldsrc = D; lddst = D; nblk = 32; }
            else if ((r -= J_OUT1) < J_IN0) { src = KIN(I_AB_WIN); gain = KIN(I_MIX_NORM); dst = (bf16_t*)(ws + WS_W + W_IN); ldsrc = 2560; lddst = D; nblk = 80; map = 2; }
            else { r -= J_IN0; src = KIN(I_CD_WIN); gain = KIN(I_MIX_NORM) + D; dst = (bf16_t*)(ws + WS_W + WL_STRIDE + W_IN); ldsrc = 1536; lddst = D; nblk = 48; map = 3; }
        }
        const int kb = r / nblk, nb = r - kb * nblk, R = 32 * nb;
        tr_item(src, ldsrc, map_col(map, R), gain, dst + (size_t)R * lddst, lddst, 64 * kb, scr, lane);
    }
    {
        const float* x = KIN(I_X); bf16_t* hb = (bf16_t*)(ws + WS_HB); float* rowss0 = (float*)(ws + WS_ROWSS);
        for (int row = gw; row < M; row += NGW) {
            const f32x4* xr = (const f32x4*)(x + (size_t)row * D) + lane; u32x2* o = (u32x2*)(hb + (size_t)row * D) + lane; float ss = 0.f;
#pragma unroll
            for (int j = 0; j < 4; ++j) { const f32x4 v = xr[64 * j]; ss += v[0] * v[0] + v[1] * v[1] + v[2] * v[2] + v[3] * v[3]; u32x2 w; w.x = cvt_pk_bf16(v[0], v[1]); w.y = cvt_pk_bf16(v[2], v[3]); o[64 * j] = w; }
            ss = wave_sum(ss);
            if (lane == 0) rowss0[row] = ss;
        }
    }
    const int gt = gw * 64 + lane, NGT = NGW * 64;
    {
        const float* p = KIN(I_P); bf16_t* pb = (bf16_t*)(ws + WS_PB);
        for (int t = gt; t < 2 * M * PLE / 8; t += NGT) { const f32x4 v0 = *(const f32x4*)(p + (size_t)t * 8), v1 = *(const f32x4*)(p + (size_t)t * 8 + 4); *(u32x4*)(pb + (size_t)t * 8) = pg8::pack8(v0, v1); }
    }
    {
        const float* w = KIN(I_GM_WS); bf16_t* wt = (bf16_t*)(ws + WS_WTRIL);
        for (int t = gt; t < 4 * 128 * 128 / 8; t += NGT) { const int e0 = t * 8, tt = (e0 >> 7) & 127, s0 = e0 & 127; float f[8];
#pragma unroll
            for (int j = 0; j < 8; ++j) f[j] = (s0 + j <= tt) ? w[e0 + j] : 0.f;
            *(u32x4*)(wt + e0) = pack8f(f); }
    }
    {
        const float* pw = KIN(I_POOL_W); const float* sc = KIN(I_POOL_SCALE); const float* wo = KIN(I_CD_WOUT); bf16_t* dst = (bf16_t*)(ws + WS_W + WL_STRIDE + W_OUT);
        for (int t = gt; t < 4 * 16 * 1024; t += NGT) { const int n = t & 1023, c8 = (t >> 10) & 15, g = t >> 14; float acc[8];
#pragma unroll
            for (int e = 0; e < 8; ++e) acc[e] = 0.f;
            const float* pwr = pw + ((size_t)g * 128 + c8 * 8) * 128;
            for (int d = 0; d < 128; ++d) { const float wv = wo[(size_t)(128 * g + d) * D + n] * sc[128 * g + d];
#pragma unroll
                for (int e = 0; e < 8; ++e) acc[e] = fmaf(pwr[e * 128 + d], wv, acc[e]); }
            *(u32x4*)(dst + (size_t)n * D + 128 * g + 8 * c8) = pack8f(acc); }
    }
}

__device__ __forceinline__ void mix0_phase(LAS unsigned char* lds, int vcu, int G, int wave) {
    asm volatile("" : "+s"(vcu), "+s"(G), "+s"(wave));
    const int tid = opaque_tid(wave), lane = tid & 63;
    unsigned char* ws = KWS;
    const bf16_t* UV = (const bf16_t*)(ws + WS_T); const bf16_t* Q = UV + (size_t)M * 1024; const bf16_t* BG = Q + (size_t)M * 512;
    bf16_t* Y = (bf16_t*)(ws + WS_Y); const bf16_t* Wtril = (const bf16_t*)(ws + WS_WTRIL);
    LAS bf16_t* vgT = (LAS bf16_t*)lds;
    const int fr = lane & 15, fq = lane >> 4;
    for (int item = vcu; item < 512; item += G) {
        const int c = item >> 2, g = item & 3;
        {
            const int tok = tid >> 2, qt = tid & 3;
            const u32x4* src = (const u32x4*)(UV + (size_t)(c * 128 + tok) * 1024 + 512 + g * 128 + qt * 32);
            float v[32];
#pragma unroll
            for (int j = 0; j < 4; ++j) { const u32x4 w = src[j]; float f[8]; unpack8(w, f);
#pragma unroll
                for (int e = 0; e < 8; ++e) v[8 * j + e] = f[e]; }
            float s = 0.f;
#pragma unroll
            for (int i = 0; i < 32; ++i) s += v[i];
            s += __shfl_xor(s, 1); s += __shfl_xor(s, 2);
            const float mean = s * (1.0f / 128.0f); float q = 0.f;
#pragma unroll
            for (int i = 0; i < 32; ++i) { v[i] -= mean; q += v[i] * v[i]; }
            q += __shfl_xor(q, 1); q += __shfl_xor(q, 2);
            const float rstd = __builtin_amdgcn_rsqf(q * (1.0f / 128.0f) + 1e-5f);
            const float* lg = KIN(I_GM_LNG) + g * 128 + qt * 32; const float* lb = KIN(I_GM_LNB) + g * 128 + qt * 32;
#pragma unroll
            for (int i = 0; i < 32; ++i) { const float val = v[i] * rstd * lg[i] + lb[i]; vgT[(qt * 32 + i) * 136 + tok] = (bf16_t)(cvt_pk_bf16(val, 0.f) & 0xffffu); }
        }
        __syncthreads();
        {
            f32x4 acc[8];
#pragma unroll
            for (int nt = 0; nt < 8; ++nt) acc[nt] = (f32x4){0.f, 0.f, 0.f, 0.f};
            const int nks = ((16 * wave + 15) >> 5) + 1;
            const bf16_t* wrow = Wtril + (size_t)g * 16384 + (16 * wave + fr) * 128 + 8 * fq;
            for (int ks = 0; ks < nks; ++ks) {
                const bf16x8 wf = *(const bf16x8*)(wrow + 32 * ks);
#pragma unroll
                for (int nt = 0; nt < 8; ++nt) { const bf16x8 vf = *(const LAS bf16x8*)(vgT + (16 * nt + fr) * 136 + 32 * ks + 8 * fq);
                    acc[nt] = __builtin_amdgcn_mfma_f32_16x16x32_bf16(vf, wf, acc[nt], 0, 0, 0); }
            }
            const int t = 16 * wave + fr; const size_t row = (size_t)c * 128 + t; const float bias = KIN(I_GM_BS)[g * 128 + t];
#pragma unroll
            for (int nt = 0; nt < 8; ++nt) { const int d = 16 * nt + 4 * fq; const u32x2 uu = *(const u32x2*)(UV + row * 1024 + g * 128 + d);
                u32x2 o; o.x = cvt_pk_bf16(bf_lo(uu.x) * (acc[nt][0] + bias), bf_hi(uu.x) * (acc[nt][1] + bias)); o.y = cvt_pk_bf16(bf_lo(uu.y) * (acc[nt][2] + bias), bf_hi(uu.y) * (acc[nt][3] + bias));
                *(u32x2*)(Y + row * 1024 + g * 128 + d) = o; }
        }
        __syncthreads();
    }
    for (int wi = vcu * NWAVES + wave; wi < M / 8; wi += G * NWAVES) {
        const int r0 = wi * 8, pos0 = r0 & (SEQ - 1);
        const float* sw = KIN(I_SC_W) + 8 * lane; float w0[8], w1[8], w2[8];
#pragma unroll
        for (int e = 0; e < 8; ++e) { w0[e] = sw[e]; w1[e] = sw[512 + e]; w2[e] = sw[1024 + e]; }
        float qm2[8], qm1[8];
#pragma unroll
        for (int e = 0; e < 8; ++e) { qm2[e] = 0.f; qm1[e] = 0.f; }
        if (pos0 != 0) { unpack8(*(const u32x4*)(Q + (size_t)(r0 - 2) * 512 + 8 * lane), qm2); unpack8(*(const u32x4*)(Q + (size_t)(r0 - 1) * 512 + 8 * lane), qm1); }
#pragma unroll
        for (int t = 0; t < 8; ++t) { float qv[8], bg[8], y[8]; unpack8(*(const u32x4*)(Q + (size_t)(r0 + t) * 512 + 8 * lane), qv); unpack8(*(const u32x4*)(BG + (size_t)(r0 + t) * 512 + 8 * lane), bg);
#pragma unroll
            for (int e = 0; e < 8; ++e) { y[e] = bg[e] * (w0[e] * qm2[e] + w1[e] * qm1[e] + w2[e] * qv[e]); qm2[e] = qm1[e]; qm1[e] = qv[e]; }
            *(u32x4*)(Y + (size_t)(r0 + t) * 1024 + 512 + 8 * lane) = pack8f(y); }
    }
}

__device__ __forceinline__ void mix1_phase(LAS unsigned char* lds, int vcu, int G, int wave) {
    asm volatile("" : "+s"(vcu), "+s"(G), "+s"(wave));
    const int tid = opaque_tid(wave), lane = tid & 63;
    unsigned char* ws = KWS;
    const bf16_t* ZC = (const bf16_t*)(ws + WS_T); const bf16_t* S = ZC + (size_t)M * 512; bf16_t* Y = (bf16_t*)(ws + WS_Y);
    for (int r = vcu * NWAVES + wave; r < M; r += G * NWAVES) {
        const int pos = r & (SEQ - 1), win = 2 << (lane >> 4), cnt = (pos + 1 < win) ? pos + 1 : win;
        float sum[8], x0[8];
        unpack8(*(const u32x4*)(ZC + (size_t)r * 512 + 8 * lane), x0);
#pragma unroll
        for (int e = 0; e < 8; ++e) sum[e] = x0[e];
        for (int k = 1; k < 16; ++k) { if (k < cnt) { float f[8]; unpack8(*(const u32x4*)(ZC + (size_t)(r - k) * 512 + 8 * lane), f);
#pragma unroll
                for (int e = 0; e < 8; ++e) sum[e] += f[e]; } }
        const float inv = 1.0f / (float)cnt; float y[8];
#pragma unroll
        for (int e = 0; e < 8; ++e) y[e] = sum[e] * inv - x0[e];
        *(u32x4*)(Y + (size_t)r * 1024 + 8 * lane) = pack8f(y);
    }
    LAS unsigned char* sl = lds;
    LAS float* hbuf = (LAS float*)(lds + 62 * 1024);
    const int cp = tid & 255, half = tid >> 8;
    float cw[31][2];
#pragma unroll
    for (int k = 0; k < 31; ++k) { cw[k][0] = KIN(I_CV_W)[k * 512 + 2 * cp]; cw[k][1] = KIN(I_CV_W)[k * 512 + 2 * cp + 1]; }
    const float cb0 = KIN(I_CV_B)[2 * cp], cb1 = KIN(I_CV_B)[2 * cp + 1];
    for (int item = vcu; item < M / 32; item += G) {
        const int t0 = item * 32, pos0 = t0 & (SEQ - 1);
#pragma unroll
        for (int ps = 0; ps < 8; ++ps) { const int row = ps * 8 + (tid >> 6);
            if (row < 62) { u32x4 v = (u32x4){0u, 0u, 0u, 0u}; if (pos0 - 30 + row >= 0) v = *(const u32x4*)(S + (size_t)(t0 - 30 + row) * 512 + 8 * (tid & 63));
                *(LAS u32x4*)(sl + row * 1024 + (tid & 63) * 16) = v; } }
        __syncthreads();
#pragma unroll
        for (int run = 0; run < 2; ++run) {
            const int tl = half * 16 + run * 8;
            float acc[8][2];
#pragma unroll
            for (int o = 0; o < 8; ++o) { acc[o][0] = cb0; acc[o][1] = cb1; }
#pragma unroll
            for (int i = 0; i < 38; ++i) { const unsigned w = *(const LAS unsigned*)(sl + (tl + i) * 1024 + cp * 4); const float x0 = bf_lo(w), x1 = bf_hi(w);
#pragma unroll
                for (int o = 0; o < 8; ++o) { const int k = i - o; if (k >= 0 && k < 31) { acc[o][0] = fmaf(cw[k][0], x0, acc[o][0]); acc[o][1] = fmaf(cw[k][1], x1, acc[o][1]); } } }
#pragma unroll
            for (int o = 0; o < 8; ++o) { typedef float f32x2v __attribute__((ext_vector_type(2))); *(LAS f32x2v*)(hbuf + (tl + o) * 512 + 2 * cp) = (f32x2v){acc[o][0], acc[o][1]}; }
        }
        __syncthreads();
#pragma unroll
        for (int tt = 0; tt < 4; ++tt) { const int tl = wave * 4 + tt; const LAS f32x4* hp = (const LAS f32x4*)(hbuf + tl * 512 + 8 * lane); const f32x4 h0 = hp[0], h1 = hp[1];
            float s = (h0[0] + h0[1]) + (h0[2] + h0[3]) + (h1[0] + h1[1]) + (h1[2] + h1[3]); s = wave_sum(s);
            const float mean = s * (1.0f / 512.0f); const f32x4 d0 = h0 - mean, d1 = h1 - mean;
            float q = (d0[0] * d0[0] + d0[1] * d0[1]) + (d0[2] * d0[2] + d0[3] * d0[3]) + (d1[0] * d1[0] + d1[1] * d1[1]) + (d1[2] * d1[2] + d1[3] * d1[3]); q = wave_sum(q);
            const float rstd = __builtin_amdgcn_rsqf(q * (1.0f / 512.0f) + 1e-5f);
            const f32x4 g0 = *(const f32x4*)(KIN(I_CV_LNG) + 8 * lane), g1 = *(const f32x4*)(KIN(I_CV_LNG) + 8 * lane + 4), b0 = *(const f32x4*)(KIN(I_CV_LNB) + 8 * lane), b1 = *(const f32x4*)(KIN(I_CV_LNB) + 8 * lane + 4);
            float y[8];
#pragma unroll
            for (int e = 0; e < 4; ++e) { y[e] = pg8::fsilu(d0[e] * rstd * g0[e] + b0[e]); y[4 + e] = pg8::fsilu(d1[e] * rstd * g1[e] + b1[e]); }
            *(u32x4*)(Y + (size_t)(t0 + tl) * 1024 + 512 + 8 * lane) = pack8f(y); }
        __syncthreads();
    }
}

__device__ __forceinline__ void final_phase(int vcu, int G, int wave) {
    asm volatile("" : "+s"(vcu), "+s"(G), "+s"(wave));
    const int tid = opaque_tid(wave), lane = tid & 63;
    const int gw = vcu * NWAVES + wave, NGW = G * NWAVES; const f32x4* g4 = (const f32x4*)KIN(I_FINAL_NORM) + lane;
    for (int row = gw; row < M; row += NGW) { f32x4* xr = (f32x4*)(KOUT + (size_t)row * D) + lane; f32x4 v[4]; float ss = 0.f;
#pragma unroll
        for (int j = 0; j < 4; ++j) { v[j] = xr[64 * j]; ss += v[j][0] * v[j][0] + v[j][1] * v[j][1] + v[j][2] * v[j][2] + v[j][3] * v[j][3]; }
        ss = wave_sum(ss); const float r = pg8::rstd_of(ss);
#pragma unroll
        for (int j = 0; j < 4; ++j) xr[64 * j] = v[j] * r * g4[64 * j]; }
}

#if DBG
__device__ __forceinline__ void dbg_compare(int cp, int vcu, int G, int wave) {
    asm volatile("" : "+s"(vcu), "+s"(G), "+s"(wave));
    const int tid = opaque_tid(wave), lane = tid & 63;
    const bf16_t* snap = (const bf16_t*)(KWS + WS_SNAP) + (size_t)cp * DBG_NT * D; float* res = (float*)(KWS + WS_DBG);
    for (int row = vcu * NWAVES + wave; row < DBG_NT; row += G * NWAVES) { float e2 = 0.f, r2 = 0.f;
        for (int j = 0; j < 16; ++j) { const int c = lane + 64 * j; const float hv = KOUT[(size_t)row * D + c]; const float sv = __uint_as_float((unsigned)snap[(size_t)row * D + c] << 16); e2 += (hv - sv) * (hv - sv); r2 += sv * sv; }
        e2 = wave_sum(e2); r2 = wave_sum(r2);
        if (lane == 0) { atomicAdd(res + 2 * cp, e2); atomicAdd(res + 2 * cp + 1, r2); } }
}
#endif

#define WSP(off) (KWS + (off))
#define ROWSS(k) ((float*)WSP(WS_ROWSS) + (size_t)(k) * M)
__global__ void __launch_bounds__(NTHREADS, 2) mk_fwd(Args a_unused) {
    extern __shared__ __attribute__((aligned(16))) unsigned char lds_raw[];
    LAS unsigned char* lds = (LAS unsigned char*)lds_raw;
    cg::grid_group grid = cg::this_grid();
    const int wave_s = __builtin_amdgcn_readfirstlane(threadIdx.x >> 6);
    const int G = gridDim.x, bx = blockIdx.x;
    const int vcu = (G % 8 == 0) ? (bx % 8) * (G / 8) + bx / 8 : bx;
    for (int u = threadIdx.x; u < 64; u += NTHREADS) ((LAS unsigned*)(lds + LDSCTL_OFF))[u] = 0u;
    __syncthreads();
    const XcdBarrier xbar = xcd_barrier_post((unsigned*)WSP(WS_BAR), (volatile LAS unsigned*)(lds + LDSCTL_OFF + 32), threadIdx.x == 0);
#define GRID_SYNC() xcd_barrier(xbar, wave_s)
#if DBG
    int dcp = 0;
#define DBG_CP() do { dbg_compare(dcp, vcu, G, wave_s); ++dcp; GRID_SYNC(); } while (0)
#else
#define DBG_CP() do { } while (0)
#endif
#define GEMM_PHASE(EPI, A_, B_, N_, K_, ...) do { int G_ = G, bx_ = bx, w_ = wave_s; asm volatile("" : "+s"(G_), "+s"(bx_), "+s"(w_));     \
        pg8::Gemm g_{(const bf16_t*)(A_), (const bf16_t*)(B_), M, (N_), (K_)}; pg8::StaticOrder S_; S_.init(M, (N_), G_, bx_); \
        pg8::EPI E_{__VA_ARGS__}; pg8::gemm_phase<pg8::EPI, pg8::StaticOrder, GP_ALIGN, GP_SP2>(lds, g_, S_, E_, w_); } while (0)

    prep_phase(lds, vcu, G, wave_s);
    __syncthreads();
    grid.sync();

#pragma unroll 1
    for (int L = 0; L < 2; ++L) {
        const size_t wl = WS_W + (size_t)L * WL_STRIDE;
        const int cur = 4 * L;
        GEMM_PHASE(EpiSwiglu, WSP(WS_HB), WSP(wl + W_GU1), 2 * FF, D, (bf16_t*)WSP(WS_T), ROWSS(cur));
        GRID_SYNC();
        GEMM_PHASE(EpiRes, WSP(WS_T), WSP(wl + W_D1), D, FF, L == 0 ? KIN(I_X) : KOUT, KOUT, (bf16_t*)WSP(WS_HB), ROWSS(cur + 1), 0.5f);
        GRID_SYNC();
        DBG_CP();
        if (L == 0) GEMM_PHASE(EpiMix0, WSP(WS_HB), WSP(wl + W_IN), 2560, D, ROWSS(cur + 1), (bf16_t*)WSP(WS_T), (bf16_t*)WSP(WS_T) + (size_t)M * 1024, (bf16_t*)WSP(WS_T) + (size_t)M * 1536);
        else GEMM_PHASE(EpiMix1, WSP(WS_HB), WSP(wl + W_IN), 1536, D, ROWSS(cur + 1), (bf16_t*)WSP(WS_T), (bf16_t*)WSP(WS_T) + (size_t)M * 512);
        GRID_SYNC();
        if (L == 0) mix0_phase(lds, vcu, G, wave_s); else mix1_phase(lds, vcu, G, wave_s);
        GRID_SYNC();
        GEMM_PHASE(EpiRes, WSP(WS_Y), WSP(wl + W_OUT), D, D, KOUT, KOUT, (bf16_t*)WSP(WS_HB), ROWSS(cur + 2), 1.0f);
        GRID_SYNC();
        DBG_CP();
        GEMM_PHASE(EpiSwiglu, WSP(WS_HB), WSP(wl + W_GU2), 2 * FF, D, (bf16_t*)WSP(WS_T), ROWSS(cur + 2));
        GEMM_PHASE(EpiPlain, (const bf16_t*)WSP(WS_PB) + (size_t)L * M * PLE, WSP(wl + W_UP), D, PLE, (bf16_t*)WSP(WS_Y));
        GRID_SYNC();
        GEMM_PHASE(EpiRes, WSP(WS_T), WSP(wl + W_D2), D, FF, KOUT, KOUT, (bf16_t*)WSP(WS_HB), ROWSS(cur + 3), 0.5f);
        GRID_SYNC();
        DBG_CP();
        GEMM_PHASE(EpiPle, WSP(WS_HB), WSP(wl + W_GATE), D, D, ROWSS(cur + 3), (const bf16_t*)WSP(WS_Y), KOUT, L == 0 ? (bf16_t*)WSP(WS_HB) : (bf16_t*)nullptr, L == 0 ? ROWSS(cur + 4) : (float*)nullptr);
        GRID_SYNC();
        DBG_CP();
    }
    final_phase(vcu, G, wave_s);
}
}
#if DBG
namespace v0 {
constexpr int D = 1024, SEQ = 2048, BATCH = 8, PLE = 256, FF = 2816;
constexpr int WA = 512, WB = 512, WC = 512, WD = 512, CHUNK = 128;
constexpr int IN_EVEN = 2560, IN_ODD = 1536;
constexpr float RMS_EPS = 1e-6f, LN_EPS = 1e-5f;

__device__ __forceinline__ float wave_sum(float v) {
#pragma unroll
    for (int o = 1; o < 64; o <<= 1) v += __shfl_xor(v, o);
    return v;
}
__device__ __forceinline__ float sigmoidf_(float x) { return 1.0f / (1.0f + expf(-x)); }
__device__ __forceinline__ float siluf_(float x) { return x * sigmoidf_(x); }
__device__ __forceinline__ float gelu_tanh(float x) {
    const float c = 0.7978845608028654f;
    return 0.5f * x * (1.0f + tanhf(c * (x + 0.044715f * x * x * x)));
}

__global__ __launch_bounds__(256) void k_rmsnorm(const float* x, const float* gain, float* y, int rows) {
    const int row = blockIdx.x * 4 + (threadIdx.x >> 6), lane = threadIdx.x & 63;
    if (row >= rows) return;
    const float4* xr = (const float4*)(x + (size_t)row * D);
    float4 v[4]; float s = 0.f;
#pragma unroll
    for (int j = 0; j < 4; ++j) { v[j] = xr[lane + 64 * j]; s += v[j].x * v[j].x + v[j].y * v[j].y + v[j].z * v[j].z + v[j].w * v[j].w; }
    s = wave_sum(s);
    const float r = 1.0f / sqrtf(s * (1.0f / D) + RMS_EPS);
    float4* yr = (float4*)(y + (size_t)row * D);
    const float4* g4 = (const float4*)gain;
#pragma unroll
    for (int j = 0; j < 4; ++j) { const float4 g = g4[lane + 64 * j]; float4 o; o.x = v[j].x * r * g.x; o.y = v[j].y * r * g.y; o.z = v[j].z * r * g.z; o.w = v[j].w * r * g.w; yr[lane + 64 * j] = o; }
}

struct GemmP { const float* A; const float* B; float* C; int M, N, K, lda, ldb, ldc; long sA1, sB1, sC1, sA2, sB2, sC2; int nb2; int tril; };
__global__ __launch_bounds__(256) void k_gemm(GemmP p) {
    __shared__ float As[16][68];
    __shared__ float Bs[16][68];
    const int z1 = blockIdx.z / p.nb2, z2 = blockIdx.z % p.nb2;
    const float* A = p.A + z1 * p.sA1 + z2 * p.sA2;
    const float* B = p.B + z1 * p.sB1 + z2 * p.sB2;
    float* C = p.C + z1 * p.sC1 + z2 * p.sC2;
    const int t = threadIdx.x, tx = t & 15, ty = t >> 4;
    const int m0 = blockIdx.y * 64, n0 = blockIdx.x * 64;
    float acc[4][4];
#pragma unroll
    for (int i = 0; i < 4; ++i)
#pragma unroll
        for (int j = 0; j < 4; ++j) acc[i][j] = 0.f;
    const int ar = t >> 2, ak = (t & 3) * 4;
    const int bk = t >> 4, bn = (t & 15) * 4;
    for (int k0 = 0; k0 < p.K; k0 += 16) {
        float4 av = *(const float4*)(A + (size_t)(m0 + ar) * p.lda + k0 + ak);
        if (p.tril) {
            const int tt = m0 + ar, ss = k0 + ak;
            if (ss + 0 > tt) av.x = 0.f; if (ss + 1 > tt) av.y = 0.f; if (ss + 2 > tt) av.z = 0.f; if (ss + 3 > tt) av.w = 0.f;
        }
        const float4 bv = *(const float4*)(B + (size_t)(k0 + bk) * p.ldb + n0 + bn);
        As[ak + 0][ar] = av.x; As[ak + 1][ar] = av.y; As[ak + 2][ar] = av.z; As[ak + 3][ar] = av.w;
        *(float4*)&Bs[bk][bn] = bv;
        __syncthreads();
#pragma unroll
        for (int k = 0; k < 16; ++k) {
            const float4 a = *(const float4*)&As[k][ty * 4];
            const float4 b = *(const float4*)&Bs[k][tx * 4];
            const float aa[4] = {a.x, a.y, a.z, a.w}, bb[4] = {b.x, b.y, b.z, b.w};
#pragma unroll
            for (int i = 0; i < 4; ++i)
#pragma unroll
                for (int j = 0; j < 4; ++j) acc[i][j] = fmaf(aa[i], bb[j], acc[i][j]);
        }
        __syncthreads();
    }
#pragma unroll
    for (int i = 0; i < 4; ++i) {
        float4 o; o.x = acc[i][0]; o.y = acc[i][1]; o.z = acc[i][2]; o.w = acc[i][3];
        *(float4*)(C + (size_t)(m0 + ty * 4 + i) * p.ldc + n0 + tx * 4) = o;
    }
}

__global__ void k_swiglu(const float* z, float* t, int rows) {
    const size_t i = (size_t)blockIdx.x * blockDim.x + threadIdx.x;
    if (i >= (size_t)rows * FF) return;
    const size_t r = i / FF, j = i % FF;
    t[i] = siluf_(z[r * (2 * FF) + j]) * z[r * (2 * FF) + FF + j];
}
__global__ void k_add_scaled(float* h, const float* y, float sc, size_t n) {
    const size_t i = (size_t)blockIdx.x * blockDim.x + threadIdx.x;
    if (i < n) h[i] += sc * y[i];
}
__global__ __launch_bounds__(256) void k_gelu_ln(const float* z, const float* ln_g, const float* ln_b, float* u, float* vg, int rows) {
    const int wid = blockIdx.x * 4 + (threadIdx.x >> 6), lane = threadIdx.x & 63;
    const int row = wid >> 2, g = wid & 3;
    if (row >= rows) return;
    const float* zr = z + (size_t)row * IN_EVEN;
    const int c0 = g * 128 + lane * 2;
    u[(size_t)row * WA + c0] = gelu_tanh(zr[c0]); u[(size_t)row * WA + c0 + 1] = gelu_tanh(zr[c0 + 1]);
    const float v0 = gelu_tanh(zr[WA + c0]), v1 = gelu_tanh(zr[WA + c0 + 1]);
    const float mu = wave_sum(v0 + v1) * (1.0f / 128.0f);
    const float d0 = v0 - mu, d1 = v1 - mu;
    const float var = wave_sum(d0 * d0 + d1 * d1) * (1.0f / 128.0f);
    const float r = 1.0f / sqrtf(var + LN_EPS);
    vg[(size_t)row * WA + c0] = d0 * r * ln_g[c0] + ln_b[c0];
    vg[(size_t)row * WA + c0 + 1] = d1 * r * ln_g[c0 + 1] + ln_b[c0 + 1];
}
__global__ void k_gate(const float* u, const float* mixed, const float* b_s, float* ycat, int rows) {
    const size_t i = (size_t)blockIdx.x * blockDim.x + threadIdx.x;
    if (i >= (size_t)rows * WA) return;
    const int r = (int)(i / WA), c = (int)(i % WA), g = c >> 7;
    ycat[(size_t)r * D + c] = u[i] * (mixed[i] + b_s[g * CHUNK + (r % CHUNK)]);
}
__global__ void k_shortconv(const float* z, const float* w, float* ycat, int rows) {
    const size_t i = (size_t)blockIdx.x * blockDim.x + threadIdx.x;
    if (i >= (size_t)rows * WB) return;
    const int r = (int)(i / WB), c = (int)(i % WB);
    float acc = 0.f;
#pragma unroll
    for (int k = 0; k < 3; ++k) {
        const int tt = r - 2 + k;
        if (tt >= 0) { const float* zr = z + (size_t)tt * IN_EVEN + 2 * WA; acc += w[k * WB + c] * (zr[WB + c] * zr[2 * WB + c]); }
    }
    ycat[(size_t)r * D + WA + c] = z[(size_t)r * IN_EVEN + 2 * WA + c] * acc;
}
__global__ void k_pool(const float* z, float* pooled, int rows) {
    const size_t i = (size_t)blockIdx.x * blockDim.x + threadIdx.x;
    if (i >= (size_t)rows * WC) return;
    const int r = (int)(i / WC), c = (int)(i % WC), win = 2 << (c >> 7);
    const int cnt = (r + 1 < win) ? (r + 1) : win;
    float s = 0.f;
    for (int k = 0; k < cnt; ++k) s += z[(size_t)(r - k) * IN_ODD + c];
    pooled[i] = s / (float)cnt - z[(size_t)r * IN_ODD + c];
}
__global__ void k_colscale_to(const float* src, const float* sc, float* ycat, int rows) {
    const size_t i = (size_t)blockIdx.x * blockDim.x + threadIdx.x;
    if (i >= (size_t)rows * WC) return;
    const int r = (int)(i / WC), c = (int)(i % WC);
    ycat[(size_t)r * D + c] = src[i] * sc[c];
}
__global__ void k_glu(const float* z, float* s, int rows) {
    const size_t i = (size_t)blockIdx.x * blockDim.x + threadIdx.x;
    if (i >= (size_t)rows * WD) return;
    const int r = (int)(i / WD), c = (int)(i % WD);
    s[i] = z[(size_t)r * IN_ODD + WC + c] * sigmoidf_(z[(size_t)r * IN_ODD + WC + WD + c]);
}
__global__ __launch_bounds__(512) void k_conv_ln_silu(const float* s, const float* cw, const float* cb, const float* ln_g, const float* ln_b, float* ycat, int rows) {
    __shared__ float red[8];
    __shared__ float red2[8];
    const int r = blockIdx.x, c = threadIdx.x;
    float acc = cb[c];
    for (int k = 0; k < 31; ++k) { const int tt = r - 30 + k; if (tt >= 0) acc += cw[k * WD + c] * s[(size_t)tt * WD + c]; }
    float ws = wave_sum(acc);
    if ((c & 63) == 0) red[c >> 6] = ws;
    __syncthreads();
    float mu = 0.f;
#pragma unroll
    for (int i = 0; i < 8; ++i) mu += red[i];
    mu *= (1.0f / 512.0f);
    const float d = acc - mu;
    float wq = wave_sum(d * d);
    if ((c & 63) == 0) red2[c >> 6] = wq;
    __syncthreads();
    float var = 0.f;
#pragma unroll
    for (int i = 0; i < 8; ++i) var += red2[i];
    var *= (1.0f / 512.0f);
    const float y = d * (1.0f / sqrtf(var + LN_EPS)) * ln_g[c] + ln_b[c];
    ycat[(size_t)r * D + WC + c] = siluf_(y);
}
__global__ void k_ple(float* h, const float* gz, const float* pu, size_t n) {
    const size_t i = (size_t)blockIdx.x * blockDim.x + threadIdx.x;
    if (i < n) h[i] += sigmoidf_(gz[i]) * pu[i];
}


static unsigned short* g_snap = nullptr; static int g_snap_i = 0;
__global__ void k_snap(const float* h, unsigned short* o, size_t n) { const size_t i = (size_t)blockIdx.x * blockDim.x + threadIdx.x; if (i < n) { unsigned u = __float_as_uint(h[i]); u += 0x7fffu + ((u >> 16) & 1u); o[i] = (unsigned short)(u >> 16); } }
static void snap_hook(hipStream_t st, const float* h, int S) { if (!g_snap) return; const size_t n = (size_t)S * 1024; hipLaunchKernelGGL(k_snap, dim3((unsigned)((n + 255) / 256)), dim3(256), 0, st, h, g_snap + (size_t)g_snap_i * n, n); ++g_snap_i; }
struct In {
    const float *x, *p, *ffn1_norm, *ffn1_w_gu, *ffn1_w_down, *mix_norm, *ffn2_norm, *ffn2_w_gu, *ffn2_w_down, *ple_norm, *ple_w_gate, *ple_w_up,
        *ab_w_in, *gm_ln_g, *gm_ln_b, *gm_w_s, *gm_b_s, *sc_w, *ab_w_out, *cd_w_in, *pool_w, *pool_scale, *cv_w, *cv_b, *cv_ln_g, *cv_ln_b, *cd_w_out, *final_norm;
};

static void gemm(hipStream_t st, const float* A, const float* B, float* C, int M, int N, int K, int lda, int ldb, int ldc,
                 int nb1 = 1, long sA1 = 0, long sB1 = 0, long sC1 = 0, int nb2 = 1, long sA2 = 0, long sB2 = 0, long sC2 = 0, int tril = 0) {
    GemmP p{A, B, C, M, N, K, lda, ldb, ldc, sA1, sB1, sC1, sA2, sB2, sC2, nb2, tril};
    hipLaunchKernelGGL(k_gemm, dim3(N / 64, M / 64, nb1 * nb2), dim3(256), 0, st, p);
}
static inline unsigned nblk(size_t n, int b) { return (unsigned)((n + b - 1) / b); }

static void forward_slab(hipStream_t st, const In& in, const float* p_slab0, const float* p_slab1, float* h, float* out, float* tmp, int S) {
    float* xn = tmp;
    float* z = xn + (size_t)S * D;
    float* t = z + (size_t)S * 2 * FF;
    float* y = t + (size_t)S * FF;
    float* ycat = y + (size_t)S * D;
    float* gz = ycat + (size_t)S * D;
    float* b0 = gz + (size_t)S * D;
    float* b1 = b0 + (size_t)S * 512; float* b2 = b1 + (size_t)S * 512; float* b3 = b2 + (size_t)S * 512;
    const size_t nh = (size_t)S * D;
    for (int i = 0; i < 2; ++i) {
        hipLaunchKernelGGL(k_rmsnorm, dim3(S / 4), dim3(256), 0, st, h, in.ffn1_norm + i * D, xn, S);
        gemm(st, xn, in.ffn1_w_gu + (size_t)i * D * 2 * FF, z, S, 2 * FF, D, D, 2 * FF, 2 * FF);
        hipLaunchKernelGGL(k_swiglu, dim3(nblk((size_t)S * FF, 256)), dim3(256), 0, st, z, t, S);
        gemm(st, t, in.ffn1_w_down + (size_t)i * FF * D, y, S, D, FF, FF, D, D);
        hipLaunchKernelGGL(k_add_scaled, dim3(nblk(nh, 256)), dim3(256), 0, st, h, y, 0.5f, nh);
        snap_hook(st, h, S);
        hipLaunchKernelGGL(k_rmsnorm, dim3(S / 4), dim3(256), 0, st, h, in.mix_norm + i * D, xn, S);
        if (i == 0) {
            gemm(st, xn, in.ab_w_in, z, S, IN_EVEN, D, D, IN_EVEN, IN_EVEN);
            float *u = b0, *vg = b1, *mixed = b2;
            hipLaunchKernelGGL(k_gelu_ln, dim3(S), dim3(256), 0, st, z, in.gm_ln_g, in.gm_ln_b, u, vg, S);
            gemm(st, in.gm_w_s, vg, mixed, CHUNK, 128, CHUNK, CHUNK, WA, WA, S / CHUNK, 0, (long)CHUNK * WA, (long)CHUNK * WA, 4, (long)CHUNK * CHUNK, 128, 128, 1);
            hipLaunchKernelGGL(k_gate, dim3(nblk((size_t)S * WA, 256)), dim3(256), 0, st, u, mixed, in.gm_b_s, ycat, S);
            hipLaunchKernelGGL(k_shortconv, dim3(nblk((size_t)S * WB, 256)), dim3(256), 0, st, z, in.sc_w, ycat, S);
            gemm(st, ycat, in.ab_w_out, y, S, D, D, D, D, D);
        } else {
            gemm(st, xn, in.cd_w_in, z, S, IN_ODD, D, D, IN_ODD, IN_ODD);
            float *pooled = b0, *ycr = b1, *sg = b2;
            hipLaunchKernelGGL(k_pool, dim3(nblk((size_t)S * WC, 256)), dim3(256), 0, st, z, pooled, S);
            gemm(st, pooled, in.pool_w, ycr, S, 128, 128, WC, 128, WC, 4, 128, 128L * 128, 128);
            hipLaunchKernelGGL(k_colscale_to, dim3(nblk((size_t)S * WC, 256)), dim3(256), 0, st, ycr, in.pool_scale, ycat, S);
            hipLaunchKernelGGL(k_glu, dim3(nblk((size_t)S * WD, 256)), dim3(256), 0, st, z, sg, S);
            hipLaunchKernelGGL(k_conv_ln_silu, dim3(S), dim3(512), 0, st, sg, in.cv_w, in.cv_b, in.cv_ln_g, in.cv_ln_b, ycat, S);
            gemm(st, ycat, in.cd_w_out, y, S, D, D, D, D, D);
        }
        hipLaunchKernelGGL(k_add_scaled, dim3(nblk(nh, 256)), dim3(256), 0, st, h, y, 1.0f, nh);
        snap_hook(st, h, S);
        hipLaunchKernelGGL(k_rmsnorm, dim3(S / 4), dim3(256), 0, st, h, in.ffn2_norm + i * D, xn, S);
        gemm(st, xn, in.ffn2_w_gu + (size_t)i * D * 2 * FF, z, S, 2 * FF, D, D, 2 * FF, 2 * FF);
        hipLaunchKernelGGL(k_swiglu, dim3(nblk((size_t)S * FF, 256)), dim3(256), 0, st, z, t, S);
        gemm(st, t, in.ffn2_w_down + (size_t)i * FF * D, y, S, D, FF, FF, D, D);
        hipLaunchKernelGGL(k_add_scaled, dim3(nblk(nh, 256)), dim3(256), 0, st, h, y, 0.5f, nh);
        snap_hook(st, h, S);
        hipLaunchKernelGGL(k_rmsnorm, dim3(S / 4), dim3(256), 0, st, h, in.ple_norm + i * D, xn, S);
        gemm(st, xn, in.ple_w_gate + (size_t)i * D * D, gz, S, D, D, D, D, D);
        gemm(st, i == 0 ? p_slab0 : p_slab1, in.ple_w_up + (size_t)i * PLE * D, y, S, D, PLE, PLE, D, D);
        hipLaunchKernelGGL(k_ple, dim3(nblk(nh, 256)), dim3(256), 0, st, h, gz, y, nh);
        snap_hook(st, h, S);
    }
    hipLaunchKernelGGL(k_rmsnorm, dim3(S / 4), dim3(256), 0, st, h, in.final_norm, out, S);
}
}
#endif

#if DBG
__global__ void k_dbg_report(const float* res, float* out) {
    if (threadIdx.x != 0 || blockIdx.x != 0) return;
    for (int cp = 0; cp < 8; ++cp) { const float e2 = res[2 * cp], r2 = res[2 * cp + 1]; const float rel = sqrtf(e2 / fmaxf(r2, 1e-30f));
        if (!(rel < DBG_THR)) { int d = (int)(rel * 10.0f); if (d > 9 || !(rel == rel)) d = 9; if (d < 0) d = 0; out[0] = 1000.0f * (float)(cp + 1) + 100.0f * (float)d; return; } }
}
#endif

extern "C" void kernel_launch(void* const* d_in, const int* in_sizes, int n_in, void* d_out, int out_size, void* d_ws, size_t ws_size, hipStream_t stream) {
    using namespace mk;
    static int grid = 0;
    if (grid == 0) {
        const size_t need = DBG ? WS_SNAP + (size_t)8 * DBG_NT * D * 2 : WS_END;
        if (n_in != 28 || in_sizes[0] != M * D || out_size != M * D || ws_size < need) { fprintf(stderr, "kernel_launch: unexpected problem (n_in %d, in0 %d, out %d, ws %zu < %zu); nothing launched\n", n_in, n_in > 0 ? in_sizes[0] : -1, out_size, ws_size, need); grid = -1; return; }
        int dev = 0, cus = 0, per_cu = 0;
        if (hipGetDevice(&dev) != hipSuccess || hipDeviceGetAttribute(&cus, hipDeviceAttributeMultiprocessorCount, dev) != hipSuccess) { grid = -1; return; }
        if (hipFuncSetAttribute((const void*)mk_fwd, hipFuncAttributeMaxDynamicSharedMemorySize, LDS_BYTES) != hipSuccess) { fprintf(stderr, "kernel_launch: hipFuncSetAttribute failed\n"); grid = -1; return; }
        if (hipOccupancyMaxActiveBlocksPerMultiprocessor(&per_cu, (const void*)mk_fwd, NTHREADS, LDS_BYTES) != hipSuccess || per_cu < 1) { fprintf(stderr, "kernel_launch: occupancy query failed (%d)\n", per_cu); (void)hipGetLastError(); grid = -1; return; }
        grid = cus * 1;
        fprintf(stderr, "kernel_launch: grid %d (cus %d, occupancy %d/CU), ws %zu\n", grid, cus, per_cu, ws_size);
    }
    if (grid < 0) return;
    (void)hipMemsetAsync((char*)d_ws + WS_CTL, 0, CTL_BYTES, stream);
    Args a{};
    for (int i = 0; i < 28; ++i) a.in[i] = (const float*)d_in[i];
    a.out = (float*)d_out; a.ws = (unsigned char*)d_ws; a.dbg = DBG; a.pad = 0;
#if DBG
    {
        v0::In in; const float** f = (const float**)&in; for (int i = 0; i < 28; ++i) f[i] = (const float*)d_in[i];
        float* href = (float*)((char*)d_ws + WS_Y); float* tmp = (float*)((char*)d_ws + WS_T);
        (void)hipMemcpyAsync(href, in.x, (size_t)DBG_NT * D * sizeof(float), hipMemcpyDeviceToDevice, stream);
        v0::g_snap = (unsigned short*)((char*)d_ws + WS_SNAP); v0::g_snap_i = 0;
        v0::forward_slab(stream, in, in.p, in.p + (size_t)v0::BATCH * v0::SEQ * v0::PLE, href, href, tmp, DBG_NT);
    }
#endif
    void* args[] = {&a};
    const hipError_t e = hipLaunchCooperativeKernel((const void*)mk_fwd, dim3(grid), dim3(NTHREADS), args, LDS_BYTES, stream);
    if (e != hipSuccess) fprintf(stderr, "kernel_launch: cooperative launch failed: %s (grid %d)\n", hipGetErrorString(e), grid);
#if DBG
    hipLaunchKernelGGL(k_dbg_report, dim3(1), dim3(64), 0, stream, (const float*)((char*)d_ws + WS_DBG), (float*)d_out);
#endif
}
```

```cpp
#define PROBE 0
#include <hip/hip_runtime.h>
#include <hip/hip_cooperative_groups.h>
#include <cstdio>
#include <cstdint>
namespace cg = cooperative_groups;

#ifndef DBG
#define DBG 0
#endif
#ifndef GP_SP2
#define GP_SP2 true
#endif
#ifndef GP_ALIGN
#define GP_ALIGN true
#endif
#ifndef DBG_THR
#define DBG_THR 0.03f
#endif
#ifndef PROBE
#define PROBE 0
#endif
#ifndef STAMPS
#define STAMPS 0
#endif
#ifndef GP_TIME
#define GP_TIME 0
#endif

namespace pg8 {
#define PG8_LAS __attribute__((address_space(3)))
typedef unsigned short bf16_t;
typedef short bf16x8 __attribute__((ext_vector_type(8)));
typedef float f32x4 __attribute__((ext_vector_type(4)));
typedef unsigned u32x4 __attribute__((ext_vector_type(4)));
typedef unsigned u32x2 __attribute__((ext_vector_type(2)));
constexpr int BM = 256, BK = 64, HALF = 128, HTB = HALF * BK * 2  , STAGE_BYTES = 8 * HTB, NXCD = 8, WGM = 8;

__host__ __device__ __forceinline__ int lds_byte(int r, int c) { const int st = (r >> 4) * 2 + (c >> 5), rr = r & 15, cc = c & 31, ob = rr * 64 + cc * 2; return st * 1024 + (ob ^ (((ob >> 9) & 1) << 5)); }
__host__ __device__ __forceinline__ void stage_rc(int b, int& R, int& C) { const int st = b / 1024, sb = b % 1024, swz = sb ^ (((sb >> 9) & 1) << 5); R = (st >> 1) * 16 + swz / 64; C = (st & 1) * 32 + (swz % 64) / 2; }
__host__ __device__ __forceinline__ int perm32(int rho) { const int n = rho >> 4, i = rho & 15; return 8 * (i >> 2) + 4 * n + (i & 3); }

struct Unit { int pm, pn; };
struct Gemm { const bf16_t* A; const bf16_t* Bt; int M, N, K; };

struct StaticOrder {
    int nM, nN, nwg, G, c;
    __host__ __device__ void init(int M, int N, int G_, int c_) { nM = M / BM; nN = N / BM; nwg = nM * nN; G = G_; c = c_; }
    __host__ __device__ bool next(int i, Unit& u) const {
        const long L = (long)i * G + c; if (L >= nwg) return false;
        int wgid = (int)L; { const int q = nwg / NXCD, r = nwg % NXCD, xcd = wgid % NXCD, off = wgid / NXCD; wgid = (xcd < r ? xcd * (q + 1) : r * (q + 1) + (xcd - r) * q) + off; }
        const int nig = WGM * nN, gid = wgid / nig, fm = gid * WGM, gsz = (nM - fm) < WGM ? (nM - fm) : WGM;
        u.pm = fm + ((wgid % nig) % gsz); u.pn = (wgid % nig) / gsz; return true;
    }
    __device__ __forceinline__ void a_ready(const Unit&) const {}
    __device__ __forceinline__ void done(const Unit&) const {}
};

__device__ __forceinline__ unsigned cvt_pk_bf16(float lo, float hi) { unsigned r; asm volatile("v_cvt_pk_bf16_f32 %0, %1, %2" : "=v"(r) : "v"(lo), "v"(hi)); return r; }
__device__ __forceinline__ float bf_lo(unsigned w) { return __uint_as_float(w << 16); }
__device__ __forceinline__ float bf_hi(unsigned w) { return __uint_as_float(w & 0xffff0000u); }
__device__ __forceinline__ float fsigmoid(float x) { return __builtin_amdgcn_rcpf(1.0f + __builtin_amdgcn_exp2f(-1.4426950408889634f * x)); }
__device__ __forceinline__ float fsilu(float x) { return x * fsigmoid(x); }
__device__ __forceinline__ float fgelu_tanh(float x) { return x * fsigmoid(1.5957691216057308f * (x + 0.044715f * x * x * x)); }
__device__ __forceinline__ float rstd_of(float ss) { return __builtin_amdgcn_rsqf(ss * (1.0f / 1024.0f) + 1e-6f); }
template <int MASK> __device__ __forceinline__ float add_xor(float v) { return v + __int_as_float(__builtin_amdgcn_ds_swizzle(__float_as_int(v), (MASK << 10) | 0x1f)); }
__device__ __forceinline__ float add_xor32(float v) { const auto r = __builtin_amdgcn_permlane32_swap(__float_as_uint(v), __float_as_uint(v), false, false); return __uint_as_float(r[0]) + __uint_as_float(r[1]); }
__device__ __forceinline__ u32x4 pack8(const f32x4& a, const f32x4& b) { u32x4 w; w.x = cvt_pk_bf16(a[0], a[1]); w.y = cvt_pk_bf16(a[2], a[3]); w.z = cvt_pk_bf16(b[0], b[1]); w.w = cvt_pk_bf16(b[2], b[3]); return w; }

constexpr int DM = 1024, DFF = 2816;

struct EpiSwiglu {
    static constexpr bool PERM = true, AFTER_DRAIN = false;
    bf16_t* T; const float* rowss;
    __device__ __forceinline__ void operator()(const f32x4 (&acc)[2][2][4][2], const Unit& u, int wr, int wc, int fr, int fq) const {
        const int row0 = u.pm * BM + wr * 64 + fr, col0 = u.pn * 128 + wc * 32 + 8 * fq;
        float rs[2][4];
#pragma unroll
        for (int ai = 0; ai < 2; ++ai)
#pragma unroll
            for (int m = 0; m < 4; ++m) rs[ai][m] = rstd_of(rowss[row0 + ai * HALF + m * 16]);
#pragma unroll
        for (int ai = 0; ai < 2; ++ai)
#pragma unroll
            for (int m = 0; m < 4; ++m) {
                const int r = row0 + ai * HALF + m * 16; const float s = rs[ai][m];
                f32x4 t0, t1;
#pragma unroll
                for (int j = 0; j < 4; ++j) { t0[j] = fsilu(acc[ai][0][m][0][j] * s) * (acc[ai][1][m][0][j] * s); t1[j] = fsilu(acc[ai][0][m][1][j] * s) * (acc[ai][1][m][1][j] * s); }
                *(u32x4*)(T + (size_t)r * DFF + col0) = pack8(t0, t1);
            }
    }
};
template <bool DRY> struct EpiResT {
    static constexpr bool PERM = true, AFTER_DRAIN = false;
    const float* base; float* out; bf16_t* hb; float* rowss_out; float scale;
    __device__ __forceinline__ void operator()(const f32x4 (&acc)[2][2][4][2], const Unit& u, int wr, int wc, int fr, int fq) const {
        const int row0 = u.pm * BM + wr * 64 + fr, col0 = u.pn * BM + wc * 32 + 8 * fq;
#pragma unroll
        for (int ai = 0; ai < 2; ++ai)
#pragma unroll
            for (int m = 0; m < 4; ++m) {
                const int r = row0 + ai * HALF + m * 16; const size_t off = (size_t)r * DM + col0;
                const f32x4 b00 = *(const f32x4*)(base + off), b01 = *(const f32x4*)(base + off + 4), b10 = *(const f32x4*)(base + off + HALF), b11 = *(const f32x4*)(base + off + HALF + 4);
                const f32x4 o00 = b00 + acc[ai][0][m][0] * scale, o01 = b01 + acc[ai][0][m][1] * scale, o10 = b10 + acc[ai][1][m][0] * scale, o11 = b11 + acc[ai][1][m][1] * scale;
                if (!DRY) { *(f32x4*)(out + off) = o00; *(f32x4*)(out + off + 4) = o01; *(f32x4*)(out + off + HALF) = o10; *(f32x4*)(out + off + HALF + 4) = o11;
                    *(u32x4*)(hb + off) = pack8(o00, o01); *(u32x4*)(hb + off + HALF) = pack8(o10, o11); }
                float ss = 0.f;
#pragma unroll
                for (int j = 0; j < 4; ++j) ss += o00[j] * o00[j] + o01[j] * o01[j] + o10[j] * o10[j] + o11[j] * o11[j];
                ss = add_xor32(add_xor<16>(ss));
                if (!DRY) { if (fq == 0) atomicAdd(rowss_out + r, ss); } else asm volatile("" :: "v"(ss));
                asm volatile("" ::: "memory");
            }
    }
};
typedef EpiResT<false> EpiRes; typedef EpiResT<true> EpiResDry;
template <bool DRY> struct EpiPleT {
    static constexpr bool PERM = true, AFTER_DRAIN = false;
    const float* rowss_in; const bf16_t* PU; float* h; bf16_t* hb; float* rowss_out;
    __device__ __forceinline__ void operator()(const f32x4 (&acc)[2][2][4][2], const Unit& u, int wr, int wc, int fr, int fq) const {
        const int row0 = u.pm * BM + wr * 64 + fr, col0 = u.pn * BM + wc * 32 + 8 * fq;
#pragma unroll
        for (int ai = 0; ai < 2; ++ai)
#pragma unroll
            for (int m = 0; m < 4; ++m) {
                const int r = row0 + ai * HALF + m * 16; const size_t off = (size_t)r * DM + col0;
                const float s = rstd_of(rowss_in[r]);
                const u32x4 p0 = *(const u32x4*)(PU + off), p1 = *(const u32x4*)(PU + off + HALF);
                const f32x4 b00 = *(const f32x4*)(h + off), b01 = *(const f32x4*)(h + off + 4), b10 = *(const f32x4*)(h + off + HALF), b11 = *(const f32x4*)(h + off + HALF + 4);
                const f32x4 q00 = {bf_lo(p0.x), bf_hi(p0.x), bf_lo(p0.y), bf_hi(p0.y)}, q01 = {bf_lo(p0.z), bf_hi(p0.z), bf_lo(p0.w), bf_hi(p0.w)};
                const f32x4 q10 = {bf_lo(p1.x), bf_hi(p1.x), bf_lo(p1.y), bf_hi(p1.y)}, q11 = {bf_lo(p1.z), bf_hi(p1.z), bf_lo(p1.w), bf_hi(p1.w)};
                f32x4 o00, o01, o10, o11;
#pragma unroll
                for (int j = 0; j < 4; ++j) {
                    o00[j] = b00[j] + fsigmoid(acc[ai][0][m][0][j] * s) * q00[j]; o01[j] = b01[j] + fsigmoid(acc[ai][0][m][1][j] * s) * q01[j];
                    o10[j] = b10[j] + fsigmoid(acc[ai][1][m][0][j] * s) * q10[j]; o11[j] = b11[j] + fsigmoid(acc[ai][1][m][1][j] * s) * q11[j]; }
                if (!DRY) { *(f32x4*)(h + off) = o00; *(f32x4*)(h + off + 4) = o01; *(f32x4*)(h + off + HALF) = o10; *(f32x4*)(h + off + HALF + 4) = o11; }
                else asm volatile("" :: "v"(o00), "v"(o01), "v"(o10), "v"(o11));
                if (!DRY && hb) {
                    *(u32x4*)(hb + off) = pack8(o00, o01); *(u32x4*)(hb + off + HALF) = pack8(o10, o11);
                    float ss = 0.f;
#pragma unroll
                    for (int j = 0; j < 4; ++j) ss += o00[j] * o00[j] + o01[j] * o01[j] + o10[j] * o10[j] + o11[j] * o11[j];
                    ss = add_xor32(add_xor<16>(ss));
                    if (fq == 0) atomicAdd(rowss_out + r, ss);
                }
                asm volatile("" ::: "memory");
            }
    }
};
typedef EpiPleT<false> EpiPle; typedef EpiPleT<true> EpiPleDry;
struct EpiPlain {
    static constexpr bool PERM = true, AFTER_DRAIN = false;
    bf16_t* O;
    __device__ __forceinline__ void operator()(const f32x4 (&acc)[2][2][4][2], const Unit& u, int wr, int wc, int fr, int fq) const {
        const int row0 = u.pm * BM + wr * 64 + fr, col0 = u.pn * BM + wc * 32 + 8 * fq;
#pragma unroll
        for (int ai = 0; ai < 2; ++ai)
#pragma unroll
            for (int m = 0; m < 4; ++m) {
                const size_t off = (size_t)(row0 + ai * HALF + m * 16) * DM + col0;
                *(u32x4*)(O + off) = pack8(acc[ai][0][m][0], acc[ai][0][m][1]); *(u32x4*)(O + off + HALF) = pack8(acc[ai][1][m][0], acc[ai][1][m][1]);
            }
    }
};
struct EpiMix0 {
    static constexpr bool PERM = true, AFTER_DRAIN = false;
    const float* rowss; bf16_t *UV, *Q, *BG;
    __device__ __forceinline__ void operator()(const f32x4 (&acc)[2][2][4][2], const Unit& u, int wr, int wc, int fr, int fq) const {
        const int row0 = u.pm * BM + wr * 64 + fr, cw = wc * 32 + 8 * fq;
#pragma unroll
        for (int ai = 0; ai < 2; ++ai)
#pragma unroll
            for (int m = 0; m < 4; ++m) {
                const int r = row0 + ai * HALF + m * 16; const float s = rstd_of(rowss[r]);
                if (u.pn < 4) {
                    f32x4 a0, a1, b0, b1;
#pragma unroll
                    for (int j = 0; j < 4; ++j) { a0[j] = fgelu_tanh(acc[ai][0][m][0][j] * s); a1[j] = fgelu_tanh(acc[ai][0][m][1][j] * s); b0[j] = fgelu_tanh(acc[ai][1][m][0][j] * s); b1[j] = fgelu_tanh(acc[ai][1][m][1][j] * s); }
                    bf16_t* p = UV + (size_t)r * 1024 + u.pn * 256 + cw; *(u32x4*)p = pack8(a0, a1); *(u32x4*)(p + HALF) = pack8(b0, b1);
                } else if (u.pn < 8) {
                    const float s2 = s * s; f32x4 q0 = acc[ai][0][m][0] * acc[ai][1][m][0] * s2, q1 = acc[ai][0][m][1] * acc[ai][1][m][1] * s2;
                    *(u32x4*)(Q + (size_t)r * 512 + (u.pn - 4) * 128 + cw) = pack8(q0, q1);
                } else {
                    bf16_t* p = BG + (size_t)r * 512 + (u.pn - 8) * 256 + cw;
                    *(u32x4*)p = pack8(acc[ai][0][m][0] * s, acc[ai][0][m][1] * s); *(u32x4*)(p + HALF) = pack8(acc[ai][1][m][0] * s, acc[ai][1][m][1] * s);
                }
            }
    }
};
struct EpiMix1 {
    static constexpr bool PERM = true, AFTER_DRAIN = false;
    const float* rowss; bf16_t *ZC, *S;
    __device__ __forceinline__ void operator()(const f32x4 (&acc)[2][2][4][2], const Unit& u, int wr, int wc, int fr, int fq) const {
        const int row0 = u.pm * BM + wr * 64 + fr, cw = wc * 32 + 8 * fq;
#pragma unroll
        for (int ai = 0; ai < 2; ++ai)
#pragma unroll
            for (int m = 0; m < 4; ++m) {
                const int r = row0 + ai * HALF + m * 16; const float s = rstd_of(rowss[r]);
                if (u.pn < 2) {
                    bf16_t* p = ZC + (size_t)r * 512 + u.pn * 256 + cw;
                    *(u32x4*)p = pack8(acc[ai][0][m][0] * s, acc[ai][0][m][1] * s); *(u32x4*)(p + HALF) = pack8(acc[ai][1][m][0] * s, acc[ai][1][m][1] * s);
                } else {
                    f32x4 q0, q1;
#pragma unroll
                    for (int j = 0; j < 4; ++j) { q0[j] = acc[ai][0][m][0][j] * s * fsigmoid(acc[ai][1][m][0][j] * s); q1[j] = acc[ai][0][m][1][j] * s * fsigmoid(acc[ai][1][m][1][j] * s); }
                    *(u32x4*)(S + (size_t)r * 512 + (u.pn - 2) * 128 + cw) = pack8(q0, q1);
                }
            }
    }
};

template <class Epi, class Sched, bool ALIGN_EPI = false, bool SP2 = false>
__device__ __forceinline__ void gemm_phase(PG8_LAS unsigned char* lds, const Gemm g, const Sched& S, const Epi& E, const int wave_s  ) {
    int tid_; asm volatile("v_mbcnt_lo_u32_b32 %0, -1, 0\n\tv_mbcnt_hi_u32_b32 %0, -1, %0" : "=v"(tid_)); tid_ |= wave_s << 6;
    const int tid = tid_, wid = wave_s, lane = tid & 63, wr = wid >> 2, wc = wid & 3, fr = lane & 15, fq = lane >> 4;
    const int K = g.K, nt = K / BK;
    unsigned voffA[2], voffB[2];
#pragma unroll
    for (int i = 0; i < 2; ++i) { int R, C; stage_rc(tid * 16 + i * 8192, R, C); const int Rb = Epi::PERM ? ((R & ~31) + perm32(R & 31)) : R;
        voffA[i] = (unsigned)(R * K + C) * 2u; voffB[i] = (unsigned)(Rb * K + C) * 2u; }
    const size_t kstep = (size_t)(BK * 2);
    const size_t hstep = (size_t)HALF * K * 2;
    const size_t tstep = 2 * hstep;
    const unsigned ldsw = (unsigned)wid * 1024u;
    const int aoff = lds_byte(wr * 64 + fr, fq * 8), boff = lds_byte(wc * 32 + fr, fq * 8);
#define PG8_SA(b, h) (((b) * 2 + (h)) * HTB)
#define PG8_SB(b, h) ((4 + (b) * 2 + (h)) * HTB)
#define PG8_STAGE(bufoff, gbase, voff) do { _Pragma("unroll") for (int _i = 0; _i < 2; ++_i) \
        __builtin_amdgcn_global_load_lds((const unsigned*)((const char*)(gbase) + (voff)[_i]), (PG8_LAS unsigned*)(lds + (bufoff) + ldsw + _i * 8192), 16, 0, 0); } while (0)
#define PG8_LDA(dst, b, h) do { _Pragma("unroll") for (int m = 0; m < 4; ++m) _Pragma("unroll") for (int k = 0; k < 2; ++k) dst[m][k] = *(const PG8_LAS bf16x8*)(lds + PG8_SA(b, h) + aoff + m * 2048 + k * 1024); } while (0)
#define PG8_LDB(dst, b, h) do { _Pragma("unroll") for (int n = 0; n < 2; ++n) _Pragma("unroll") for (int k = 0; k < 2; ++k) dst[n][k] = *(const PG8_LAS bf16x8*)(lds + PG8_SB(b, h) + boff + n * 2048 + k * 1024); } while (0)
#define PG8_MMA(ai, bj, At, Bt) do { __builtin_amdgcn_s_setprio(1); _Pragma("unroll") for (int m = 0; m < 4; ++m) _Pragma("unroll") for (int n = 0; n < 2; ++n) _Pragma("unroll") for (int k = 0; k < 2; ++k) \
        acc[ai][bj][m][n] = __builtin_amdgcn_mfma_f32_16x16x32_bf16(Bt[n][k], At[m][k], acc[ai][bj][m][n], 0, 0, 0); __builtin_amdgcn_s_setprio(0); } while (0)
#define PG8_WAIT_V(n) asm volatile("s_waitcnt vmcnt(" #n ")" ::: "memory")
#define PG8_WAIT_L(n) asm volatile("s_waitcnt lgkmcnt(" #n ")" ::: "memory")
#define PG8_BAR __builtin_amdgcn_s_barrier()
#define PG8_SCHED __builtin_amdgcn_sched_barrier(0)
    Unit cur, nxt; int ui = 0;
    if (!S.next(0, cur)) return;
    f32x4 acc[2][2][4][2];
#pragma unroll
    for (int a = 0; a < 2; ++a)
#pragma unroll
        for (int b = 0; b < 2; ++b)
#pragma unroll
            for (int m = 0; m < 4; ++m)
#pragma unroll
                for (int n = 0; n < 2; ++n) acc[a][b][m][n] = (f32x4){0.f, 0.f, 0.f, 0.f};
    bf16x8 At[4][2], B0[2][2], B1[2][2];
    const char* cA = (const char*)g.A + (size_t)cur.pm * tstep; const char* cB = (const char*)g.Bt + (size_t)cur.pn * tstep;
    S.a_ready(cur);
    if constexpr (SP2) {
        PG8_STAGE(PG8_SB(0, 0), cB, voffB); PG8_STAGE(PG8_SB(0, 1), cB + hstep, voffB); PG8_STAGE(PG8_SA(0, 0), cA, voffA); PG8_STAGE(PG8_SA(0, 1), cA + hstep, voffA);
        if (wr == 1) PG8_BAR;
        PG8_WAIT_V(2); PG8_BAR;
        PG8_STAGE(PG8_SB(1, 0), cB + kstep, voffB); PG8_STAGE(PG8_SA(1, 0), cA + kstep, voffA); PG8_STAGE(PG8_SB(1, 1), cB + hstep + kstep, voffB);
        PG8_WAIT_V(6); PG8_BAR;
    } else {
        PG8_STAGE(PG8_SB(0, 0), cB, voffB); PG8_STAGE(PG8_SA(0, 0), cA, voffA); PG8_STAGE(PG8_SB(0, 1), cB + hstep, voffB); PG8_STAGE(PG8_SA(0, 1), cA + hstep, voffA);
        if (wr == 1) PG8_BAR;
        PG8_WAIT_V(4); PG8_BAR;
        PG8_STAGE(PG8_SB(1, 0), cB + kstep, voffB); PG8_STAGE(PG8_SA(1, 0), cA + kstep, voffA); PG8_STAGE(PG8_SB(1, 1), cB + hstep + kstep, voffB);
        PG8_WAIT_V(6); PG8_BAR;
    }
    for (;;) {
        const bool has_next = S.next(ui + 1, nxt);
        const char* nA = has_next ? (const char*)g.A + (size_t)nxt.pm * tstep : cA; const char* nB = has_next ? (const char*)g.Bt + (size_t)nxt.pn * tstep : cB;
        for (int t = 0; t < nt; t += 2) {
            const bool last = (t == nt - 2);
            const char* a1 = cA + (size_t)(t + 1) * kstep;
            const char* a2 = last ? nA : cA + (size_t)(t + 2) * kstep; const char* b2 = last ? nB : cB + (size_t)(t + 2) * kstep;
            const char* a3 = a2 + kstep; const char* b3 = b2 + kstep;
            if (last && has_next) S.a_ready(nxt);
            if constexpr (SP2) {
            PG8_LDB(B0, 0, 0); PG8_LDB(B1, 0, 1); PG8_SCHED; PG8_LDA(At, 0, 0); PG8_STAGE(PG8_SA(1, 1), a1 + hstep, voffA);
            PG8_WAIT_V(8); PG8_WAIT_L(0); PG8_BAR; PG8_MMA(0, 0, At, B0); PG8_MMA(0, 1, At, B1); PG8_BAR; PG8_SCHED;
            PG8_LDA(At, 0, 1); PG8_STAGE(PG8_SB(0, 0), b2, voffB); PG8_STAGE(PG8_SB(0, 1), b2 + hstep, voffB); PG8_STAGE(PG8_SA(0, 0), a2, voffA);
            PG8_WAIT_V(8); PG8_WAIT_L(0); PG8_BAR; PG8_MMA(1, 0, At, B0); PG8_MMA(1, 1, At, B1); PG8_BAR; PG8_SCHED;
            PG8_LDB(B0, 1, 0); PG8_LDB(B1, 1, 1); PG8_SCHED; PG8_LDA(At, 1, 0); PG8_STAGE(PG8_SA(0, 1), a2 + hstep, voffA);
            PG8_WAIT_V(8); PG8_WAIT_L(0); PG8_BAR; PG8_MMA(0, 0, At, B0); PG8_MMA(0, 1, At, B1); PG8_BAR; PG8_SCHED;
            PG8_LDA(At, 1, 1); PG8_STAGE(PG8_SB(1, 0), b3, voffB); PG8_STAGE(PG8_SB(1, 1), b3 + hstep, voffB); PG8_STAGE(PG8_SA(1, 0), a3, voffA);
            PG8_WAIT_V(8); PG8_WAIT_L(0); PG8_BAR; PG8_MMA(1, 0, At, B0); PG8_MMA(1, 1, At, B1); PG8_BAR; PG8_SCHED;
            } else {
            PG8_LDB(B0, 0, 0); PG8_SCHED; PG8_LDA(At, 0, 0); PG8_STAGE(PG8_SA(1, 1), a1 + hstep, voffA);
            PG8_WAIT_L(8); PG8_BAR; PG8_WAIT_L(0); PG8_MMA(0, 0, At, B0); PG8_BAR; PG8_SCHED;
            PG8_LDB(B1, 0, 1); PG8_STAGE(PG8_SB(0, 0), b2, voffB);
            PG8_BAR; PG8_WAIT_L(0); PG8_MMA(0, 1, At, B1); PG8_BAR;
            PG8_LDA(At, 0, 1); PG8_STAGE(PG8_SA(0, 0), a2, voffA);
            PG8_BAR; PG8_WAIT_L(0); PG8_MMA(1, 0, At, B0); PG8_BAR; PG8_SCHED;
            PG8_STAGE(PG8_SB(0, 1), b2 + hstep, voffB);
            PG8_WAIT_V(6); PG8_BAR; PG8_MMA(1, 1, At, B1); PG8_BAR;
            PG8_LDB(B0, 1, 0); PG8_SCHED; PG8_LDA(At, 1, 0); PG8_STAGE(PG8_SA(0, 1), a2 + hstep, voffA);
            PG8_WAIT_L(8); PG8_BAR; PG8_WAIT_L(0); PG8_MMA(0, 0, At, B0); PG8_BAR; PG8_SCHED;
            PG8_LDB(B1, 1, 1); PG8_STAGE(PG8_SB(1, 0), b3, voffB);
            PG8_BAR; PG8_WAIT_L(0); PG8_MMA(0, 1, At, B1); PG8_BAR;
            PG8_LDA(At, 1, 1); PG8_STAGE(PG8_SA(1, 0), a3, voffA);
            PG8_BAR; PG8_WAIT_L(0); PG8_MMA(1, 0, At, B0); PG8_BAR; PG8_SCHED;
            PG8_STAGE(PG8_SB(1, 1), b3 + hstep, voffB);
            PG8_WAIT_V(6); PG8_BAR; PG8_MMA(1, 1, At, B1); PG8_BAR;
            }
        }
        if constexpr (ALIGN_EPI) { if (wr == 0) PG8_BAR; }
        if constexpr (!Epi::AFTER_DRAIN) { int l_; asm volatile("v_mbcnt_lo_u32_b32 %0, -1, 0\n\tv_mbcnt_hi_u32_b32 %0, -1, %0" : "=v"(l_));
#if GP_TIME
            const unsigned long long te0_ = __builtin_amdgcn_s_memrealtime();
#endif
            E(acc, cur, wr, wc, l_ & 15, l_ >> 4); S.done(cur);
#if GP_TIME
            asm volatile("s_waitcnt vmcnt(0)" ::: "memory");
            if (wid == 0) { const unsigned long long te1_ = __builtin_amdgcn_s_memrealtime(); if ((tid & 63) == 0) *(PG8_LAS unsigned*)(lds + 131072 + 128) += (unsigned)(te1_ - te0_); }
#endif
            }
        if (!has_next) break;
#pragma unroll
        for (int a = 0; a < 2; ++a)
#pragma unroll
            for (int b = 0; b < 2; ++b)
#pragma unroll
                for (int m = 0; m < 4; ++m)
#pragma unroll
                    for (int n = 0; n < 2; ++n) acc[a][b][m][n] = (f32x4){0.f, 0.f, 0.f, 0.f};
        cur = nxt; cA = nA; cB = nB; ++ui;
        if constexpr (ALIGN_EPI) { if (wr == 1) PG8_BAR; }
    }
    PG8_WAIT_V(0);
    if constexpr (!ALIGN_EPI) { if (wr == 0) PG8_BAR; }
    PG8_BAR;
    if constexpr (Epi::AFTER_DRAIN) { E.fused(acc, cur, wr, wc, fr, fq, lds, wid, lane); S.done(cur); }
#undef PG8_SA
#undef PG8_SB
#undef PG8_STAGE
#undef PG8_LDA
#undef PG8_LDB
#undef PG8_MMA
#undef PG8_WAIT_V
#undef PG8_WAIT_L
#undef PG8_BAR
#undef PG8_SCHED
}
}

namespace mk {
using pg8::bf16_t; using pg8::bf16x8; using pg8::f32x4; using pg8::u32x4; using pg8::u32x2; using pg8::cvt_pk_bf16; using pg8::bf_lo; using pg8::bf_hi;
#define LAS __attribute__((address_space(3)))
#define LDS_WAIT() asm volatile("s_waitcnt lgkmcnt(0)" ::: "memory")
constexpr int M = 16384, D = 1024, FF = 2816, SEQ = 2048, PLE = 256;
constexpr int NWAVES = 8, NTHREADS = 512;
constexpr int LDS_BYTES = 147456;
constexpr size_t MiB = 1u << 20, HM = 512u * 1024u;
constexpr size_t WS_CTL = 0, CTL_BYTES = 2 * MiB;
constexpr size_t WS_BAR = 4096;
constexpr int LDSCTL_OFF = 131072;
constexpr size_t WS_DBG = 64 * 1024;
constexpr size_t WS_ROWSS = 1 * MiB;
constexpr size_t WS_W = 2 * MiB;
constexpr size_t W_GU1 = 0, W_D1 = 22 * HM, W_GU2 = 33 * HM, W_D2 = 55 * HM, W_GATE = 66 * HM, W_UP = 70 * HM, W_OUT = 71 * HM, W_IN = 75 * HM, WL_STRIDE = 85 * HM;
constexpr size_t WS_WTRIL = WS_W + 2 * WL_STRIDE;
constexpr size_t WS_HB = 88 * MiB;
constexpr size_t WS_T = 120 * MiB;
constexpr size_t WS_Y = 208 * MiB;
constexpr size_t WS_PB = 240 * MiB;
constexpr size_t WS_END = 256 * MiB;
constexpr size_t WS_SNAP = 256 * MiB;
constexpr int DBG_NT = 384;
static_assert(WS_WTRIL + 131072 <= WS_HB && WS_T + (size_t)M * FF * 2 <= WS_Y, "ws map");

struct Args { const float* in[28]; float* out; unsigned char* ws; int dbg; int pad; };
enum { I_X = 0, I_P, I_FFN1_NORM, I_FFN1_WGU, I_FFN1_WD, I_MIX_NORM, I_FFN2_NORM, I_FFN2_WGU, I_FFN2_WD, I_PLE_NORM, I_PLE_WG, I_PLE_WU, I_AB_WIN, I_GM_LNG, I_GM_LNB, I_GM_WS, I_GM_BS,
       I_SC_W, I_AB_WOUT, I_CD_WIN, I_POOL_W, I_POOL_SCALE, I_CV_W, I_CV_B, I_CV_LNG, I_CV_LNB, I_CD_WOUT, I_FINAL_NORM };

typedef const __attribute__((address_space(4))) unsigned char* kargp_t;
__device__ __forceinline__ kargp_t kargs() { kargp_t p = (kargp_t)__builtin_amdgcn_kernarg_segment_ptr(); asm volatile("" : "+s"(p)); return p; }
#define KIN(i) (*(const float* const __attribute__((address_space(4)))*)(kargs() + 8 * (i)))
#define KOUT (*(float* const __attribute__((address_space(4)))*)(kargs() + 8 * 28))
#define KWS (*(unsigned char* const __attribute__((address_space(4)))*)(kargs() + 8 * 29))
#define WSP(off) (KWS + (off))
#define ROWSS(k) ((float*)WSP(WS_ROWSS) + (size_t)(k) * M)
__device__ __forceinline__ int lane_id() { int l; asm volatile("v_mbcnt_lo_u32_b32 %0, -1, 0\n\tv_mbcnt_hi_u32_b32 %0, -1, %0" : "=v"(l)); return l; }
__device__ __forceinline__ int opaque_tid(int wave_s) { int t = (wave_s << 6) | lane_id(); asm volatile("" : "+v"(t)); return t; }
__device__ __forceinline__ float wave_sum(float v) { using pg8::add_xor; return pg8::add_xor32(add_xor<16>(add_xor<8>(add_xor<4>(add_xor<2>(add_xor<1>(v)))))); }
__device__ __forceinline__ void unpack8(const u32x4& w, float (&f)[8]) { f[0] = bf_lo(w.x); f[1] = bf_hi(w.x); f[2] = bf_lo(w.y); f[3] = bf_hi(w.y); f[4] = bf_lo(w.z); f[5] = bf_hi(w.z); f[6] = bf_lo(w.w); f[7] = bf_hi(w.w); }
__device__ __forceinline__ u32x4 pack8f(const float (&f)[8]) { u32x4 w; w.x = cvt_pk_bf16(f[0], f[1]); w.y = cvt_pk_bf16(f[2], f[3]); w.z = cvt_pk_bf16(f[4], f[5]); w.w = cvt_pk_bf16(f[6], f[7]); return w; }

__device__ __forceinline__ unsigned long long rt() { return __builtin_amdgcn_s_memrealtime(); }
#define XB_TMO      128
#define XB_XCNT(j)  (256  + 64 * (j))
#define XB_XSUB(j)  (1280 + 64 * (j))
#define XB_XGEN(j)  (2304 + 64 * (j))
#define XB_TOP      3328
#define XB_TOPGEN   3392
#define XCD_BAR_WORDS 3456
#define XB_SPIN_CAP (1u << 18)

__device__ __forceinline__ unsigned xb_ld(unsigned* p)              { return __hip_atomic_load(p, __ATOMIC_RELAXED, __HIP_MEMORY_SCOPE_AGENT); }
__device__ __forceinline__ unsigned xb_add(unsigned* p, unsigned v) { return __hip_atomic_fetch_add(p, v, __ATOMIC_RELAXED, __HIP_MEMORY_SCOPE_AGENT); }
__device__ __forceinline__ unsigned xb_xcc_id() { return (unsigned)__builtin_amdgcn_s_getreg((3 << 11) | 20) & 0xFu; }
#define XB_SPIN(cond, bar) do { unsigned _sp = 0; while (cond) { __builtin_amdgcn_s_sleep(1); \
    if ((++_sp & 255u) == 0u) { if (xb_ld(&(bar)[XB_TMO])) break; if (_sp > XB_SPIN_CAP) { atomicAdd(&(bar)[XB_TMO], 1u); break; } } } } while (0)

struct XcdBarrier {
    unsigned* bar; unsigned x;
    volatile LAS unsigned* st;
};

__device__ __forceinline__ XcdBarrier xcd_barrier_post(unsigned* bar, volatile LAS unsigned* st, const bool tid0) {
    XcdBarrier b; b.bar = bar; b.x = xb_xcc_id(); b.st = st;
    if (tid0) (void)xb_add(&bar[XB_XCNT(b.x)], 1u);
    return b;
}
__device__ __forceinline__ void xcd_barrier_complete(unsigned* bar, unsigned x, unsigned& nloc, unsigned& nx) {
    const unsigned G = gridDim.x * gridDim.y * gridDim.z;
    unsigned sum, cnt, mine, sp = 0u;
    for (;;) {
        sum = 0u; cnt = 0u; mine = 0u;
#pragma unroll
        for (unsigned j = 0; j < 16; ++j) { const unsigned c = xb_ld(&bar[XB_XCNT(j)]); sum += c; cnt += (c > 0u) ? 1u : 0u; mine = (j == x) ? c : mine; }
        if (sum == G) break;
        __builtin_amdgcn_s_sleep(1);
        if ((++sp & 255u) == 0u) { if (xb_ld(&bar[XB_TMO])) break; if (sp > XB_SPIN_CAP) { atomicAdd(&bar[XB_TMO], 1u); break; } }
    }
    nloc = mine > 0u ? mine : 1u; nx = cnt > 0u ? cnt : 1u;
}

__device__ __forceinline__ void xcd_barrier(const XcdBarrier& b, const int wave_s) {
    asm volatile("s_waitcnt vmcnt(0)" ::: "memory");
    __syncthreads();
    if (wave_s == 0 && lane_id() == 0) {
        unsigned* bar = b.bar; unsigned xq = b.x; asm volatile("" : "+s"(xq));
        __builtin_amdgcn_s_waitcnt(0);
        unsigned nloc = b.st[0], nx = b.st[1];
        if (nloc == 0u) { xcd_barrier_complete(bar, xq, nloc, nx); b.st[0] = nloc; b.st[1] = nx; }
        const unsigned old = xb_add(&bar[XB_XSUB(xq)], 1u);
        const unsigned gen = old / nloc;
        if (old + 1u == (gen + 1u) * nloc) {
            __builtin_amdgcn_fence(__ATOMIC_RELEASE, "agent");
            asm volatile("s_waitcnt vmcnt(0)" ::: "memory");
            const unsigned og = xb_add(&bar[XB_TOP], 1u);
            const unsigned tg = og / nx;
            if (og + 1u == (tg + 1u) * nx) xb_add(&bar[XB_TOPGEN], 1u);
            else XB_SPIN(xb_ld(&bar[XB_TOPGEN]) == tg, bar);
            __builtin_amdgcn_fence(__ATOMIC_ACQUIRE, "agent");
            xb_add(&bar[XB_XGEN(xq)], 1u);
            asm volatile("s_waitcnt vmcnt(0)" ::: "memory");
        } else {
            XB_SPIN(xb_ld(&bar[XB_XGEN(xq)]) == gen, bar);
            __builtin_amdgcn_fence(__ATOMIC_ACQUIRE, "agent");
            asm volatile("s_waitcnt vmcnt(0)" ::: "memory");
        }
    }
    __syncthreads();
}

__device__ __forceinline__ void tr_item(const float* W, int ldsrc, int srccol0, const float* gain, bf16_t* dstblk, int lddst, int k0, LAS float* scr, int lane) {
    const int r8 = lane >> 3, c4 = (lane & 7) * 4;
    f32x4 v[8]; float gn[8];
#pragma unroll
    for (int i = 0; i < 8; ++i) { v[i] = *(const f32x4*)(W + (size_t)(k0 + 8 * i + r8) * ldsrc + srccol0 + c4); gn[i] = gain ? gain[k0 + 8 * i + r8] : 1.0f; }
#pragma unroll
    for (int i = 0; i < 8; ++i) { LAS float* s = scr + (8 * i + r8) * 33 + c4; const f32x4 x = v[i] * gn[i]; s[0] = x[0]; s[1] = x[1]; s[2] = x[2]; s[3] = x[3]; }
    LDS_WAIT(); asm volatile("" ::: "memory");
    const int c = lane & 7;
#pragma unroll
    for (int j = 0; j < 4; ++j) { const int n = (lane >> 3) + 8 * j; const LAS float* s = scr + (8 * c) * 33 + n;
        u32x4 o; o.x = cvt_pk_bf16(s[0 * 33], s[1 * 33]); o.y = cvt_pk_bf16(s[2 * 33], s[3 * 33]); o.z = cvt_pk_bf16(s[4 * 33], s[5 * 33]); o.w = cvt_pk_bf16(s[6 * 33], s[7 * 33]);
        *(u32x4*)(dstblk + (size_t)n * lddst + k0 + 8 * c) = o; }
    LDS_WAIT(); asm volatile("" ::: "memory");
}
__device__ __forceinline__ int map_col(int map, int R) {
    if (map == 0) return R;
    if (map == 1) { const int pn = R >> 8, w = R & 255; return w < 128 ? 128 * pn + w : 2816 + 128 * pn + (w - 128); }
    if (map == 2) { if (R < 1024) return R; if (R < 2048) { const int t = (R - 1024) >> 8, w = (R - 1024) & 255; return w < 128 ? 1536 + 128 * t + w : 2048 + 128 * t + (w - 128); } return 1024 + (R - 2048); }
    if (R < 512) return R; { const int t = (R - 512) >> 8, w = (R - 512) & 255; return w < 128 ? 512 + 128 * t + w : 1024 + 128 * t + (w - 128); }
}
__device__ __forceinline__ void fold_item(LAS unsigned char* lds, int item, int tid) {
    const int g = item >> 5, nt = item & 31;
    const float* pw = KIN(I_POOL_W) + (size_t)g * 16384; const float* sc = KIN(I_POOL_SCALE) + 128 * g; const float* wo = KIN(I_CD_WOUT) + (size_t)(128 * g) * D + 32 * nt;
    bf16_t* dst = (bf16_t*)WSP(WS_W + WL_STRIDE + W_OUT);
    LAS float* Ps = (LAS float*)lds;
    {
        const int c = tid >> 2, d0 = (tid & 3) * 32;
#pragma unroll
        for (int j = 0; j < 8; ++j) { const f32x4 v = *(const f32x4*)(pw + c * 128 + d0 + 4 * j), s4 = *(const f32x4*)(sc + d0 + 4 * j);
#pragma unroll
            for (int e = 0; e < 4; ++e) Ps[(d0 + 4 * j + e) * 128 + c] = v[e] * s4[e]; }
    }
    __syncthreads();
    {
        const int n = tid & 31, cb = (tid >> 5) * 8; float acc[8];
#pragma unroll
        for (int e = 0; e < 8; ++e) acc[e] = 0.f;
#pragma unroll 8
        for (int d = 0; d < 128; ++d) { const float wv = wo[(size_t)d * D + n]; const LAS f32x4* pp = (const LAS f32x4*)(Ps + d * 128 + cb); const f32x4 p0 = pp[0], p1 = pp[1];
#pragma unroll
            for (int e = 0; e < 4; ++e) { acc[e] = fmaf(p0[e], wv, acc[e]); acc[4 + e] = fmaf(p1[e], wv, acc[4 + e]); } }
        *(u32x4*)(dst + (size_t)(32 * nt + n) * D + 128 * g + cb) = pack8f(acc);
    }
    __syncthreads();
}
__device__ __forceinline__ void prep_phase(LAS unsigned char* lds, int vcu, int G, int wave) {
    asm volatile("" : "+s"(vcu), "+s"(G), "+s"(wave));
    const int tid = opaque_tid(wave), lane = tid & 63;
    for (int item = vcu; item < 128; item += G) fold_item(lds, item, tid);
    LAS float* scr = (LAS float*)(lds + wave * 16384);
    const int gw = vcu * NWAVES + wave, NGW = G * NWAVES;
    constexpr int J_GU = 16 * 176, J_D = 44 * 32, J_GATE = 16 * 32, J_UP = 4 * 32, J_L = 2 * J_GU + 2 * J_D + J_GATE + J_UP;
    constexpr int J_OUT0 = 16 * 32, J_OUT1 = 8 * 32, J_IN0 = 16 * 80, J_IN1 = 16 * 48, NITEMS = 2 * J_L + J_OUT0 + J_OUT1 + J_IN0 + J_IN1;
    for (int it = gw; it < NITEMS; it += NGW) {
        int r = it; const float* src; const float* gain = nullptr; bf16_t* dst; int ldsrc, lddst, nblk, map = 0;
        if (r < 2 * J_L) {
            const int L = r / J_L; r -= L * J_L; const size_t wl = WS_W + (size_t)L * WL_STRIDE;
            if (r < J_GU) { src = KIN(I_FFN1_WGU) + (size_t)L * D * 2 * FF; gain = KIN(I_FFN1_NORM) + L * D; dst = (bf16_t*)WSP(wl + W_GU1); ldsrc = 2 * FF; lddst = D; nblk = 176; map = 1; }
            else if ((r -= J_GU) < J_D) { src = KIN(I_FFN1_WD) + (size_t)L * FF * D; dst = (bf16_t*)WSP(wl + W_D1); ldsrc = D; lddst = FF; nblk = 32; }
            else if ((r -= J_D) < J_GU) { src = KIN(I_FFN2_WGU) + (size_t)L * D * 2 * FF; gain = KIN(I_FFN2_NORM) + L * D; dst = (bf16_t*)WSP(wl + W_GU2); ldsrc = 2 * FF; lddst = D; nblk = 176; map = 1; }
            else if ((r -= J_GU) < J_D) { src = KIN(I_FFN2_WD) + (size_t)L * FF * D; dst = (bf16_t*)WSP(wl + W_D2); ldsrc = D; lddst = FF; nblk = 32; }
            else if ((r -= J_D) < J_GATE) { src = KIN(I_PLE_WG) + (size_t)L * D * D; gain = KIN(I_PLE_NORM) + L * D; dst = (bf16_t*)WSP(wl + W_GATE); ldsrc = D; lddst = D; nblk = 32; }
            else { r -= J_GATE; src = KIN(I_PLE_WU) + (size_t)L * PLE * D; dst = (bf16_t*)WSP(wl + W_UP); ldsrc = D; lddst = PLE; nblk = 32; }
        } else {
            r -= 2 * J_L;
            if (r < J_OUT0) { src = KIN(I_AB_WOUT); dst = (bf16_t*)WSP(WS_W + W_OUT); ldsrc = D; lddst = D; nblk = 32; }
            else if ((r -= J_OUT0) < J_OUT1) { src = KIN(I_CD_WOUT) + (size_t)512 * D; dst = (bf16_t*)WSP(WS_W + WL_STRIDE + W_OUT) + 512; ldsrc = D; lddst = D; nblk = 32; }
            else if ((r -= J_OUT1) < J_IN0) { src = KIN(I_AB_WIN); gain = KIN(I_MIX_NORM); dst = (bf16_t*)WSP(WS_W + W_IN); ldsrc = 2560; lddst = D; nblk = 80; map = 2; }
            else { r -= J_IN0; src = KIN(I_CD_WIN); gain = KIN(I_MIX_NORM) + D; dst = (bf16_t*)WSP(WS_W + WL_STRIDE + W_IN); ldsrc = 1536; lddst = D; nblk = 48; map = 3; }
        }
        const int kb = r / nblk, nb = r - kb * nblk, R = 32 * nb;
        tr_item(src, ldsrc, map_col(map, R), gain, dst + (size_t)R * lddst, lddst, 64 * kb, scr, lane);
    }
    {
        const float* x = KIN(I_X); bf16_t* hb = (bf16_t*)WSP(WS_HB); float* rowss0 = (float*)WSP(WS_ROWSS);
        for (int row = 2 * gw; row < M; row += 2 * NGW) {
            const f32x4* xr = (const f32x4*)(x + (size_t)row * D) + lane; u32x2* o = (u32x2*)(hb + (size_t)row * D) + lane; f32x4 v[8];
#pragma unroll
            for (int j = 0; j < 8; ++j) v[j] = xr[64 * j];
            float ss0 = 0.f, ss1 = 0.f;
#pragma unroll
            for (int j = 0; j < 4; ++j) { ss0 += v[j][0] * v[j][0] + v[j][1] * v[j][1] + v[j][2] * v[j][2] + v[j][3] * v[j][3]; ss1 += v[4 + j][0] * v[4 + j][0] + v[4 + j][1] * v[4 + j][1] + v[4 + j][2] * v[4 + j][2] + v[4 + j][3] * v[4 + j][3]; }
#pragma unroll
            for (int j = 0; j < 8; ++j) { u32x2 w; w.x = cvt_pk_bf16(v[j][0], v[j][1]); w.y = cvt_pk_bf16(v[j][2], v[j][3]); o[64 * j] = w; }
            ss0 = wave_sum(ss0); ss1 = wave_sum(ss1);
            if (lane == 0) { rowss0[row] = ss0; rowss0[row + 1] = ss1; }
        }
    }
    const int gt = gw * 64 + lane, NGT = NGW * 64;
    {
        const float* p = KIN(I_P); bf16_t* pb = (bf16_t*)WSP(WS_PB);
        for (int t = gt; t < 2 * M * PLE / 32; t += NGT) { f32x4 v[8];
#pragma unroll
            for (int j = 0; j < 4; ++j) { const size_t e = ((size_t)t + (size_t)j * (2 * M * PLE / 32)) * 8; v[2 * j] = *(const f32x4*)(p + e); v[2 * j + 1] = *(const f32x4*)(p + e + 4); }
#pragma unroll
            for (int j = 0; j < 4; ++j) { const size_t e = ((size_t)t + (size_t)j * (2 * M * PLE / 32)) * 8; *(u32x4*)(pb + e) = pg8::pack8(v[2 * j], v[2 * j + 1]); } }
    }
    {
        const float* w = KIN(I_GM_WS); bf16_t* wt = (bf16_t*)WSP(WS_WTRIL);
        for (int t = gt; t < 4 * 128 * 128 / 8; t += NGT) { const int e0 = t * 8, tt = (e0 >> 7) & 127, s0 = e0 & 127; float f[8];
#pragma unroll
            for (int j = 0; j < 8; ++j) f[j] = (s0 + j <= tt) ? w[e0 + j] : 0.f;
            *(u32x4*)(wt + e0) = pack8f(f); }
    }
}

__device__ __forceinline__ void mix0_phase(LAS unsigned char* lds, int vcu, int G, int wave) {
    asm volatile("" : "+s"(vcu), "+s"(G), "+s"(wave));
    const int tid = opaque_tid(wave), lane = tid & 63;
    unsigned char* ws = KWS;
    const bf16_t* UV = (const bf16_t*)(ws + WS_T); const bf16_t* Q = UV + (size_t)M * 1024; const bf16_t* BG = Q + (size_t)M * 512;
    bf16_t* Y = (bf16_t*)(ws + WS_Y); const bf16_t* Wtril = (const bf16_t*)(ws + WS_WTRIL);
    LAS bf16_t* vgT = (LAS bf16_t*)lds;
    const int fr = lane & 15, fq = lane >> 4;
    for (int item = vcu; item < 512; item += G) {
        const int c = item >> 2, g = item & 3;
        {
            const int tok = tid >> 2, qt = tid & 3;
            const u32x4* src = (const u32x4*)(UV + (size_t)(c * 128 + tok) * 1024 + 512 + g * 128 + qt * 32);
            float v[32];
#pragma unroll
            for (int j = 0; j < 4; ++j) { const u32x4 w = src[j]; float f[8]; unpack8(w, f);
#pragma unroll
                for (int e = 0; e < 8; ++e) v[8 * j + e] = f[e]; }
            float s = 0.f;
#pragma unroll
            for (int i = 0; i < 32; ++i) s += v[i];
            s = pg8::add_xor<2>(pg8::add_xor<1>(s));
            const float mean = s * (1.0f / 128.0f); float q = 0.f;
#pragma unroll
            for (int i = 0; i < 32; ++i) { v[i] -= mean; q += v[i] * v[i]; }
            q = pg8::add_xor<2>(pg8::add_xor<1>(q));
            const float rstd = __builtin_amdgcn_rsqf(q * (1.0f / 128.0f) + 1e-5f);
            const float* lg = KIN(I_GM_LNG) + g * 128 + qt * 32; const float* lb = KIN(I_GM_LNB) + g * 128 + qt * 32;
#pragma unroll
            for (int i = 0; i < 32; ++i) { const float val = v[i] * rstd * lg[i] + lb[i]; vgT[(qt * 32 + i) * 136 + tok] = (bf16_t)(cvt_pk_bf16(val, 0.f) & 0xffffu); }
        }
        __syncthreads();
        {
            f32x4 acc[8];
#pragma unroll
            for (int nt = 0; nt < 8; ++nt) acc[nt] = (f32x4){0.f, 0.f, 0.f, 0.f};
            const int nks = ((16 * wave + 15) >> 5) + 1;
            const bf16_t* wrow = Wtril + (size_t)g * 16384 + (16 * wave + fr) * 128 + 8 * fq;
            for (int ks = 0; ks < nks; ++ks) {
                const bf16x8 wf = *(const bf16x8*)(wrow + 32 * ks);
#pragma unroll
                for (int nt = 0; nt < 8; ++nt) { const bf16x8 vf = *(const LAS bf16x8*)(vgT + (16 * nt + fr) * 136 + 32 * ks + 8 * fq);
                    acc[nt] = __builtin_amdgcn_mfma_f32_16x16x32_bf16(vf, wf, acc[nt], 0, 0, 0); }
            }
            const int t = 16 * wave + fr; const size_t row = (size_t)c * 128 + t; const float bias = KIN(I_GM_BS)[g * 128 + t];
#pragma unroll
            for (int nt = 0; nt < 8; ++nt) { const int d = 16 * nt + 4 * fq; const u32x2 uu = *(const u32x2*)(UV + row * 1024 + g * 128 + d);
                u32x2 o; o.x = cvt_pk_bf16(bf_lo(uu.x) * (acc[nt][0] + bias), bf_hi(uu.x) * (acc[nt][1] + bias)); o.y = cvt_pk_bf16(bf_lo(uu.y) * (acc[nt][2] + bias), bf_hi(uu.y) * (acc[nt][3] + bias));
                *(u32x2*)(Y + row * 1024 + g * 128 + d) = o; }
        }
        __syncthreads();
    }
    for (int wi = vcu * NWAVES + wave; wi < M / 8; wi += G * NWAVES) {
        const int r0 = wi * 8, pos0 = r0 & (SEQ - 1);
        const float* sw = KIN(I_SC_W) + 8 * lane; float w0[8], w1[8], w2[8];
#pragma unroll
        for (int e = 0; e < 8; ++e) { w0[e] = sw[e]; w1[e] = sw[512 + e]; w2[e] = sw[1024 + e]; }
        float qm2[8], qm1[8];
#pragma unroll
        for (int e = 0; e < 8; ++e) { qm2[e] = 0.f; qm1[e] = 0.f; }
        if (pos0 != 0) { unpack8(*(const u32x4*)(Q + (size_t)(r0 - 2) * 512 + 8 * lane), qm2); unpack8(*(const u32x4*)(Q + (size_t)(r0 - 1) * 512 + 8 * lane), qm1); }
#pragma unroll
        for (int t = 0; t < 8; ++t) { float qv[8], bg[8], y[8]; unpack8(*(const u32x4*)(Q + (size_t)(r0 + t) * 512 + 8 * lane), qv); unpack8(*(const u32x4*)(BG + (size_t)(r0 + t) * 512 + 8 * lane), bg);
#pragma unroll
            for (int e = 0; e < 8; ++e) { y[e] = bg[e] * (w0[e] * qm2[e] + w1[e] * qm1[e] + w2[e] * qv[e]); qm2[e] = qm1[e]; qm1[e] = qv[e]; }
            *(u32x4*)(Y + (size_t)(r0 + t) * 1024 + 512 + 8 * lane) = pack8f(y); }
    }
}

__device__ __forceinline__ void mix1_phase(LAS unsigned char* lds, int vcu, int G, int wave) {
    asm volatile("" : "+s"(vcu), "+s"(G), "+s"(wave));
    const int tid = opaque_tid(wave), lane = tid & 63;
    unsigned char* ws = KWS;
    const bf16_t* ZC = (const bf16_t*)(ws + WS_T); const bf16_t* S = ZC + (size_t)M * 512; bf16_t* Y = (bf16_t*)(ws + WS_Y);
    for (int r = vcu * NWAVES + wave; r < M; r += G * NWAVES) {
        const int pos = r & (SEQ - 1), win = 2 << (lane >> 4), cnt = (pos + 1 < win) ? pos + 1 : win;
        float sum[8], x0[8];
        unpack8(*(const u32x4*)(ZC + (size_t)r * 512 + 8 * lane), x0);
#pragma unroll
        for (int e = 0; e < 8; ++e) sum[e] = x0[e];
        for (int k = 1; k < 16; ++k) { if (k < cnt) { float f[8]; unpack8(*(const u32x4*)(ZC + (size_t)(r - k) * 512 + 8 * lane), f);
#pragma unroll
                for (int e = 0; e < 8; ++e) sum[e] += f[e]; } }
        const float inv = 1.0f / (float)cnt; float y[8];
#pragma unroll
        for (int e = 0; e < 8; ++e) y[e] = sum[e] * inv - x0[e];
        *(u32x4*)(Y + (size_t)r * 1024 + 8 * lane) = pack8f(y);
    }
    LAS unsigned char* sl = lds;
    LAS float* hbuf = (LAS float*)(lds + 62 * 1024);
    const int cp = tid & 255, half = tid >> 8;
    float cw[31][2];
#pragma unroll
    for (int k = 0; k < 31; ++k) { cw[k][0] = KIN(I_CV_W)[k * 512 + 2 * cp]; cw[k][1] = KIN(I_CV_W)[k * 512 + 2 * cp + 1]; }
    const float cb0 = KIN(I_CV_B)[2 * cp], cb1 = KIN(I_CV_B)[2 * cp + 1];
    for (int item = vcu; item < M / 32; item += G) {
        const int t0 = item * 32, pos0 = t0 & (SEQ - 1);
#pragma unroll
        for (int ps = 0; ps < 8; ++ps) { const int row = ps * 8 + (tid >> 6);
            if (row < 62) { u32x4 v = (u32x4){0u, 0u, 0u, 0u}; if (pos0 - 30 + row >= 0) v = *(const u32x4*)(S + (size_t)(t0 - 30 + row) * 512 + 8 * (tid & 63));
                *(LAS u32x4*)(sl + row * 1024 + (tid & 63) * 16) = v; } }
        __syncthreads();
#pragma unroll
        for (int run = 0; run < 2; ++run) {
            const int tl = half * 16 + run * 8;
            float acc[8][2];
#pragma unroll
            for (int o = 0; o < 8; ++o) { acc[o][0] = cb0; acc[o][1] = cb1; }
#pragma unroll
            for (int i = 0; i < 38; ++i) { const unsigned w = *(const LAS unsigned*)(sl + (tl + i) * 1024 + cp * 4); const float x0 = bf_lo(w), x1 = bf_hi(w);
#pragma unroll
                for (int o = 0; o < 8; ++o) { const int k = i - o; if (k >= 0 && k < 31) { acc[o][0] = fmaf(cw[k][0], x0, acc[o][0]); acc[o][1] = fmaf(cw[k][1], x1, acc[o][1]); } } }
#pragma unroll
            for (int o = 0; o < 8; ++o) { typedef float f32x2v __attribute__((ext_vector_type(2))); *(LAS f32x2v*)(hbuf + (tl + o) * 512 + 2 * cp) = (f32x2v){acc[o][0], acc[o][1]}; }
        }
        __syncthreads();
#pragma unroll
        for (int tt = 0; tt < 4; ++tt) { const int tl = wave * 4 + tt; const LAS f32x4* hp = (const LAS f32x4*)(hbuf + tl * 512 + 8 * lane); const f32x4 h0 = hp[0], h1 = hp[1];
            float s = (h0[0] + h0[1]) + (h0[2] + h0[3]) + (h1[0] + h1[1]) + (h1[2] + h1[3]); s = wave_sum(s);
            const float mean = s * (1.0f / 512.0f); const f32x4 d0 = h0 - mean, d1 = h1 - mean;
            float q = (d0[0] * d0[0] + d0[1] * d0[1]) + (d0[2] * d0[2] + d0[3] * d0[3]) + (d1[0] * d1[0] + d1[1] * d1[1]) + (d1[2] * d1[2] + d1[3] * d1[3]); q = wave_sum(q);
            const float rstd = __builtin_amdgcn_rsqf(q * (1.0f / 512.0f) + 1e-5f);
            const f32x4 g0 = *(const f32x4*)(KIN(I_CV_LNG) + 8 * lane), g1 = *(const f32x4*)(KIN(I_CV_LNG) + 8 * lane + 4), b0 = *(const f32x4*)(KIN(I_CV_LNB) + 8 * lane), b1 = *(const f32x4*)(KIN(I_CV_LNB) + 8 * lane + 4);
            float y[8];
#pragma unroll
            for (int e = 0; e < 4; ++e) { y[e] = pg8::fsilu(d0[e] * rstd * g0[e] + b0[e]); y[4 + e] = pg8::fsilu(d1[e] * rstd * g1[e] + b1[e]); }
            *(u32x4*)(Y + (size_t)(t0 + tl) * 1024 + 512 + 8 * lane) = pack8f(y); }
        __syncthreads();
    }
}

__device__ __forceinline__ void final_phase(int vcu, int G, int wave) {
    asm volatile("" : "+s"(vcu), "+s"(G), "+s"(wave));
    const int tid = opaque_tid(wave), lane = tid & 63;
    const int gw = vcu * NWAVES + wave, NGW = G * NWAVES; const f32x4* g4 = (const f32x4*)KIN(I_FINAL_NORM) + lane;
    for (int row = gw; row < M; row += NGW) { f32x4* xr = (f32x4*)(KOUT + (size_t)row * D) + lane; f32x4 v[4]; float ss = 0.f;
#pragma unroll
        for (int j = 0; j < 4; ++j) { v[j] = xr[64 * j]; ss += v[j][0] * v[j][0] + v[j][1] * v[j][1] + v[j][2] * v[j][2] + v[j][3] * v[j][3]; }
        ss = wave_sum(ss); const float r = pg8::rstd_of(ss);
#pragma unroll
        for (int j = 0; j < 4; ++j) xr[64 * j] = v[j] * r * g4[64 * j]; }
}

#if DBG
__device__ __forceinline__ void dbg_compare(int cp, int vcu, int G, int wave) {
    asm volatile("" : "+s"(vcu), "+s"(G), "+s"(wave));
    const int tid = opaque_tid(wave), lane = tid & 63;
    const bf16_t* snap = (const bf16_t*)(KWS + WS_SNAP) + (size_t)cp * DBG_NT * D; float* res = (float*)(KWS + WS_DBG);
    for (int row = vcu * NWAVES + wave; row < DBG_NT; row += G * NWAVES) { float e2 = 0.f, r2 = 0.f;
        for (int j = 0; j < 16; ++j) { const int c = lane + 64 * j; const float hv = KOUT[(size_t)row * D + c]; const float sv = __uint_as_float((unsigned)snap[(size_t)row * D + c] << 16); e2 += (hv - sv) * (hv - sv); r2 += sv * sv; }
        e2 = wave_sum(e2); r2 = wave_sum(r2);
        if (lane == 0) { atomicAdd(res + 2 * cp, e2); atomicAdd(res + 2 * cp + 1, r2); } }
}
#endif

__global__ void __launch_bounds__(NTHREADS, 2) mk_fwd(Args a_unused) {
    extern __shared__ __attribute__((aligned(16))) unsigned char lds_raw[];
    LAS unsigned char* lds = (LAS unsigned char*)lds_raw;
    cg::grid_group grid = cg::this_grid();
    const int wave_s = __builtin_amdgcn_readfirstlane(threadIdx.x >> 6);
    const int G = gridDim.x, bx = blockIdx.x;
    const int vcu = (G % 8 == 0) ? (bx % 8) * (G / 8) + bx / 8 : bx;
    for (int u = threadIdx.x; u < 64; u += NTHREADS) ((LAS unsigned*)(lds + LDSCTL_OFF))[u] = 0u;
    __syncthreads();
    const XcdBarrier xbar = xcd_barrier_post((unsigned*)WSP(WS_BAR), (volatile LAS unsigned*)(lds + LDSCTL_OFF + 32), threadIdx.x == 0);
#define GRID_SYNC() xcd_barrier(xbar, wave_s)
#if DBG
    int dcp = 0;
#define DBG_CP() do { dbg_compare(dcp, vcu, G, wave_s); ++dcp; GRID_SYNC(); } while (0)
#else
#define DBG_CP() do { } while (0)
#endif
#define GEMM_PHASE(EPI, A_, B_, N_, K_, ...) GEMM_PHASE_X(EPI, G, bx, A_, B_, N_, K_, __VA_ARGS__)
#define GEMM_PHASE_X(EPI, GX_, CX_, A_, B_, N_, K_, ...) do { int G_ = (GX_), bx_ = (CX_), w_ = wave_s; asm volatile("" : "+s"(G_), "+s"(bx_), "+s"(w_));     \
        pg8::Gemm g_{(const bf16_t*)(A_), (const bf16_t*)(B_), M, (N_), (K_)}; pg8::StaticOrder S_; S_.init(M, (N_), G_, bx_); \
        pg8::EPI E_{__VA_ARGS__}; pg8::gemm_phase<pg8::EPI, pg8::StaticOrder, GP_ALIGN, GP_SP2>(lds, g_, S_, E_, w_); } while (0)

#if STAMPS
    unsigned long long st_[6]; int sti_ = 0;
#define STAMP_AT() do { if (sti_ < 6) st_[sti_] = rt(); ++sti_; } while (0)
#else
#define STAMP_AT() do { } while (0)
#endif
    STAMP_AT();
#pragma unroll 1
    for (int rep = 0; rep < (PROBE == 1 ? 2 : 1); ++rep) {
    prep_phase(lds, vcu, G, wave_s);
    __syncthreads();
    grid.sync();
    }
    STAMP_AT();
#if PROBE == 8
#undef GRID_SYNC
#define GRID_SYNC() do { xcd_barrier(xbar, wave_s); xcd_barrier(xbar, wave_s); } while (0)
#endif

#pragma unroll 1
    for (int L = 0; L < 2; ++L) {
        const size_t wl = WS_W + (size_t)L * WL_STRIDE;
        const int cur = 4 * L;
#pragma unroll 1
        for (int rep = 0; rep < (PROBE == 2 ? 2 : 1); ++rep) {
        GEMM_PHASE(EpiSwiglu, WSP(WS_HB), WSP(wl + W_GU1), 2 * FF, D, (bf16_t*)WSP(WS_T), ROWSS(cur));
        GRID_SYNC();
        }
        if (PROBE == 3) { GEMM_PHASE(EpiResDry, WSP(WS_T), WSP(wl + W_D1), D, FF, L == 0 ? KIN(I_X) : KOUT, KOUT, (bf16_t*)WSP(WS_HB), ROWSS(cur + 1), 0.5f); GRID_SYNC(); }
        GEMM_PHASE(EpiRes, WSP(WS_T), WSP(wl + W_D1), D, FF, L == 0 ? KIN(I_X) : KOUT, KOUT, (bf16_t*)WSP(WS_HB), ROWSS(cur + 1), 0.5f);
        GRID_SYNC();
        DBG_CP();
#pragma unroll 1
        for (int rep = 0; rep < (PROBE == 4 ? 2 : 1); ++rep) {
        if (L == 0) GEMM_PHASE(EpiMix0, WSP(WS_HB), WSP(wl + W_IN), 2560, D, ROWSS(cur + 1), (bf16_t*)WSP(WS_T), (bf16_t*)WSP(WS_T) + (size_t)M * 1024, (bf16_t*)WSP(WS_T) + (size_t)M * 1536);
        else GEMM_PHASE(EpiMix1, WSP(WS_HB), WSP(wl + W_IN), 1536, D, ROWSS(cur + 1), (bf16_t*)WSP(WS_T), (bf16_t*)WSP(WS_T) + (size_t)M * 512);
        GRID_SYNC();
        }
#pragma unroll 1
        for (int rep = 0; rep < (PROBE == 5 ? 2 : 1); ++rep) {
        if (L == 0) mix0_phase(lds, vcu, G, wave_s); else mix1_phase(lds, vcu, G, wave_s);
        GRID_SYNC();
        }
        if (PROBE == 6) { GEMM_PHASE(EpiResDry, WSP(WS_Y), WSP(wl + W_OUT), D, D, KOUT, KOUT, (bf16_t*)WSP(WS_HB), ROWSS(cur + 2), 1.0f); GRID_SYNC(); }
        GEMM_PHASE(EpiRes, WSP(WS_Y), WSP(wl + W_OUT), D, D, KOUT, KOUT, (bf16_t*)WSP(WS_HB), ROWSS(cur + 2), 1.0f);
        GRID_SYNC();
        DBG_CP();
#pragma unroll 1
        for (int rep = 0; rep < (PROBE == 2 ? 2 : 1); ++rep) {
        GEMM_PHASE(EpiSwiglu, WSP(WS_HB), WSP(wl + W_GU2), 2 * FF, D, (bf16_t*)WSP(WS_T), ROWSS(cur + 2));
#pragma unroll 1
        for (int rep2 = 0; rep2 < (PROBE == 7 ? 2 : 1); ++rep2) {
            if (G == 256) { if (bx >= 128) GEMM_PHASE_X(EpiPlain, 128, bx - 128, (const bf16_t*)WSP(WS_PB) + (size_t)L * M * PLE, WSP(wl + W_UP), D, PLE, (bf16_t*)WSP(WS_Y)); }
            else GEMM_PHASE(EpiPlain, (const bf16_t*)WSP(WS_PB) + (size_t)L * M * PLE, WSP(wl + W_UP), D, PLE, (bf16_t*)WSP(WS_Y));
        }
        GRID_SYNC();
        }
        if (PROBE == 3) { GEMM_PHASE(EpiResDry, WSP(WS_T), WSP(wl + W_D2), D, FF, KOUT, KOUT, (bf16_t*)WSP(WS_HB), ROWSS(cur + 3), 0.5f); GRID_SYNC(); }
        GEMM_PHASE(EpiRes, WSP(WS_T), WSP(wl + W_D2), D, FF, KOUT, KOUT, (bf16_t*)WSP(WS_HB), ROWSS(cur + 3), 0.5f);
        GRID_SYNC();
        DBG_CP();
        if (PROBE == 6) { GEMM_PHASE(EpiPleDry, WSP(WS_HB), WSP(wl + W_GATE), D, D, ROWSS(cur + 3), (const bf16_t*)WSP(WS_Y), KOUT, L == 0 ? (bf16_t*)WSP(WS_HB) : (bf16_t*)nullptr, L == 0 ? ROWSS(cur + 4) : (float*)nullptr); GRID_SYNC(); }
        GEMM_PHASE(EpiPle, WSP(WS_HB), WSP(wl + W_GATE), D, D, ROWSS(cur + 3), (const bf16_t*)WSP(WS_Y), KOUT, L == 0 ? (bf16_t*)WSP(WS_HB) : (bf16_t*)nullptr, L == 0 ? ROWSS(cur + 4) : (float*)nullptr);
        GRID_SYNC();
        DBG_CP();
    }
    STAMP_AT();
#if STAMPS == 3
    final_phase(vcu, G, wave_s); GRID_SYNC(); STAMP_AT();
#endif
#if STAMPS
    {
#if STAMPS == 4
        if (bx == 0) { const unsigned long long d_ = *(volatile LAS unsigned*)(lds + LDSCTL_OFF + 128), t_ = rt(); while (rt() - t_ < d_) __builtin_amdgcn_s_sleep(8); }
#else
        if (bx == 0) { const unsigned long long d_ = st_[STAMPS] - st_[STAMPS - 1], t_ = rt(); while (rt() - t_ < d_) __builtin_amdgcn_s_sleep(8); }
#endif
        GRID_SYNC();
    }
#endif
    final_phase(vcu, G, wave_s);
}
}
#if DBG
namespace v0 {
constexpr int D = 1024, SEQ = 2048, BATCH = 8, PLE = 256, FF = 2816;
constexpr int WA = 512, WB = 512, WC = 512, WD = 512, CHUNK = 128;
constexpr int IN_EVEN = 2560, IN_ODD = 1536;
constexpr float RMS_EPS = 1e-6f, LN_EPS = 1e-5f;

__device__ __forceinline__ float wave_sum(float v) {
#pragma unroll
    for (int o = 1; o < 64; o <<= 1) v += __shfl_xor(v, o);
    return v;
}
__device__ __forceinline__ float sigmoidf_(float x) { return 1.0f / (1.0f + expf(-x)); }
__device__ __forceinline__ float siluf_(float x) { return x * sigmoidf_(x); }
__device__ __forceinline__ float gelu_tanh(float x) {
    const float c = 0.7978845608028654f;
    return 0.5f * x * (1.0f + tanhf(c * (x + 0.044715f * x * x * x)));
}

__global__ __launch_bounds__(256) void k_rmsnorm(const float* x, const float* gain, float* y, int rows) {
    const int row = blockIdx.x * 4 + (threadIdx.x >> 6), lane = threadIdx.x & 63;
    if (row >= rows) return;
    const float4* xr = (const float4*)(x + (size_t)row * D);
    float4 v[4]; float s = 0.f;
#pragma unroll
    for (int j = 0; j < 4; ++j) { v[j] = xr[lane + 64 * j]; s += v[j].x * v[j].x + v[j].y * v[j].y + v[j].z * v[j].z + v[j].w * v[j].w; }
    s = wave_sum(s);
    const float r = 1.0f / sqrtf(s * (1.0f / D) + RMS_EPS);
    float4* yr = (float4*)(y + (size_t)row * D);
    const float4* g4 = (const float4*)gain;
#pragma unroll
    for (int j = 0; j < 4; ++j) { const float4 g = g4[lane + 64 * j]; float4 o; o.x = v[j].x * r * g.x; o.y = v[j].y * r * g.y; o.z = v[j].z * r * g.z; o.w = v[j].w * r * g.w; yr[lane + 64 * j] = o; }
}

struct GemmP { const float* A; const float* B; float* C; int M, N, K, lda, ldb, ldc; long sA1, sB1, sC1, sA2, sB2, sC2; int nb2; int tril; };
__global__ __launch_bounds__(256) void k_gemm(GemmP p) {
    __shared__ float As[16][68];
    __shared__ float Bs[16][68];
    const int z1 = blockIdx.z / p.nb2, z2 = blockIdx.z % p.nb2;
    const float* A = p.A + z1 * p.sA1 + z2 * p.sA2;
    const float* B = p.B + z1 * p.sB1 + z2 * p.sB2;
    float* C = p.C + z1 * p.sC1 + z2 * p.sC2;
    const int t = threadIdx.x, tx = t & 15, ty = t >> 4;
    const int m0 = blockIdx.y * 64, n0 = blockIdx.x * 64;
    float acc[4][4];
#pragma unroll
    for (int i = 0; i < 4; ++i)
#pragma unroll
        for (int j = 0; j < 4; ++j) acc[i][j] = 0.f;
    const int ar = t >> 2, ak = (t & 3) * 4;
    const int bk = t >> 4, bn = (t & 15) * 4;
    for (int k0 = 0; k0 < p.K; k0 += 16) {
        float4 av = *(const float4*)(A + (size_t)(m0 + ar) * p.lda + k0 + ak);
        if (p.tril) {
            const int tt = m0 + ar, ss = k0 + ak;
            if (ss + 0 > tt) av.x = 0.f; if (ss + 1 > tt) av.y = 0.f; if (ss + 2 > tt) av.z = 0.f; if (ss + 3 > tt) av.w = 0.f;
        }
        const float4 bv = *(const float4*)(B + (size_t)(k0 + bk) * p.ldb + n0 + bn);
        As[ak + 0][ar] = av.x; As[ak + 1][ar] = av.y; As[ak + 2][ar] = av.z; As[ak + 3][ar] = av.w;
        *(float4*)&Bs[bk][bn] = bv;
        __syncthreads();
#pragma unroll
        for (int k = 0; k < 16; ++k) {
            const float4 a = *(const float4*)&As[k][ty * 4];
            const float4 b = *(const float4*)&Bs[k][tx * 4];
            const float aa[4] = {a.x, a.y, a.z, a.w}, bb[4] = {b.x, b.y, b.z, b.w};
#pragma unroll
            for (int i = 0; i < 4; ++i)
#pragma unroll
                for (int j = 0; j < 4; ++j) acc[i][j] = fmaf(aa[i], bb[j], acc[i][j]);
        }
        __syncthreads();
    }
#pragma unroll
    for (int i = 0; i < 4; ++i) {
        float4 o; o.x = acc[i][0]; o.y = acc[i][1]; o.z = acc[i][2]; o.w = acc[i][3];
        *(float4*)(C + (size_t)(m0 + ty * 4 + i) * p.ldc + n0 + tx * 4) = o;
    }
}

__global__ void k_swiglu(const float* z, float* t, int rows) {
    const size_t i = (size_t)blockIdx.x * blockDim.x + threadIdx.x;
    if (i >= (size_t)rows * FF) return;
    const size_t r = i / FF, j = i % FF;
    t[i] = siluf_(z[r * (2 * FF) + j]) * z[r * (2 * FF) + FF + j];
}
__global__ void k_add_scaled(float* h, const float* y, float sc, size_t n) {
    const size_t i = (size_t)blockIdx.x * blockDim.x + threadIdx.x;
    if (i < n) h[i] += sc * y[i];
}
__global__ __launch_bounds__(256) void k_gelu_ln(const float* z, const float* ln_g, const float* ln_b, float* u, float* vg, int rows) {
    const int wid = blockIdx.x * 4 + (threadIdx.x >> 6), lane = threadIdx.x & 63;
    const int row = wid >> 2, g = wid & 3;
    if (row >= rows) return;
    const float* zr = z + (size_t)row * IN_EVEN;
    const int c0 = g * 128 + lane * 2;
    u[(size_t)row * WA + c0] = gelu_tanh(zr[c0]); u[(size_t)row * WA + c0 + 1] = gelu_tanh(zr[c0 + 1]);
    const float v0 = gelu_tanh(zr[WA + c0]), v1 = gelu_tanh(zr[WA + c0 + 1]);
    const float mu = wave_sum(v0 + v1) * (1.0f / 128.0f);
    const float d0 = v0 - mu, d1 = v1 - mu;
    const float var = wave_sum(d0 * d0 + d1 * d1) * (1.0f / 128.0f);
    const float r = 1.0f / sqrtf(var + LN_EPS);
    vg[(size_t)row * WA + c0] = d0 * r * ln_g[c0] + ln_b[c0];
    vg[(size_t)row * WA + c0 + 1] = d1 * r * ln_g[c0 + 1] + ln_b[c0 + 1];
}
__global__ void k_gate(const float* u, const float* mixed, const float* b_s, float* ycat, int rows) {
    const size_t i = (size_t)blockIdx.x * blockDim.x + threadIdx.x;
    if (i >= (size_t)rows * WA) return;
    const int r = (int)(i / WA), c = (int)(i % WA), g = c >> 7;
    ycat[(size_t)r * D + c] = u[i] * (mixed[i] + b_s[g * CHUNK + (r % CHUNK)]);
}
__global__ void k_shortconv(const float* z, const float* w, float* ycat, int rows) {
    const size_t i = (size_t)blockIdx.x * blockDim.x + threadIdx.x;
    if (i >= (size_t)rows * WB) return;
    const int r = (int)(i / WB), c = (int)(i % WB);
    float acc = 0.f;
#pragma unroll
    for (int k = 0; k < 3; ++k) {
        const int tt = r - 2 + k;
        if (tt >= 0) { const float* zr = z + (size_t)tt * IN_EVEN + 2 * WA; acc += w[k * WB + c] * (zr[WB + c] * zr[2 * WB + c]); }
    }
    ycat[(size_t)r * D + WA + c] = z[(size_t)r * IN_EVEN + 2 * WA + c] * acc;
}
__global__ void k_pool(const float* z, float* pooled, int rows) {
    const size_t i = (size_t)blockIdx.x * blockDim.x + threadIdx.x;
    if (i >= (size_t)rows * WC) return;
    const int r = (int)(i / WC), c = (int)(i % WC), win = 2 << (c >> 7);
    const int cnt = (r + 1 < win) ? (r + 1) : win;
    float s = 0.f;
    for (int k = 0; k < cnt; ++k) s += z[(size_t)(r - k) * IN_ODD + c];
    pooled[i] = s / (float)cnt - z[(size_t)r * IN_ODD + c];
}
__global__ void k_colscale_to(const float* src, const float* sc, float* ycat, int rows) {
    const size_t i = (size_t)blockIdx.x * blockDim.x + threadIdx.x;
    if (i >= (size_t)rows * WC) return;
    const int r = (int)(i / WC), c = (int)(i % WC);
    ycat[(size_t)r * D + c] = src[i] * sc[c];
}
__global__ void k_glu(const float* z, float* s, int rows) {
    const size_t i = (size_t)blockIdx.x * blockDim.x + threadIdx.x;
    if (i >= (size_t)rows * WD) return;
    const int r = (int)(i / WD), c = (int)(i % WD);
    s[i] = z[(size_t)r * IN_ODD + WC + c] * sigmoidf_(z[(size_t)r * IN_ODD + WC + WD + c]);
}
__global__ __launch_bounds__(512) void k_conv_ln_silu(const float* s, const float* cw, const float* cb, const float* ln_g, const float* ln_b, float* ycat, int rows) {
    __shared__ float red[8];
    __shared__ float red2[8];
    const int r = blockIdx.x, c = threadIdx.x;
    float acc = cb[c];
    for (int k = 0; k < 31; ++k) { const int tt = r - 30 + k; if (tt >= 0) acc += cw[k * WD + c] * s[(size_t)tt * WD + c]; }
    float ws = wave_sum(acc);
    if ((c & 63) == 0) red[c >> 6] = ws;
    __syncthreads();
    float mu = 0.f;
#pragma unroll
    for (int i = 0; i < 8; ++i) mu += red[i];
    mu *= (1.0f / 512.0f);
    const float d = acc - mu;
    float wq = wave_sum(d * d);
    if ((c & 63) == 0) red2[c >> 6] = wq;
    __syncthreads();
    float var = 0.f;
#pragma unroll
    for (int i = 0; i < 8; ++i) var += red2[i];
    var *= (1.0f / 512.0f);
    const float y = d * (1.0f / sqrtf(var + LN_EPS)) * ln_g[c] + ln_b[c];
    ycat[(size_t)r * D + WC + c] = siluf_(y);
}
__global__ void k_ple(float* h, const float* gz, const float* pu, size_t n) {
    const size_t i = (size_t)blockIdx.x * blockDim.x + threadIdx.x;
    if (i < n) h[i] += sigmoidf_(gz[i]) * pu[i];
}


static unsigned short* g_snap = nullptr; static int g_snap_i = 0;
__global__ void k_snap(const float* h, unsigned short* o, size_t n) { const size_t i = (size_t)blockIdx.x * blockDim.x + threadIdx.x; if (i < n) { unsigned u = __float_as_uint(h[i]); u += 0x7fffu + ((u >> 16) & 1u); o[i] = (unsigned short)(u >> 16); } }
static void snap_hook(hipStream_t st, const float* h, int S) { if (!g_snap) return; const size_t n = (size_t)S * 1024; hipLaunchKernelGGL(k_snap, dim3((unsigned)((n + 255) / 256)), dim3(256), 0, st, h, g_snap + (size_t)g_snap_i * n, n); ++g_snap_i; }
struct In {
    const float *x, *p, *ffn1_norm, *ffn1_w_gu, *ffn1_w_down, *mix_norm, *ffn2_norm, *ffn2_w_gu, *ffn2_w_down, *ple_norm, *ple_w_gate, *ple_w_up,
        *ab_w_in, *gm_ln_g, *gm_ln_b, *gm_w_s, *gm_b_s, *sc_w, *ab_w_out, *cd_w_in, *pool_w, *pool_scale, *cv_w, *cv_b, *cv_ln_g, *cv_ln_b, *cd_w_out, *final_norm;
};

static void gemm(hipStream_t st, const float* A, const float* B, float* C, int M, int N, int K, int lda, int ldb, int ldc,
                 int nb1 = 1, long sA1 = 0, long sB1 = 0, long sC1 = 0, int nb2 = 1, long sA2 = 0, long sB2 = 0, long sC2 = 0, int tril = 0) {
    GemmP p{A, B, C, M, N, K, lda, ldb, ldc, sA1, sB1, sC1, sA2, sB2, sC2, nb2, tril};
    hipLaunchKernelGGL(k_gemm, dim3(N / 64, M / 64, nb1 * nb2), dim3(256), 0, st, p);
}
static inline unsigned nblk(size_t n, int b) { return (unsigned)((n + b - 1) / b); }

static void forward_slab(hipStream_t st, const In& in, const float* p_slab0, const float* p_slab1, float* h, float* out, float* tmp, int S) {
    float* xn = tmp;
    float* z = xn + (size_t)S * D;
    float* t = z + (size_t)S * 2 * FF;
    float* y = t + (size_t)S * FF;
    float* ycat = y + (size_t)S * D;
    float* gz = ycat + (size_t)S * D;
    float* b0 = gz + (size_t)S * D;
    float* b1 = b0 + (size_t)S * 512; float* b2 = b1 + (size_t)S * 512; float* b3 = b2 + (size_t)S * 512;
    const size_t nh = (size_t)S * D;
    for (int i = 0; i < 2; ++i) {
        hipLaunchKernelGGL(k_rmsnorm, dim3(S / 4), dim3(256), 0, st, h, in.ffn1_norm + i * D, xn, S);
        gemm(st, xn, in.ffn1_w_gu + (size_t)i * D * 2 * FF, z, S, 2 * FF, D, D, 2 * FF, 2 * FF);
        hipLaunchKernelGGL(k_swiglu, dim3(nblk((size_t)S * FF, 256)), dim3(256), 0, st, z, t, S);
        gemm(st, t, in.ffn1_w_down + (size_t)i * FF * D, y, S, D, FF, FF, D, D);
        hipLaunchKernelGGL(k_add_scaled, dim3(nblk(nh, 256)), dim3(256), 0, st, h, y, 0.5f, nh);
        snap_hook(st, h, S);
        hipLaunchKernelGGL(k_rmsnorm, dim3(S / 4), dim3(256), 0, st, h, in.mix_norm + i * D, xn, S);
        if (i == 0) {
            gemm(st, xn, in.ab_w_in, z, S, IN_EVEN, D, D, IN_EVEN, IN_EVEN);
            float *u = b0, *vg = b1, *mixed = b2;
            hipLaunchKernelGGL(k_gelu_ln, dim3(S), dim3(256), 0, st, z, in.gm_ln_g, in.gm_ln_b, u, vg, S);
            gemm(st, in.gm_w_s, vg, mixed, CHUNK, 128, CHUNK, CHUNK, WA, WA, S / CHUNK, 0, (long)CHUNK * WA, (long)CHUNK * WA, 4, (long)CHUNK * CHUNK, 128, 128, 1);
            hipLaunchKernelGGL(k_gate, dim3(nblk((size_t)S * WA, 256)), dim3(256), 0, st, u, mixed, in.gm_b_s, ycat, S);
            hipLaunchKernelGGL(k_shortconv, dim3(nblk((size_t)S * WB, 256)), dim3(256), 0, st, z, in.sc_w, ycat, S);
            gemm(st, ycat, in.ab_w_out, y, S, D, D, D, D, D);
        } else {
            gemm(st, xn, in.cd_w_in, z, S, IN_ODD, D, D, IN_ODD, IN_ODD);
            float *pooled = b0, *ycr = b1, *sg = b2;
            hipLaunchKernelGGL(k_pool, dim3(nblk((size_t)S * WC, 256)), dim3(256), 0, st, z, pooled, S);
            gemm(st, pooled, in.pool_w, ycr, S, 128, 128, WC, 128, WC, 4, 128, 128L * 128, 128);
            hipLaunchKernelGGL(k_colscale_to, dim3(nblk((size_t)S * WC, 256)), dim3(256), 0, st, ycr, in.pool_scale, ycat, S);
            hipLaunchKernelGGL(k_glu, dim3(nblk((size_t)S * WD, 256)), dim3(256), 0, st, z, sg, S);
            hipLaunchKernelGGL(k_conv_ln_silu, dim3(S), dim3(512), 0, st, sg, in.cv_w, in.cv_b, in.cv_ln_g, in.cv_ln_b, ycat, S);
            gemm(st, ycat, in.cd_w_out, y, S, D, D, D, D, D);
        }
        hipLaunchKernelGGL(k_add_scaled, dim3(nblk(nh, 256)), dim3(256), 0, st, h, y, 1.0f, nh);
        snap_hook(st, h, S);
        hipLaunchKernelGGL(k_rmsnorm, dim3(S / 4), dim3(256), 0, st, h, in.ffn2_norm + i * D, xn, S);
        gemm(st, xn, in.ffn2_w_gu + (size_t)i * D * 2 * FF, z, S, 2 * FF, D, D, 2 * FF, 2 * FF);
        hipLaunchKernelGGL(k_swiglu, dim3(nblk((size_t)S * FF, 256)), dim3(256), 0, st, z, t, S);
        gemm(st, t, in.ffn2_w_down + (size_t)i * FF * D, y, S, D, FF, FF, D, D);
        hipLaunchKernelGGL(k_add_scaled, dim3(nblk(nh, 256)), dim3(256), 0, st, h, y, 0.5f, nh);
        snap_hook(st, h, S);
        hipLaunchKernelGGL(k_rmsnorm, dim3(S / 4), dim3(256), 0, st, h, in.ple_norm + i * D, xn, S);
        gemm(st, xn, in.ple_w_gate + (size_t)i * D * D, gz, S, D, D, D, D, D);
        gemm(st, i == 0 ? p_slab0 : p_slab1, in.ple_w_up + (size_t)i * PLE * D, y, S, D, PLE, PLE, D, D);
        hipLaunchKernelGGL(k_ple, dim3(nblk(nh, 256)), dim3(256), 0, st, h, gz, y, nh);
        snap_hook(st, h, S);
    }
    hipLaunchKernelGGL(k_rmsnorm, dim3(S / 4), dim3(256), 0, st, h, in.final_norm, out, S);
}
}
#endif

#if DBG
__global__ void k_dbg_report(const float* res, float* out) {
    if (threadIdx.x != 0 || blockIdx.x != 0) return;
    for (int cp = 0; cp < 8; ++cp) { const float e2 = res[2 * cp], r2 = res[2 * cp + 1]; const float rel = sqrtf(e2 / fmaxf(r2, 1e-30f));
        if (!(rel < DBG_THR)) { int d = (int)(rel * 10.0f); if (d > 9 || !(rel == rel)) d = 9; if (d < 0) d = 0; out[0] = 1000.0f * (float)(cp + 1) + 100.0f * (float)d; return; } }
}
#endif

extern "C" void kernel_launch(void* const* d_in, const int* in_sizes, int n_in, void* d_out, int out_size, void* d_ws, size_t ws_size, hipStream_t stream) {
    using namespace mk;
    static int grid = 0;
    if (grid == 0) {
        const size_t need = DBG ? WS_SNAP + (size_t)8 * DBG_NT * D * 2 : WS_END;
        if (n_in != 28 || in_sizes[0] != M * D || out_size != M * D || ws_size < need) { fprintf(stderr, "kernel_launch: unexpected problem (n_in %d, in0 %d, out %d, ws %zu < %zu); nothing launched\n", n_in, n_in > 0 ? in_sizes[0] : -1, out_size, ws_size, need); grid = -1; return; }
        int dev = 0, cus = 0, per_cu = 0;
        if (hipGetDevice(&dev) != hipSuccess || hipDeviceGetAttribute(&cus, hipDeviceAttributeMultiprocessorCount, dev) != hipSuccess) { grid = -1; return; }
        if (hipFuncSetAttribute((const void*)mk_fwd, hipFuncAttributeMaxDynamicSharedMemorySize, LDS_BYTES) != hipSuccess) { fprintf(stderr, "kernel_launch: hipFuncSetAttribute failed\n"); grid = -1; return; }
        if (hipOccupancyMaxActiveBlocksPerMultiprocessor(&per_cu, (const void*)mk_fwd, NTHREADS, LDS_BYTES) != hipSuccess || per_cu < 1) { fprintf(stderr, "kernel_launch: occupancy query failed (%d)\n", per_cu); (void)hipGetLastError(); grid = -1; return; }
        grid = cus * 1;
        fprintf(stderr, "kernel_launch: grid %d (cus %d, occupancy %d/CU), ws %zu\n", grid, cus, per_cu, ws_size);
    }
    if (grid < 0) return;
    (void)hipMemsetAsync((char*)d_ws + WS_CTL, 0, CTL_BYTES, stream);
    Args a{};
    for (int i = 0; i < 28; ++i) a.in[i] = (const float*)d_in[i];
    a.out = (float*)d_out; a.ws = (unsigned char*)d_ws; a.dbg = DBG; a.pad = 0;
#if DBG
    {
        v0::In in; const float** f = (const float**)&in; for (int i = 0; i < 28; ++i) f[i] = (const float*)d_in[i];
        float* href = (float*)((char*)d_ws + WS_Y); float* tmp = (float*)((char*)d_ws + WS_T);
        (void)hipMemcpyAsync(href, in.x, (size_t)DBG_NT * D * sizeof(float), hipMemcpyDeviceToDevice, stream);
        v0::g_snap = (unsigned short*)((char*)d_ws + WS_SNAP); v0::g_snap_i = 0;
        v0::forward_slab(stream, in, in.p, in.p + (size_t)v0::BATCH * v0::SEQ * v0::PLE, href, href, tmp, DBG_NT);
    }
#endif
    void* args[] = {&a};
    const hipError_t e = hipLaunchCooperativeKernel((const void*)mk_fwd, dim3(grid), dim3(NTHREADS), args, LDS_BYTES, stream);
    if (e != hipSuccess) fprintf(stderr, "kernel_launch: cooperative launch failed: %s (grid %d)\n", hipGetErrorString(e), grid);
#if DBG
    hipLaunchKernelGGL(k_dbg_report, dim3(1), dim3(64), 0, stream, (const float*)((char*)d_ws + WS_DBG), (float*)d_out);
#endif
}
```

```cpp
#define PROBE 0
#include <hip/hip_runtime.h>
#include <hip/hip_cooperative_groups.h>
#include <cstdio>
#include <cstdint>
namespace cg = cooperative_groups;

#ifndef DBG
#define DBG 0
#endif
#ifndef GP_SP2
#define GP_SP2 true
#endif
#ifndef GP_ALIGN
#define GP_ALIGN true
#endif
#ifndef DBG_THR
#define DBG_THR 0.03f
#endif
#ifndef PROBE
#define PROBE 0
#endif
#ifndef STAMPS
#define STAMPS 0
#endif
#ifndef GP_TIME
#define GP_TIME 0
#endif

namespace pg8 {
#define PG8_LAS __attribute__((address_space(3)))
typedef unsigned short bf16_t;
typedef short bf16x8 __attribute__((ext_vector_type(8)));
typedef float f32x4 __attribute__((ext_vector_type(4)));
typedef unsigned u32x4 __attribute__((ext_vector_type(4)));
typedef unsigned u32x2 __attribute__((ext_vector_type(2)));
constexpr int BM = 256, BK = 64, HALF = 128, HTB = HALF * BK * 2  , STAGE_BYTES = 8 * HTB, NXCD = 8, WGM = 8;

__host__ __device__ __forceinline__ int lds_byte(int r, int c) { const int st = (r >> 4) * 2 + (c >> 5), rr = r & 15, cc = c & 31, ob = rr * 64 + cc * 2; return st * 1024 + (ob ^ (((ob >> 9) & 1) << 5)); }
__host__ __device__ __forceinline__ void stage_rc(int b, int& R, int& C) { const int st = b / 1024, sb = b % 1024, swz = sb ^ (((sb >> 9) & 1) << 5); R = (st >> 1) * 16 + swz / 64; C = (st & 1) * 32 + (swz % 64) / 2; }
__host__ __device__ __forceinline__ int perm32(int rho) { const int n = rho >> 4, i = rho & 15; return 8 * (i >> 2) + 4 * n + (i & 3); }

struct Unit { int pm, pn; };
struct Gemm { const bf16_t* A; const bf16_t* Bt; int M, N, K; };

struct StaticOrder {
    int nM, nN, nwg, G, c;
    __host__ __device__ void init(int M, int N, int G_, int c_) { nM = M / BM; nN = N / BM; nwg = nM * nN; G = G_; c = c_; }
    __host__ __device__ bool next(int i, Unit& u) const {
        const long L = (long)i * G + c; if (L >= nwg) return false;
        int wgid = (int)L; { const int q = nwg / NXCD, r = nwg % NXCD, xcd = wgid % NXCD, off = wgid / NXCD; wgid = (xcd < r ? xcd * (q + 1) : r * (q + 1) + (xcd - r) * q) + off; }
        const int nig = WGM * nN, gid = wgid / nig, fm = gid * WGM, gsz = (nM - fm) < WGM ? (nM - fm) : WGM;
        u.pm = fm + ((wgid % nig) % gsz); u.pn = (wgid % nig) / gsz; return true;
    }
    __device__ __forceinline__ void a_ready(const Unit&) const {}
    __device__ __forceinline__ void done(const Unit&) const {}
};

typedef __bf16 bf16x2_t __attribute__((ext_vector_type(2)));
typedef float f32x2 __attribute__((ext_vector_type(2)));
__device__ __forceinline__ unsigned cvt_pk_bf16(float lo, float hi) { const f32x2 v = {lo, hi}; const bf16x2_t b = __builtin_convertvector(v, bf16x2_t); return __builtin_bit_cast(unsigned, b); }
__device__ __forceinline__ float bf_lo(unsigned w) { return __uint_as_float(w << 16); }
__device__ __forceinline__ float bf_hi(unsigned w) { return __uint_as_float(w & 0xffff0000u); }
__device__ __forceinline__ float fsigmoid(float x) { return __builtin_amdgcn_rcpf(1.0f + __builtin_amdgcn_exp2f(-1.4426950408889634f * x)); }
__device__ __forceinline__ float fsilu(float x) { return x * fsigmoid(x); }
__device__ __forceinline__ float fgelu_tanh(float x) { return x * fsigmoid(1.5957691216057308f * (x + 0.044715f * x * x * x)); }
__device__ __forceinline__ float rstd_of(float ss) { return __builtin_amdgcn_rsqf(ss * (1.0f / 1024.0f) + 1e-6f); }
__device__ __forceinline__ f32x4 vexp2(const f32x4& x) { return (f32x4){__builtin_amdgcn_exp2f(x[0]), __builtin_amdgcn_exp2f(x[1]), __builtin_amdgcn_exp2f(x[2]), __builtin_amdgcn_exp2f(x[3])}; }
__device__ __forceinline__ f32x4 vrcp(const f32x4& x) { return (f32x4){__builtin_amdgcn_rcpf(x[0]), __builtin_amdgcn_rcpf(x[1]), __builtin_amdgcn_rcpf(x[2]), __builtin_amdgcn_rcpf(x[3])}; }
__device__ __forceinline__ f32x4 vsig_neg(const f32x4& z  ) { return vrcp(vexp2(z) + 1.0f); }
__device__ __forceinline__ f32x4 vgelu(const f32x4& x) { const f32x4 x2 = x * x; return x * vsig_neg(x * (x2 * (-0.10294324f) + (-2.30220820f))); }
template <int MASK> __device__ __forceinline__ float add_xor(float v) { return v + __int_as_float(__builtin_amdgcn_ds_swizzle(__float_as_int(v), (MASK << 10) | 0x1f)); }
__device__ __forceinline__ float add_xor32(float v) { const auto r = __builtin_amdgcn_permlane32_swap(__float_as_uint(v), __float_as_uint(v), false, false); return __uint_as_float(r[0]) + __uint_as_float(r[1]); }
__device__ __forceinline__ u32x4 pack8(const f32x4& a, const f32x4& b) { u32x4 w; w.x = cvt_pk_bf16(a[0], a[1]); w.y = cvt_pk_bf16(a[2], a[3]); w.z = cvt_pk_bf16(b[0], b[1]); w.w = cvt_pk_bf16(b[2], b[3]); return w; }

constexpr int DM = 1024, DFF = 2816;

struct EpiSwiglu {
    static constexpr bool PERM = true, AFTER_DRAIN = false;
    bf16_t* T; const float* rowss;
    __device__ __forceinline__ void operator()(const f32x4 (&acc)[2][2][4][2], const Unit& u, int wr, int wc, int fr, int fq) const {
        const int row0 = u.pm * BM + wr * 64 + fr, col0 = u.pn * 128 + wc * 32 + 8 * fq;
        float rs[2][4];
#pragma unroll
        for (int ai = 0; ai < 2; ++ai)
#pragma unroll
            for (int m = 0; m < 4; ++m) rs[ai][m] = rstd_of(rowss[row0 + ai * HALF + m * 16]);
#pragma unroll
        for (int ai = 0; ai < 2; ++ai)
#pragma unroll
            for (int m = 0; m < 4; ++m) {
                const int r = row0 + ai * HALF + m * 16; const float s = rs[ai][m], s2 = s * s, cs = -1.4426950408889634f * s;
                const f32x4 t0 = (acc[ai][0][m][0] * acc[ai][1][m][0] * s2) * vsig_neg(acc[ai][0][m][0] * cs);
                const f32x4 t1 = (acc[ai][0][m][1] * acc[ai][1][m][1] * s2) * vsig_neg(acc[ai][0][m][1] * cs);
                *(u32x4*)(T + (size_t)r * DFF + col0) = pack8(t0, t1);
            }
    }
};
template <bool DRY> struct EpiResT {
    static constexpr bool PERM = true, AFTER_DRAIN = false;
    const float* base; float* out; bf16_t* hb; float* rowss_out; float scale;
    __device__ __forceinline__ void operator()(const f32x4 (&acc)[2][2][4][2], const Unit& u, int wr, int wc, int fr, int fq) const {
        const int row0 = u.pm * BM + wr * 64 + fr, col0 = u.pn * BM + wc * 32 + 8 * fq;
#pragma unroll
        for (int ai = 0; ai < 2; ++ai)
#pragma unroll
            for (int m = 0; m < 4; ++m) {
                const int r = row0 + ai * HALF + m * 16; const size_t off = (size_t)r * DM + col0;
                const f32x4 b00 = *(const f32x4*)(base + off), b01 = *(const f32x4*)(base + off + 4), b10 = *(const f32x4*)(base + off + HALF), b11 = *(const f32x4*)(base + off + HALF + 4);
                const f32x4 o00 = b00 + acc[ai][0][m][0] * scale, o01 = b01 + acc[ai][0][m][1] * scale, o10 = b10 + acc[ai][1][m][0] * scale, o11 = b11 + acc[ai][1][m][1] * scale;
                if (!DRY) { *(f32x4*)(out + off) = o00; *(f32x4*)(out + off + 4) = o01; *(f32x4*)(out + off + HALF) = o10; *(f32x4*)(out + off + HALF + 4) = o11;
                    *(u32x4*)(hb + off) = pack8(o00, o01); *(u32x4*)(hb + off + HALF) = pack8(o10, o11); }
                float ss = 0.f;
#pragma unroll
                for (int j = 0; j < 4; ++j) ss += o00[j] * o00[j] + o01[j] * o01[j] + o10[j] * o10[j] + o11[j] * o11[j];
                ss = add_xor32(add_xor<16>(ss));
                if (!DRY) { if (fq == 0) atomicAdd(rowss_out + r, ss); } else asm volatile("" :: "v"(ss));
                asm volatile("" ::: "memory");
            }
    }
};
typedef EpiResT<false> EpiRes; typedef EpiResT<true> EpiResDry;
template <bool DRY> struct EpiPleT {
    static constexpr bool PERM = true, AFTER_DRAIN = false;
    const float* rowss_in; const bf16_t* PU; float* h; bf16_t* hb; float* rowss_out;
    __device__ __forceinline__ void operator()(const f32x4 (&acc)[2][2][4][2], const Unit& u, int wr, int wc, int fr, int fq) const {
        const int row0 = u.pm * BM + wr * 64 + fr, col0 = u.pn * BM + wc * 32 + 8 * fq;
#pragma unroll
        for (int ai = 0; ai < 2; ++ai)
#pragma unroll
            for (int m = 0; m < 4; ++m) {
                const int r = row0 + ai * HALF + m * 16; const size_t off = (size_t)r * DM + col0;
                const float s = rstd_of(rowss_in[r]);
                const u32x4 p0 = *(const u32x4*)(PU + off), p1 = *(const u32x4*)(PU + off + HALF);
                const f32x4 b00 = *(const f32x4*)(h + off), b01 = *(const f32x4*)(h + off + 4), b10 = *(const f32x4*)(h + off + HALF), b11 = *(const f32x4*)(h + off + HALF + 4);
                const f32x4 q00 = {bf_lo(p0.x), bf_hi(p0.x), bf_lo(p0.y), bf_hi(p0.y)}, q01 = {bf_lo(p0.z), bf_hi(p0.z), bf_lo(p0.w), bf_hi(p0.w)};
                const f32x4 q10 = {bf_lo(p1.x), bf_hi(p1.x), bf_lo(p1.y), bf_hi(p1.y)}, q11 = {bf_lo(p1.z), bf_hi(p1.z), bf_lo(p1.w), bf_hi(p1.w)};
                const float cs = -1.4426950408889634f * s;
                const f32x4 o00 = b00 + vsig_neg(acc[ai][0][m][0] * cs) * q00, o01 = b01 + vsig_neg(acc[ai][0][m][1] * cs) * q01;
                const f32x4 o10 = b10 + vsig_neg(acc[ai][1][m][0] * cs) * q10, o11 = b11 + vsig_neg(acc[ai][1][m][1] * cs) * q11;
                if (!DRY) { *(f32x4*)(h + off) = o00; *(f32x4*)(h + off + 4) = o01; *(f32x4*)(h + off + HALF) = o10; *(f32x4*)(h + off + HALF + 4) = o11; }
                else asm volatile("" :: "v"(o00), "v"(o01), "v"(o10), "v"(o11));
                if (!DRY && hb) {
                    *(u32x4*)(hb + off) = pack8(o00, o01); *(u32x4*)(hb + off + HALF) = pack8(o10, o11);
                    float ss = 0.f;
#pragma unroll
                    for (int j = 0; j < 4; ++j) ss += o00[j] * o00[j] + o01[j] * o01[j] + o10[j] * o10[j] + o11[j] * o11[j];
                    ss = add_xor32(add_xor<16>(ss));
                    if (fq == 0) atomicAdd(rowss_out + r, ss);
                }
                asm volatile("" ::: "memory");
            }
    }
};
typedef EpiPleT<false> EpiPle; typedef EpiPleT<true> EpiPleDry;
struct EpiPlain {
    static constexpr bool PERM = true, AFTER_DRAIN = false;
    bf16_t* O;
    __device__ __forceinline__ void operator()(const f32x4 (&acc)[2][2][4][2], const Unit& u, int wr, int wc, int fr, int fq) const {
        const int row0 = u.pm * BM + wr * 64 + fr, col0 = u.pn * BM + wc * 32 + 8 * fq;
#pragma unroll
        for (int ai = 0; ai < 2; ++ai)
#pragma unroll
            for (int m = 0; m < 4; ++m) {
                const size_t off = (size_t)(row0 + ai * HALF + m * 16) * DM + col0;
                *(u32x4*)(O + off) = pack8(acc[ai][0][m][0], acc[ai][0][m][1]); *(u32x4*)(O + off + HALF) = pack8(acc[ai][1][m][0], acc[ai][1][m][1]);
            }
    }
};
struct EpiMix0 {
    static constexpr bool PERM = true, AFTER_DRAIN = false;
    const float* rowss; bf16_t *UV, *Q, *BG;
    __device__ __forceinline__ void operator()(const f32x4 (&acc)[2][2][4][2], const Unit& u, int wr, int wc, int fr, int fq) const {
        const int row0 = u.pm * BM + wr * 64 + fr, cw = wc * 32 + 8 * fq;
#pragma unroll
        for (int ai = 0; ai < 2; ++ai)
#pragma unroll
            for (int m = 0; m < 4; ++m) {
                const int r = row0 + ai * HALF + m * 16; const float s = rstd_of(rowss[r]);
                if (u.pn < 4) {
                    const f32x4 a0 = vgelu(acc[ai][0][m][0] * s), a1 = vgelu(acc[ai][0][m][1] * s), b0 = vgelu(acc[ai][1][m][0] * s), b1 = vgelu(acc[ai][1][m][1] * s);
                    bf16_t* p = UV + (size_t)r * 1024 + u.pn * 256 + cw; *(u32x4*)p = pack8(a0, a1); *(u32x4*)(p + HALF) = pack8(b0, b1);
                } else if (u.pn < 8) {
                    const float s2 = s * s; f32x4 q0 = acc[ai][0][m][0] * acc[ai][1][m][0] * s2, q1 = acc[ai][0][m][1] * acc[ai][1][m][1] * s2;
                    *(u32x4*)(Q + (size_t)r * 512 + (u.pn - 4) * 128 + cw) = pack8(q0, q1);
                } else {
                    bf16_t* p = BG + (size_t)r * 512 + (u.pn - 8) * 256 + cw;
                    *(u32x4*)p = pack8(acc[ai][0][m][0] * s, acc[ai][0][m][1] * s); *(u32x4*)(p + HALF) = pack8(acc[ai][1][m][0] * s, acc[ai][1][m][1] * s);
                }
            }
    }
};
struct EpiMix1 {
    static constexpr bool PERM = true, AFTER_DRAIN = false;
    const float* rowss; bf16_t *ZC, *S;
    __device__ __forceinline__ void operator()(const f32x4 (&acc)[2][2][4][2], const Unit& u, int wr, int wc, int fr, int fq) const {
        const int row0 = u.pm * BM + wr * 64 + fr, cw = wc * 32 + 8 * fq;
#pragma unroll
        for (int ai = 0; ai < 2; ++ai)
#pragma unroll
            for (int m = 0; m < 4; ++m) {
                const int r = row0 + ai * HALF + m * 16; const float s = rstd_of(rowss[r]);
                if (u.pn < 2) {
                    bf16_t* p = ZC + (size_t)r * 512 + u.pn * 256 + cw;
                    *(u32x4*)p = pack8(acc[ai][0][m][0] * s, acc[ai][0][m][1] * s); *(u32x4*)(p + HALF) = pack8(acc[ai][1][m][0] * s, acc[ai][1][m][1] * s);
                } else {
                    const float cs = -1.4426950408889634f * s;
                    const f32x4 q0 = (acc[ai][0][m][0] * s) * vsig_neg(acc[ai][1][m][0] * cs), q1 = (acc[ai][0][m][1] * s) * vsig_neg(acc[ai][1][m][1] * cs);
                    *(u32x4*)(S + (size_t)r * 512 + (u.pn - 2) * 128 + cw) = pack8(q0, q1);
                }
            }
    }
};

template <class Epi, class Sched, bool ALIGN_EPI = false, bool SP2 = false>
__device__ __forceinline__ void gemm_phase(PG8_LAS unsigned char* lds, const Gemm g, const Sched& S, const Epi& E, const int wave_s  ) {
    int tid_; asm volatile("v_mbcnt_lo_u32_b32 %0, -1, 0\n\tv_mbcnt_hi_u32_b32 %0, -1, %0" : "=v"(tid_)); tid_ |= wave_s << 6;
    const int tid = tid_, wid = wave_s, lane = tid & 63, wr = wid >> 2, wc = wid & 3, fr = lane & 15, fq = lane >> 4;
    const int K = g.K, nt = K / BK;
    unsigned voffA[2], voffB[2];
#pragma unroll
    for (int i = 0; i < 2; ++i) { int R, C; stage_rc(tid * 16 + i * 8192, R, C); const int Rb = Epi::PERM ? ((R & ~31) + perm32(R & 31)) : R;
        voffA[i] = (unsigned)(R * K + C) * 2u; voffB[i] = (unsigned)(Rb * K + C) * 2u; }
    const size_t kstep = (size_t)(BK * 2);
    const size_t hstep = (size_t)HALF * K * 2;
    const size_t tstep = 2 * hstep;
    const unsigned ldsw = (unsigned)wid * 1024u;
    const int aoff = lds_byte(wr * 64 + fr, fq * 8), boff = lds_byte(wc * 32 + fr, fq * 8);
#define PG8_SA(b, h) (((b) * 2 + (h)) * HTB)
#define PG8_SB(b, h) ((4 + (b) * 2 + (h)) * HTB)
#define PG8_STAGE(bufoff, gbase, voff) do { _Pragma("unroll") for (int _i = 0; _i < 2; ++_i) \
        __builtin_amdgcn_global_load_lds((const unsigned*)((const char*)(gbase) + (voff)[_i]), (PG8_LAS unsigned*)(lds + (bufoff) + ldsw + _i * 8192), 16, 0, 0); } while (0)
#define PG8_LDA(dst, b, h) do { _Pragma("unroll") for (int m = 0; m < 4; ++m) _Pragma("unroll") for (int k = 0; k < 2; ++k) dst[m][k] = *(const PG8_LAS bf16x8*)(lds + PG8_SA(b, h) + aoff + m * 2048 + k * 1024); } while (0)
#define PG8_LDB(dst, b, h) do { _Pragma("unroll") for (int n = 0; n < 2; ++n) _Pragma("unroll") for (int k = 0; k < 2; ++k) dst[n][k] = *(const PG8_LAS bf16x8*)(lds + PG8_SB(b, h) + boff + n * 2048 + k * 1024); } while (0)
#define PG8_MMA(ai, bj, At, Bt) do { __builtin_amdgcn_s_setprio(1); _Pragma("unroll") for (int m = 0; m < 4; ++m) _Pragma("unroll") for (int n = 0; n < 2; ++n) _Pragma("unroll") for (int k = 0; k < 2; ++k) \
        acc[ai][bj][m][n] = __builtin_amdgcn_mfma_f32_16x16x32_bf16(Bt[n][k], At[m][k], acc[ai][bj][m][n], 0, 0, 0); __builtin_amdgcn_s_setprio(0); } while (0)
#define PG8_WAIT_V(n) asm volatile("s_waitcnt vmcnt(" #n ")" ::: "memory")
#define PG8_WAIT_L(n) asm volatile("s_waitcnt lgkmcnt(" #n ")" ::: "memory")
#define PG8_BAR __builtin_amdgcn_s_barrier()
#define PG8_SCHED __builtin_amdgcn_sched_barrier(0)
    Unit cur, nxt; int ui = 0;
    if (!S.next(0, cur)) return;
    f32x4 acc[2][2][4][2];
#pragma unroll
    for (int a = 0; a < 2; ++a)
#pragma unroll
        for (int b = 0; b < 2; ++b)
#pragma unroll
            for (int m = 0; m < 4; ++m)
#pragma unroll
                for (int n = 0; n < 2; ++n) acc[a][b][m][n] = (f32x4){0.f, 0.f, 0.f, 0.f};
    bf16x8 At[4][2], B0[2][2], B1[2][2];
    const char* cA = (const char*)g.A + (size_t)cur.pm * tstep; const char* cB = (const char*)g.Bt + (size_t)cur.pn * tstep;
    S.a_ready(cur);
    if constexpr (SP2) {
        PG8_STAGE(PG8_SB(0, 0), cB, voffB); PG8_STAGE(PG8_SB(0, 1), cB + hstep, voffB); PG8_STAGE(PG8_SA(0, 0), cA, voffA); PG8_STAGE(PG8_SA(0, 1), cA + hstep, voffA);
        if (wr == 1) PG8_BAR;
        PG8_WAIT_V(2); PG8_BAR;
        PG8_STAGE(PG8_SB(1, 0), cB + kstep, voffB); PG8_STAGE(PG8_SA(1, 0), cA + kstep, voffA); PG8_STAGE(PG8_SB(1, 1), cB + hstep + kstep, voffB);
        PG8_WAIT_V(6); PG8_BAR;
    } else {
        PG8_STAGE(PG8_SB(0, 0), cB, voffB); PG8_STAGE(PG8_SA(0, 0), cA, voffA); PG8_STAGE(PG8_SB(0, 1), cB + hstep, voffB); PG8_STAGE(PG8_SA(0, 1), cA + hstep, voffA);
        if (wr == 1) PG8_BAR;
        PG8_WAIT_V(4); PG8_BAR;
        PG8_STAGE(PG8_SB(1, 0), cB + kstep, voffB); PG8_STAGE(PG8_SA(1, 0), cA + kstep, voffA); PG8_STAGE(PG8_SB(1, 1), cB + hstep + kstep, voffB);
        PG8_WAIT_V(6); PG8_BAR;
    }
    for (;;) {
        const bool has_next = S.next(ui + 1, nxt);
        const char* nA = has_next ? (const char*)g.A + (size_t)nxt.pm * tstep : cA; const char* nB = has_next ? (const char*)g.Bt + (size_t)nxt.pn * tstep : cB;
#if GP_TIME == 2
        const unsigned long long tk0_ = __builtin_amdgcn_s_memrealtime();
#endif
        for (int t = 0; t < nt; t += 2) {
            const bool last = (t == nt - 2);
            const char* a1 = cA + (size_t)(t + 1) * kstep;
            const char* a2 = last ? nA : cA + (size_t)(t + 2) * kstep; const char* b2 = last ? nB : cB + (size_t)(t + 2) * kstep;
            const char* a3 = a2 + kstep; const char* b3 = b2 + kstep;
            if (last && has_next) S.a_ready(nxt);
            if constexpr (SP2) {
            PG8_LDB(B0, 0, 0); PG8_LDB(B1, 0, 1); PG8_SCHED; PG8_LDA(At, 0, 0); PG8_STAGE(PG8_SA(1, 1), a1 + hstep, voffA);
            PG8_WAIT_V(8); PG8_WAIT_L(0); PG8_BAR; PG8_MMA(0, 0, At, B0); PG8_MMA(0, 1, At, B1); PG8_BAR; PG8_SCHED;
            PG8_LDA(At, 0, 1); PG8_STAGE(PG8_SB(0, 0), b2, voffB); PG8_STAGE(PG8_SB(0, 1), b2 + hstep, voffB); PG8_STAGE(PG8_SA(0, 0), a2, voffA);
            PG8_WAIT_V(8); PG8_WAIT_L(0); PG8_BAR; PG8_MMA(1, 0, At, B0); PG8_MMA(1, 1, At, B1); PG8_BAR; PG8_SCHED;
            PG8_LDB(B0, 1, 0); PG8_LDB(B1, 1, 1); PG8_SCHED; PG8_LDA(At, 1, 0); PG8_STAGE(PG8_SA(0, 1), a2 + hstep, voffA);
            PG8_WAIT_V(8); PG8_WAIT_L(0); PG8_BAR; PG8_MMA(0, 0, At, B0); PG8_MMA(0, 1, At, B1); PG8_BAR; PG8_SCHED;
            PG8_LDA(At, 1, 1); PG8_STAGE(PG8_SB(1, 0), b3, voffB); PG8_STAGE(PG8_SB(1, 1), b3 + hstep, voffB); PG8_STAGE(PG8_SA(1, 0), a3, voffA);
            PG8_WAIT_V(8); PG8_WAIT_L(0); PG8_BAR; PG8_MMA(1, 0, At, B0); PG8_MMA(1, 1, At, B1); PG8_BAR; PG8_SCHED;
            } else {
            PG8_LDB(B0, 0, 0); PG8_SCHED; PG8_LDA(At, 0, 0); PG8_STAGE(PG8_SA(1, 1), a1 + hstep, voffA);
            PG8_WAIT_L(8); PG8_BAR; PG8_WAIT_L(0); PG8_MMA(0, 0, At, B0); PG8_BAR; PG8_SCHED;
            PG8_LDB(B1, 0, 1); PG8_STAGE(PG8_SB(0, 0), b2, voffB);
            PG8_BAR; PG8_WAIT_L(0); PG8_MMA(0, 1, At, B1); PG8_BAR;
            PG8_LDA(At, 0, 1); PG8_STAGE(PG8_SA(0, 0), a2, voffA);
            PG8_BAR; PG8_WAIT_L(0); PG8_MMA(1, 0, At, B0); PG8_BAR; PG8_SCHED;
            PG8_STAGE(PG8_SB(0, 1), b2 + hstep, voffB);
            PG8_WAIT_V(6); PG8_BAR; PG8_MMA(1, 1, At, B1); PG8_BAR;
            PG8_LDB(B0, 1, 0); PG8_SCHED; PG8_LDA(At, 1, 0); PG8_STAGE(PG8_SA(0, 1), a2 + hstep, voffA);
            PG8_WAIT_L(8); PG8_BAR; PG8_WAIT_L(0); PG8_MMA(0, 0, At, B0); PG8_BAR; PG8_SCHED;
            PG8_LDB(B1, 1, 1); PG8_STAGE(PG8_SB(1, 0), b3, voffB);
            PG8_BAR; PG8_WAIT_L(0); PG8_MMA(0, 1, At, B1); PG8_BAR;
            PG8_LDA(At, 1, 1); PG8_STAGE(PG8_SA(1, 0), a3, voffA);
            PG8_BAR; PG8_WAIT_L(0); PG8_MMA(1, 0, At, B0); PG8_BAR; PG8_SCHED;
            PG8_STAGE(PG8_SB(1, 1), b3 + hstep, voffB);
            PG8_WAIT_V(6); PG8_BAR; PG8_MMA(1, 1, At, B1); PG8_BAR;
            }
        }
#if GP_TIME == 2
        if (wid == 0) { const unsigned long long tk1_ = __builtin_amdgcn_s_memrealtime(); if ((tid & 63) == 0) *(PG8_LAS unsigned*)(lds + 131072 + 128) += (unsigned)(tk1_ - tk0_); }
#endif
        if constexpr (ALIGN_EPI) { if (wr == 0) PG8_BAR; }
        if constexpr (!Epi::AFTER_DRAIN) { int l_; asm volatile("v_mbcnt_lo_u32_b32 %0, -1, 0\n\tv_mbcnt_hi_u32_b32 %0, -1, %0" : "=v"(l_));
#if GP_TIME == 1
            const unsigned long long te0_ = __builtin_amdgcn_s_memrealtime();
#endif
            E(acc, cur, wr, wc, l_ & 15, l_ >> 4); S.done(cur);
#if GP_TIME == 1
            asm volatile("s_waitcnt vmcnt(0)" ::: "memory");
            if (wid == 0) { const unsigned long long te1_ = __builtin_amdgcn_s_memrealtime(); if ((tid & 63) == 0) *(PG8_LAS unsigned*)(lds + 131072 + 128) += (unsigned)(te1_ - te0_); }
#endif
            }
        if (!has_next) break;
#pragma unroll
        for (int a = 0; a < 2; ++a)
#pragma unroll
            for (int b = 0; b < 2; ++b)
#pragma unroll
                for (int m = 0; m < 4; ++m)
#pragma unroll
                    for (int n = 0; n < 2; ++n) acc[a][b][m][n] = (f32x4){0.f, 0.f, 0.f, 0.f};
        cur = nxt; cA = nA; cB = nB; ++ui;
        if constexpr (ALIGN_EPI) { if (wr == 1) PG8_BAR; }
    }
    PG8_WAIT_V(0);
    if constexpr (!ALIGN_EPI) { if (wr == 0) PG8_BAR; }
    PG8_BAR;
    if constexpr (Epi::AFTER_DRAIN) { E.fused(acc, cur, wr, wc, fr, fq, lds, wid, lane); S.done(cur); }
#undef PG8_SA
#undef PG8_SB
#undef PG8_STAGE
#undef PG8_LDA
#undef PG8_LDB
#undef PG8_MMA
#undef PG8_WAIT_V
#undef PG8_WAIT_L
#undef PG8_BAR
#undef PG8_SCHED
}
}

namespace mk {
using pg8::bf16_t; using pg8::bf16x8; using pg8::f32x4; using pg8::u32x4; using pg8::u32x2; using pg8::cvt_pk_bf16; using pg8::bf_lo; using pg8::bf_hi;
#define LAS __attribute__((address_space(3)))
#define LDS_WAIT() asm volatile("s_waitcnt lgkmcnt(0)" ::: "memory")
constexpr int M = 16384, D = 1024, FF = 2816, SEQ = 2048, PLE = 256;
constexpr int NWAVES = 8, NTHREADS = 512;
constexpr int LDS_BYTES = 147456;
constexpr size_t MiB = 1u << 20, HM = 512u * 1024u;
constexpr size_t WS_CTL = 0, CTL_BYTES = 2 * MiB;
constexpr size_t WS_BAR = 4096;
constexpr int LDSCTL_OFF = 131072;
constexpr size_t WS_DBG = 64 * 1024;
constexpr size_t WS_ROWSS = 1 * MiB;
constexpr size_t WS_W = 2 * MiB;
constexpr size_t W_GU1 = 0, W_D1 = 22 * HM, W_GU2 = 33 * HM, W_D2 = 55 * HM, W_GATE = 66 * HM, W_UP = 70 * HM, W_OUT = 71 * HM, W_IN = 75 * HM, WL_STRIDE = 85 * HM;
constexpr size_t WS_WTRIL = WS_W + 2 * WL_STRIDE;
constexpr size_t WS_HB = 88 * MiB;
constexpr size_t WS_T = 120 * MiB;
constexpr size_t WS_Y = 208 * MiB;
constexpr size_t WS_PB = 240 * MiB;
constexpr size_t WS_END = 256 * MiB;
constexpr size_t WS_SNAP = 256 * MiB;
constexpr int DBG_NT = 384;
static_assert(WS_WTRIL + 131072 <= WS_HB && WS_T + (size_t)M * FF * 2 <= WS_Y, "ws map");

struct Args { const float* in[28]; float* out; unsigned char* ws; int dbg; int pad; };
enum { I_X = 0, I_P, I_FFN1_NORM, I_FFN1_WGU, I_FFN1_WD, I_MIX_NORM, I_FFN2_NORM, I_FFN2_WGU, I_FFN2_WD, I_PLE_NORM, I_PLE_WG, I_PLE_WU, I_AB_WIN, I_GM_LNG, I_GM_LNB, I_GM_WS, I_GM_BS,
       I_SC_W, I_AB_WOUT, I_CD_WIN, I_POOL_W, I_POOL_SCALE, I_CV_W, I_CV_B, I_CV_LNG, I_CV_LNB, I_CD_WOUT, I_FINAL_NORM };

typedef const __attribute__((address_space(4))) unsigned char* kargp_t;
__device__ __forceinline__ kargp_t kargs() { kargp_t p = (kargp_t)__builtin_amdgcn_kernarg_segment_ptr(); asm volatile("" : "+s"(p)); return p; }
#define KIN(i) (*(const float* const __attribute__((address_space(4)))*)(kargs() + 8 * (i)))
#define KOUT (*(float* const __attribute__((address_space(4)))*)(kargs() + 8 * 28))
#define KWS (*(unsigned char* const __attribute__((address_space(4)))*)(kargs() + 8 * 29))
#define WSP(off) (KWS + (off))
#define ROWSS(k) ((float*)WSP(WS_ROWSS) + (size_t)(k) * M)
__device__ __forceinline__ int lane_id() { int l; asm volatile("v_mbcnt_lo_u32_b32 %0, -1, 0\n\tv_mbcnt_hi_u32_b32 %0, -1, %0" : "=v"(l)); return l; }
__device__ __forceinline__ int opaque_tid(int wave_s) { int t = (wave_s << 6) | lane_id(); asm volatile("" : "+v"(t)); return t; }
__device__ __forceinline__ float wave_sum(float v) { using pg8::add_xor; return pg8::add_xor32(add_xor<16>(add_xor<8>(add_xor<4>(add_xor<2>(add_xor<1>(v)))))); }
__device__ __forceinline__ void unpack8(const u32x4& w, float (&f)[8]) { f[0] = bf_lo(w.x); f[1] = bf_hi(w.x); f[2] = bf_lo(w.y); f[3] = bf_hi(w.y); f[4] = bf_lo(w.z); f[5] = bf_hi(w.z); f[6] = bf_lo(w.w); f[7] = bf_hi(w.w); }
__device__ __forceinline__ u32x4 pack8f(const float (&f)[8]) { u32x4 w; w.x = cvt_pk_bf16(f[0], f[1]); w.y = cvt_pk_bf16(f[2], f[3]); w.z = cvt_pk_bf16(f[4], f[5]); w.w = cvt_pk_bf16(f[6], f[7]); return w; }

__device__ __forceinline__ unsigned long long rt() { return __builtin_amdgcn_s_memrealtime(); }
#define XB_TMO      128
#define XB_XCNT(j)  (256  + 64 * (j))
#define XB_XSUB(j)  (1280 + 64 * (j))
#define XB_XGEN(j)  (2304 + 64 * (j))
#define XB_TOP      3328
#define XB_TOPGEN   3392
#define XCD_BAR_WORDS 3456
#define XB_SPIN_CAP (1u << 18)

__device__ __forceinline__ unsigned xb_ld(unsigned* p)              { return __hip_atomic_load(p, __ATOMIC_RELAXED, __HIP_MEMORY_SCOPE_AGENT); }
__device__ __forceinline__ unsigned xb_add(unsigned* p, unsigned v) { return __hip_atomic_fetch_add(p, v, __ATOMIC_RELAXED, __HIP_MEMORY_SCOPE_AGENT); }
__device__ __forceinline__ unsigned xb_xcc_id() { return (unsigned)__builtin_amdgcn_s_getreg((3 << 11) | 20) & 0xFu; }
#define XB_SPIN(cond, bar) do { unsigned _sp = 0; while (cond) { __builtin_amdgcn_s_sleep(1); \
    if ((++_sp & 255u) == 0u) { if (xb_ld(&(bar)[XB_TMO])) break; if (_sp > XB_SPIN_CAP) { atomicAdd(&(bar)[XB_TMO], 1u); break; } } } } while (0)

struct XcdBarrier {
    unsigned* bar; unsigned x;
    volatile LAS unsigned* st;
};

__device__ __forceinline__ XcdBarrier xcd_barrier_post(unsigned* bar, volatile LAS unsigned* st, const bool tid0) {
    XcdBarrier b; b.bar = bar; b.x = xb_xcc_id(); b.st = st;
    if (tid0) (void)xb_add(&bar[XB_XCNT(b.x)], 1u);
    return b;
}
__device__ __forceinline__ void xcd_barrier_complete(unsigned* bar, unsigned x, unsigned& nloc, unsigned& nx) {
    const unsigned G = gridDim.x * gridDim.y * gridDim.z;
    unsigned sum, cnt, mine, sp = 0u;
    for (;;) {
        sum = 0u; cnt = 0u; mine = 0u;
#pragma unroll
        for (unsigned j = 0; j < 16; ++j) { const unsigned c = xb_ld(&bar[XB_XCNT(j)]); sum += c; cnt += (c > 0u) ? 1u : 0u; mine = (j == x) ? c : mine; }
        if (sum == G) break;
        __builtin_amdgcn_s_sleep(1);
        if ((++sp & 255u) == 0u) { if (xb_ld(&bar[XB_TMO])) break; if (sp > XB_SPIN_CAP) { atomicAdd(&bar[XB_TMO], 1u); break; } }
    }
    nloc = mine > 0u ? mine : 1u; nx = cnt > 0u ? cnt : 1u;
}

__device__ __forceinline__ void xcd_barrier(const XcdBarrier& b, const int wave_s) {
    asm volatile("s_waitcnt vmcnt(0)" ::: "memory");
    __syncthreads();
    if (wave_s == 0 && lane_id() == 0) {
        unsigned* bar = b.bar; unsigned xq = b.x; asm volatile("" : "+s"(xq));
        __builtin_amdgcn_s_waitcnt(0);
        unsigned nloc = b.st[0], nx = b.st[1];
        if (nloc == 0u) { xcd_barrier_complete(bar, xq, nloc, nx); b.st[0] = nloc; b.st[1] = nx; }
        const unsigned old = xb_add(&bar[XB_XSUB(xq)], 1u);
        const unsigned gen = old / nloc;
        if (old + 1u == (gen + 1u) * nloc) {
            __builtin_amdgcn_fence(__ATOMIC_RELEASE, "agent");
            asm volatile("s_waitcnt vmcnt(0)" ::: "memory");
            const unsigned og = xb_add(&bar[XB_TOP], 1u);
            const unsigned tg = og / nx;
            if (og + 1u == (tg + 1u) * nx) xb_add(&bar[XB_TOPGEN], 1u);
            else XB_SPIN(xb_ld(&bar[XB_TOPGEN]) == tg, bar);
            __builtin_amdgcn_fence(__ATOMIC_ACQUIRE, "agent");
            xb_add(&bar[XB_XGEN(xq)], 1u);
            asm volatile("s_waitcnt vmcnt(0)" ::: "memory");
        } else {
            XB_SPIN(xb_ld(&bar[XB_XGEN(xq)]) == gen, bar);
            __builtin_amdgcn_fence(__ATOMIC_ACQUIRE, "agent");
            asm volatile("s_waitcnt vmcnt(0)" ::: "memory");
        }
    }
    __syncthreads();
}

struct TrItem { const float* src; const float* gain; bf16_t* dstblk; int ldsrc, lddst, k0; };
__device__ __forceinline__ void tr_load(const TrItem& t, f32x4 (&v)[8], float (&gn)[8], int lane) {
    const int r8 = lane >> 3, c4 = (lane & 7) * 4;
#pragma unroll
    for (int i = 0; i < 8; ++i) { v[i] = *(const f32x4*)(t.src + (size_t)(t.k0 + 8 * i + r8) * t.ldsrc + c4); gn[i] = t.gain ? t.gain[t.k0 + 8 * i + r8] : 1.0f; }
}
__device__ __forceinline__ void tr_store(const TrItem& t, const f32x4 (&v)[8], const float (&gn)[8], LAS float* scr, int lane) {
    const int r8 = lane >> 3, c4 = (lane & 7) * 4;
#pragma unroll
    for (int i = 0; i < 8; ++i) { LAS float* s = scr + (8 * i + r8) * 33 + c4; const f32x4 x = v[i] * gn[i]; s[0] = x[0]; s[1] = x[1]; s[2] = x[2]; s[3] = x[3]; }
    LDS_WAIT(); asm volatile("" ::: "memory");
    const int c = lane & 7;
#pragma unroll
    for (int j = 0; j < 4; ++j) { const int n = (lane >> 3) + 8 * j; const LAS float* s = scr + (8 * c) * 33 + n;
        u32x4 o; o.x = cvt_pk_bf16(s[0 * 33], s[1 * 33]); o.y = cvt_pk_bf16(s[2 * 33], s[3 * 33]); o.z = cvt_pk_bf16(s[4 * 33], s[5 * 33]); o.w = cvt_pk_bf16(s[6 * 33], s[7 * 33]);
        *(u32x4*)(t.dstblk + (size_t)n * t.lddst + t.k0 + 8 * c) = o; }
    LDS_WAIT(); asm volatile("" ::: "memory");
}
__device__ __forceinline__ int map_col(int map, int R) {
    if (map == 0) return R;
    if (map == 1) { const int pn = R >> 8, w = R & 255; return w < 128 ? 128 * pn + w : 2816 + 128 * pn + (w - 128); }
    if (map == 2) { if (R < 1024) return R; if (R < 2048) { const int t = (R - 1024) >> 8, w = (R - 1024) & 255; return w < 128 ? 1536 + 128 * t + w : 2048 + 128 * t + (w - 128); } return 1024 + (R - 2048); }
    if (R < 512) return R; { const int t = (R - 512) >> 8, w = (R - 512) & 255; return w < 128 ? 512 + 128 * t + w : 1024 + 128 * t + (w - 128); }
}
__device__ __forceinline__ void fold_item(LAS unsigned char* lds, int item, int tid) {
    const int g = item >> 5, nt = item & 31;
    const float* pw = KIN(I_POOL_W) + (size_t)g * 16384; const float* sc = KIN(I_POOL_SCALE) + 128 * g; const float* wo = KIN(I_CD_WOUT) + (size_t)(128 * g) * D + 32 * nt;
    bf16_t* dst = (bf16_t*)WSP(WS_W + WL_STRIDE + W_OUT);
    LAS float* Ps = (LAS float*)lds;
    {
        const int c = tid >> 2, d0 = (tid & 3) * 32;
#pragma unroll
        for (int j = 0; j < 8; ++j) { const f32x4 v = *(const f32x4*)(pw + c * 128 + d0 + 4 * j), s4 = *(const f32x4*)(sc + d0 + 4 * j);
#pragma unroll
            for (int e = 0; e < 4; ++e) Ps[(d0 + 4 * j + e) * 128 + c] = v[e] * s4[e]; }
    }
    __syncthreads();
    {
        const int n = tid & 31, cb = (tid >> 5) * 8; float acc[8];
#pragma unroll
        for (int e = 0; e < 8; ++e) acc[e] = 0.f;
#pragma unroll 8
        for (int d = 0; d < 128; ++d) { const float wv = wo[(size_t)d * D + n]; const LAS f32x4* pp = (const LAS f32x4*)(Ps + d * 128 + cb); const f32x4 p0 = pp[0], p1 = pp[1];
#pragma unroll
            for (int e = 0; e < 4; ++e) { acc[e] = fmaf(p0[e], wv, acc[e]); acc[4 + e] = fmaf(p1[e], wv, acc[4 + e]); } }
        *(u32x4*)(dst + (size_t)(32 * nt + n) * D + 128 * g + cb) = pack8f(acc);
    }
    __syncthreads();
}
enum : unsigned { JB_GU1 = 1u, JB_D1 = 2u, JB_GU2 = 4u, JB_D2 = 8u, JB_GATE = 16u, JB_UP = 32u, JB_OUT = 64u, JB_IN = 128u, JB_TRIL = 1u << 16, JB_FOLD = 1u << 17, JB_PB0 = 1u << 18, JB_PB1 = 1u << 19, JB_XHB = 1u << 20 };
__device__ __forceinline__ int job_items(int j) {
    const int L = j >> 3, k = j & 7;
    return k == 0 || k == 2 ? 16 * 176 : k == 1 || k == 3 ? 44 * 32 : k == 4 ? 16 * 32 : k == 5 ? 4 * 32 : k == 6 ? (L == 0 ? 16 * 32 : 8 * 32) : (L == 0 ? 16 * 80 : 16 * 48);
}
__device__ __forceinline__ void convert_jobs(LAS unsigned char* lds, const unsigned mask, int wi, int nw, int wave) {
    asm volatile("" : "+s"(wi), "+s"(nw), "+s"(wave));
    const int tid = opaque_tid(wave), lane = tid & 63;
    if (mask & JB_FOLD) for (int item = wi; item < 128; item += nw) fold_item(lds, item, tid);
    LAS float* scr = (LAS float*)(lds + wave * 16384);
    const int gw = wi * NWAVES + wave, NGW = nw * NWAVES;
    int total = 0;
#pragma unroll
    for (int j = 0; j < 16; ++j) if (mask & (1u << j)) total += job_items(j);
#define TR_DECODE(it_, T_) do { int r = (it_), j = 0; \
        _Pragma("unroll") for (int jj = 0; jj < 16; ++jj) if (mask & (1u << jj)) { const int n = job_items(jj); if (r >= 0 && r < n) { j = jj; r -= 0x40000000; } else if (r >= 0) r -= n; } \
        r += 0x40000000; \
        const int L = j >> 3, k = j & 7; const size_t wl = WS_W + (size_t)L * WL_STRIDE; \
        const float* src; const float* gain = nullptr; bf16_t* dst; int ldsrc, lddst, nblk, map = 0; \
        if (k == 0) { src = KIN(I_FFN1_WGU) + (size_t)L * D * 2 * FF; gain = KIN(I_FFN1_NORM) + L * D; dst = (bf16_t*)WSP(wl + W_GU1); ldsrc = 2 * FF; lddst = D; nblk = 176; map = 1; } \
        else if (k == 1) { src = KIN(I_FFN1_WD) + (size_t)L * FF * D; dst = (bf16_t*)WSP(wl + W_D1); ldsrc = D; lddst = FF; nblk = 32; } \
        else if (k == 2) { src = KIN(I_FFN2_WGU) + (size_t)L * D * 2 * FF; gain = KIN(I_FFN2_NORM) + L * D; dst = (bf16_t*)WSP(wl + W_GU2); ldsrc = 2 * FF; lddst = D; nblk = 176; map = 1; } \
        else if (k == 3) { src = KIN(I_FFN2_WD) + (size_t)L * FF * D; dst = (bf16_t*)WSP(wl + W_D2); ldsrc = D; lddst = FF; nblk = 32; } \
        else if (k == 4) { src = KIN(I_PLE_WG) + (size_t)L * D * D; gain = KIN(I_PLE_NORM) + L * D; dst = (bf16_t*)WSP(wl + W_GATE); ldsrc = D; lddst = D; nblk = 32; } \
        else if (k == 5) { src = KIN(I_PLE_WU) + (size_t)L * PLE * D; dst = (bf16_t*)WSP(wl + W_UP); ldsrc = D; lddst = PLE; nblk = 32; } \
        else if (k == 6) { if (L == 0) { src = KIN(I_AB_WOUT); dst = (bf16_t*)WSP(wl + W_OUT); } else { src = KIN(I_CD_WOUT) + (size_t)512 * D; dst = (bf16_t*)WSP(wl + W_OUT) + 512; }   \
                           ldsrc = D; lddst = D; nblk = 32; } \
        else { if (L == 0) { src = KIN(I_AB_WIN); ldsrc = 2560; nblk = 80; map = 2; } else { src = KIN(I_CD_WIN); ldsrc = 1536; nblk = 48; map = 3; } \
               gain = KIN(I_MIX_NORM) + L * D; dst = (bf16_t*)WSP(wl + W_IN); lddst = D; } \
        const int kb = r / nblk, nb = r - kb * nblk, R = 32 * nb; \
        T_.src = src + map_col(map, R); T_.gain = gain; T_.dstblk = dst + (size_t)R * lddst; T_.ldsrc = ldsrc; T_.lddst = lddst; T_.k0 = 64 * kb; } while (0)
    if (gw < total) {
        TrItem ta, tb; f32x4 va[8], vb[8]; float ga[8], gb[8];
        int it = gw; const int last = total - 1;
        TR_DECODE(it, ta); tr_load(ta, va, ga, lane);
        for (;;) {
            { const int nx = it + NGW < total ? it + NGW : last; TR_DECODE(nx, tb); tr_load(tb, vb, gb, lane); }
            tr_store(ta, va, ga, scr, lane);
            it += NGW; if (it >= total) break;
            { const int nx = it + NGW < total ? it + NGW : last; TR_DECODE(nx, ta); tr_load(ta, va, ga, lane); }
            tr_store(tb, vb, gb, scr, lane);
            it += NGW; if (it >= total) break;
        }
    }
#undef TR_DECODE
    if (mask & JB_XHB) {
        const float* x = KIN(I_X); bf16_t* hb = (bf16_t*)WSP(WS_HB); float* rowss0 = (float*)WSP(WS_ROWSS);
        for (int row = 2 * gw; row < M; row += 2 * NGW) {
            const f32x4* xr = (const f32x4*)(x + (size_t)row * D) + lane; u32x2* o = (u32x2*)(hb + (size_t)row * D) + lane; f32x4 v[8];
#pragma unroll
            for (int j = 0; j < 8; ++j) v[j] = xr[64 * j];
            float ss0 = 0.f, ss1 = 0.f;
#pragma unroll
            for (int j = 0; j < 4; ++j) { ss0 += v[j][0] * v[j][0] + v[j][1] * v[j][1] + v[j][2] * v[j][2] + v[j][3] * v[j][3]; ss1 += v[4 + j][0] * v[4 + j][0] + v[4 + j][1] * v[4 + j][1] + v[4 + j][2] * v[4 + j][2] + v[4 + j][3] * v[4 + j][3]; }
#pragma unroll
            for (int j = 0; j < 8; ++j) { u32x2 w; w.x = cvt_pk_bf16(v[j][0], v[j][1]); w.y = cvt_pk_bf16(v[j][2], v[j][3]); o[64 * j] = w; }
            ss0 = wave_sum(ss0); ss1 = wave_sum(ss1);
            if (lane == 0) { rowss0[row] = ss0; rowss0[row + 1] = ss1; }
        }
    }
    const int gt = gw * 64 + lane, NGT = NGW * 64;
#pragma unroll
    for (int L = 0; L < 2; ++L) if (mask & (L == 0 ? JB_PB0 : JB_PB1)) {
        const float* p = KIN(I_P) + (size_t)L * M * PLE; bf16_t* pb = (bf16_t*)WSP(WS_PB) + (size_t)L * M * PLE; constexpr int Q4 = M * PLE / 32;
        for (int t = gt; t < Q4; t += NGT) { f32x4 v[8];
#pragma unroll
            for (int j = 0; j < 4; ++j) { const size_t e = ((size_t)t + (size_t)j * Q4) * 8; v[2 * j] = *(const f32x4*)(p + e); v[2 * j + 1] = *(const f32x4*)(p + e + 4); }
#pragma unroll
            for (int j = 0; j < 4; ++j) { const size_t e = ((size_t)t + (size_t)j * Q4) * 8; *(u32x4*)(pb + e) = pg8::pack8(v[2 * j], v[2 * j + 1]); } }
    }
    if (mask & JB_TRIL) {
        const float* w = KIN(I_GM_WS); bf16_t* wt = (bf16_t*)WSP(WS_WTRIL);
        for (int t = gt; t < 4 * 128 * 128 / 8; t += NGT) { const int e0 = t * 8, tt = (e0 >> 7) & 127, s0 = e0 & 127; float f[8];
#pragma unroll
            for (int j = 0; j < 8; ++j) f[j] = (s0 + j <= tt) ? w[e0 + j] : 0.f;
            *(u32x4*)(wt + e0) = pack8f(f); }
    }
    __syncthreads();
}
constexpr unsigned JM_ALL = 0xffffu | JB_TRIL | JB_FOLD | JB_PB0 | JB_PB1 | JB_XHB;
constexpr unsigned JM_PREP = JB_XHB | JB_GU1 | (JB_GU1 << 8);
constexpr unsigned JM_B1 = JB_D1 | JB_IN | JB_OUT | JB_TRIL | JB_D2 | JB_GATE;
constexpr unsigned JM_B2 = JB_GU2 | JB_UP | JB_PB0;
constexpr unsigned JM_B3 = ((JB_D1 | JB_IN | JB_OUT | JB_D2 | JB_GATE) << 8) | JB_FOLD;
constexpr unsigned JM_B4 = ((JB_GU2 | JB_UP) << 8) | JB_PB1;
static_assert((JM_PREP | JM_B1 | JM_B2 | JM_B3 | JM_B4) == JM_ALL && (JM_PREP & JM_B1) == 0 && ((JM_PREP | JM_B1) & JM_B2) == 0 && ((JM_PREP | JM_B1 | JM_B2) & JM_B3) == 0 && ((JM_PREP | JM_B1 | JM_B2 | JM_B3) & JM_B4) == 0, "every job exactly once");

__device__ __forceinline__ void mix0_phase(LAS unsigned char* lds, int vcu, int G, int wave) {
    asm volatile("" : "+s"(vcu), "+s"(G), "+s"(wave));
    const int tid = opaque_tid(wave), lane = tid & 63;
    unsigned char* ws = KWS;
    const bf16_t* UV = (const bf16_t*)(ws + WS_T); const bf16_t* Q = UV + (size_t)M * 1024; const bf16_t* BG = Q + (size_t)M * 512;
    bf16_t* Y = (bf16_t*)(ws + WS_Y); const bf16_t* Wtril = (const bf16_t*)(ws + WS_WTRIL);
    LAS bf16_t* vgT = (LAS bf16_t*)lds;
    const int fr = lane & 15, fq = lane >> 4;
    for (int item = vcu; item < 512; item += G) {
        const int c = item >> 2, g = item & 3;
        {
            const int tok = tid >> 2, qt = tid & 3;
            const u32x4* src = (const u32x4*)(UV + (size_t)(c * 128 + tok) * 1024 + 512 + g * 128 + qt * 32);
            float v[32];
#pragma unroll
            for (int j = 0; j < 4; ++j) { const u32x4 w = src[j]; float f[8]; unpack8(w, f);
#pragma unroll
                for (int e = 0; e < 8; ++e) v[8 * j + e] = f[e]; }
            float s = 0.f;
#pragma unroll
            for (int i = 0; i < 32; ++i) s += v[i];
            s = pg8::add_xor<2>(pg8::add_xor<1>(s));
            const float mean = s * (1.0f / 128.0f); float q = 0.f;
#pragma unroll
            for (int i = 0; i < 32; ++i) { v[i] -= mean; q += v[i] * v[i]; }
            q = pg8::add_xor<2>(pg8::add_xor<1>(q));
            const float rstd = __builtin_amdgcn_rsqf(q * (1.0f / 128.0f) + 1e-5f);
            const float* lg = KIN(I_GM_LNG) + g * 128 + qt * 32; const float* lb = KIN(I_GM_LNB) + g * 128 + qt * 32;
#pragma unroll
            for (int i = 0; i < 32; ++i) { const float val = v[i] * rstd * lg[i] + lb[i]; vgT[(qt * 32 + i) * 136 + tok] = (bf16_t)(cvt_pk_bf16(val, 0.f) & 0xffffu); }
        }
        __syncthreads();
        {
            f32x4 acc[8];
#pragma unroll
            for (int nt = 0; nt < 8; ++nt) acc[nt] = (f32x4){0.f, 0.f, 0.f, 0.f};
            const int nks = ((16 * wave + 15) >> 5) + 1;
            const bf16_t* wrow = Wtril + (size_t)g * 16384 + (16 * wave + fr) * 128 + 8 * fq;
            for (int ks = 0; ks < nks; ++ks) {
                const bf16x8 wf = *(const bf16x8*)(wrow + 32 * ks);
#pragma unroll
                for (int nt = 0; nt < 8; ++nt) { const bf16x8 vf = *(const LAS bf16x8*)(vgT + (16 * nt + fr) * 136 + 32 * ks + 8 * fq);
                    acc[nt] = __builtin_amdgcn_mfma_f32_16x16x32_bf16(vf, wf, acc[nt], 0, 0, 0); }
            }
            const int t = 16 * wave + fr; const size_t row = (size_t)c * 128 + t; const float bias = KIN(I_GM_BS)[g * 128 + t];
#pragma unroll
            for (int nt = 0; nt < 8; ++nt) { const int d = 16 * nt + 4 * fq; const u32x2 uu = *(const u32x2*)(UV + row * 1024 + g * 128 + d);
                u32x2 o; o.x = cvt_pk_bf16(bf_lo(uu.x) * (acc[nt][0] + bias), bf_hi(uu.x) * (acc[nt][1] + bias)); o.y = cvt_pk_bf16(bf_lo(uu.y) * (acc[nt][2] + bias), bf_hi(uu.y) * (acc[nt][3] + bias));
                *(u32x2*)(Y + row * 1024 + g * 128 + d) = o; }
        }
        __syncthreads();
    }
    for (int wi = vcu * NWAVES + wave; wi < M / 8; wi += G * NWAVES) {
        const int r0 = wi * 8, pos0 = r0 & (SEQ - 1);
        const float* sw = KIN(I_SC_W) + 8 * lane; float w0[8], w1[8], w2[8];
#pragma unroll
        for (int e = 0; e < 8; ++e) { w0[e] = sw[e]; w1[e] = sw[512 + e]; w2[e] = sw[1024 + e]; }
        float qm2[8], qm1[8];
#pragma unroll
        for (int e = 0; e < 8; ++e) { qm2[e] = 0.f; qm1[e] = 0.f; }
        if (pos0 != 0) { unpack8(*(const u32x4*)(Q + (size_t)(r0 - 2) * 512 + 8 * lane), qm2); unpack8(*(const u32x4*)(Q + (size_t)(r0 - 1) * 512 + 8 * lane), qm1); }
#pragma unroll
        for (int t = 0; t < 8; ++t) { float qv[8], bg[8], y[8]; unpack8(*(const u32x4*)(Q + (size_t)(r0 + t) * 512 + 8 * lane), qv); unpack8(*(const u32x4*)(BG + (size_t)(r0 + t) * 512 + 8 * lane), bg);
#pragma unroll
            for (int e = 0; e < 8; ++e) { y[e] = bg[e] * (w0[e] * qm2[e] + w1[e] * qm1[e] + w2[e] * qv[e]); qm2[e] = qm1[e]; qm1[e] = qv[e]; }
            *(u32x4*)(Y + (size_t)(r0 + t) * 1024 + 512 + 8 * lane) = pack8f(y); }
    }
}

__device__ __forceinline__ void mix1_phase(LAS unsigned char* lds, int vcu, int G, int wave) {
    asm volatile("" : "+s"(vcu), "+s"(G), "+s"(wave));
    const int tid = opaque_tid(wave), lane = tid & 63;
    unsigned char* ws = KWS;
    const bf16_t* ZC = (const bf16_t*)(ws + WS_T); const bf16_t* S = ZC + (size_t)M * 512; bf16_t* Y = (bf16_t*)(ws + WS_Y);
    for (int r = vcu * NWAVES + wave; r < M; r += G * NWAVES) {
        const int pos = r & (SEQ - 1), win = 2 << (lane >> 4), cnt = (pos + 1 < win) ? pos + 1 : win;
        float sum[8], x0[8];
        unpack8(*(const u32x4*)(ZC + (size_t)r * 512 + 8 * lane), x0);
#pragma unroll
        for (int e = 0; e < 8; ++e) sum[e] = x0[e];
        for (int k = 1; k < 16; ++k) { if (k < cnt) { float f[8]; unpack8(*(const u32x4*)(ZC + (size_t)(r - k) * 512 + 8 * lane), f);
#pragma unroll
                for (int e = 0; e < 8; ++e) sum[e] += f[e]; } }
        const float inv = 1.0f / (float)cnt; float y[8];
#pragma unroll
        for (int e = 0; e < 8; ++e) y[e] = sum[e] * inv - x0[e];
        *(u32x4*)(Y + (size_t)r * 1024 + 8 * lane) = pack8f(y);
    }
    LAS unsigned char* sl = lds;
    LAS float* hbuf = (LAS float*)(lds + 62 * 1024);
    const int cp = tid & 255, half = tid >> 8;
    float cw[31][2];
#pragma unroll
    for (int k = 0; k < 31; ++k) { cw[k][0] = KIN(I_CV_W)[k * 512 + 2 * cp]; cw[k][1] = KIN(I_CV_W)[k * 512 + 2 * cp + 1]; }
    const float cb0 = KIN(I_CV_B)[2 * cp], cb1 = KIN(I_CV_B)[2 * cp + 1];
    for (int item = vcu; item < M / 32; item += G) {
        const int t0 = item * 32, pos0 = t0 & (SEQ - 1);
#pragma unroll
        for (int ps = 0; ps < 8; ++ps) { const int row = ps * 8 + (tid >> 6);
            if (row < 62) { u32x4 v = (u32x4){0u, 0u, 0u, 0u}; if (pos0 - 30 + row >= 0) v = *(const u32x4*)(S + (size_t)(t0 - 30 + row) * 512 + 8 * (tid & 63));
                *(LAS u32x4*)(sl + row * 1024 + (tid & 63) * 16) = v; } }
        __syncthreads();
#pragma unroll
        for (int run = 0; run < 2; ++run) {
            const int tl = half * 16 + run * 8;
            float acc[8][2];
#pragma unroll
            for (int o = 0; o < 8; ++o) { acc[o][0] = cb0; acc[o][1] = cb1; }
#pragma unroll
            for (int i = 0; i < 38; ++i) { const unsigned w = *(const LAS unsigned*)(sl + (tl + i) * 1024 + cp * 4); const float x0 = bf_lo(w), x1 = bf_hi(w);
#pragma unroll
                for (int o = 0; o < 8; ++o) { const int k = i - o; if (k >= 0 && k < 31) { acc[o][0] = fmaf(cw[k][0], x0, acc[o][0]); acc[o][1] = fmaf(cw[k][1], x1, acc[o][1]); } } }
#pragma unroll
            for (int o = 0; o < 8; ++o) { typedef float f32x2v __attribute__((ext_vector_type(2))); *(LAS f32x2v*)(hbuf + (tl + o) * 512 + 2 * cp) = (f32x2v){acc[o][0], acc[o][1]}; }
        }
        __syncthreads();
#pragma unroll
        for (int tt = 0; tt < 4; ++tt) { const int tl = wave * 4 + tt; const LAS f32x4* hp = (const LAS f32x4*)(hbuf + tl * 512 + 8 * lane); const f32x4 h0 = hp[0], h1 = hp[1];
            float s = (h0[0] + h0[1]) + (h0[2] + h0[3]) + (h1[0] + h1[1]) + (h1[2] + h1[3]); s = wave_sum(s);
            const float mean = s * (1.0f / 512.0f); const f32x4 d0 = h0 - mean, d1 = h1 - mean;
            float q = (d0[0] * d0[0] + d0[1] * d0[1]) + (d0[2] * d0[2] + d0[3] * d0[3]) + (d1[0] * d1[0] + d1[1] * d1[1]) + (d1[2] * d1[2] + d1[3] * d1[3]); q = wave_sum(q);
            const float rstd = __builtin_amdgcn_rsqf(q * (1.0f / 512.0f) + 1e-5f);
            const f32x4 g0 = *(const f32x4*)(KIN(I_CV_LNG) + 8 * lane), g1 = *(const f32x4*)(KIN(I_CV_LNG) + 8 * lane + 4), b0 = *(const f32x4*)(KIN(I_CV_LNB) + 8 * lane), b1 = *(const f32x4*)(KIN(I_CV_LNB) + 8 * lane + 4);
            float y[8];
#pragma unroll
            for (int e = 0; e < 4; ++e) { y[e] = pg8::fsilu(d0[e] * rstd * g0[e] + b0[e]); y[4 + e] = pg8::fsilu(d1[e] * rstd * g1[e] + b1[e]); }
            *(u32x4*)(Y + (size_t)(t0 + tl) * 1024 + 512 + 8 * lane) = pack8f(y); }
        __syncthreads();
    }
}

__device__ __forceinline__ void final_phase(int vcu, int G, int wave) {
    asm volatile("" : "+s"(vcu), "+s"(G), "+s"(wave));
    const int tid = opaque_tid(wave), lane = tid & 63;
    const int gw = vcu * NWAVES + wave, NGW = G * NWAVES; const f32x4* g4 = (const f32x4*)KIN(I_FINAL_NORM) + lane;
    for (int row = gw; row < M; row += NGW) { f32x4* xr = (f32x4*)(KOUT + (size_t)row * D) + lane; f32x4 v[4]; float ss = 0.f;
#pragma unroll
        for (int j = 0; j < 4; ++j) { v[j] = xr[64 * j]; ss += v[j][0] * v[j][0] + v[j][1] * v[j][1] + v[j][2] * v[j][2] + v[j][3] * v[j][3]; }
        ss = wave_sum(ss); const float r = pg8::rstd_of(ss);
#pragma unroll
        for (int j = 0; j < 4; ++j) xr[64 * j] = v[j] * r * g4[64 * j]; }
}

#if DBG
__device__ __forceinline__ void dbg_compare(int cp, int vcu, int G, int wave) {
    asm volatile("" : "+s"(vcu), "+s"(G), "+s"(wave));
    const int tid = opaque_tid(wave), lane = tid & 63;
    const bf16_t* snap = (const bf16_t*)(KWS + WS_SNAP) + (size_t)cp * DBG_NT * D; float* res = (float*)(KWS + WS_DBG);
    for (int row = vcu * NWAVES + wave; row < DBG_NT; row += G * NWAVES) { float e2 = 0.f, r2 = 0.f;
        for (int j = 0; j < 16; ++j) { const int c = lane + 64 * j; const float hv = KOUT[(size_t)row * D + c]; const float sv = __uint_as_float((unsigned)snap[(size_t)row * D + c] << 16); e2 += (hv - sv) * (hv - sv); r2 += sv * sv; }
        e2 = wave_sum(e2); r2 = wave_sum(r2);
        if (lane == 0) { atomicAdd(res + 2 * cp, e2); atomicAdd(res + 2 * cp + 1, r2); } }
}
#endif

__global__ void __launch_bounds__(NTHREADS, 2) mk_fwd(Args a_unused) {
    extern __shared__ __attribute__((aligned(16))) unsigned char lds_raw[];
    LAS unsigned char* lds = (LAS unsigned char*)lds_raw;
    cg::grid_group grid = cg::this_grid();
    const int wave_s = __builtin_amdgcn_readfirstlane(threadIdx.x >> 6);
    const int G = gridDim.x, bx = blockIdx.x;
    const int vcu = (G % 8 == 0) ? (bx % 8) * (G / 8) + bx / 8 : bx;
    const bool bub = (G == 256);
    const int bwi = (bx & 7) * 16 + ((bx >> 3) - 16);
    for (int u = threadIdx.x; u < 64; u += NTHREADS) ((LAS unsigned*)(lds + LDSCTL_OFF))[u] = 0u;
    __syncthreads();
    const XcdBarrier xbar = xcd_barrier_post((unsigned*)WSP(WS_BAR), (volatile LAS unsigned*)(lds + LDSCTL_OFF + 32), threadIdx.x == 0);
#define GRID_SYNC() xcd_barrier(xbar, wave_s)
#if DBG
    int dcp = 0;
#define DBG_CP() do { dbg_compare(dcp, vcu, G, wave_s); ++dcp; GRID_SYNC(); } while (0)
#else
#define DBG_CP() do { } while (0)
#endif
#define GEMM_PHASE(EPI, A_, B_, N_, K_, ...) GEMM_PHASE_X(EPI, G, bx, A_, B_, N_, K_, __VA_ARGS__)
#define GEMM_PHASE_X(EPI, GX_, CX_, A_, B_, N_, K_, ...) do { int G_ = (GX_), bx_ = (CX_), w_ = wave_s; asm volatile("" : "+s"(G_), "+s"(bx_), "+s"(w_));     \
        pg8::Gemm g_{(const bf16_t*)(A_), (const bf16_t*)(B_), M, (N_), (K_)}; pg8::StaticOrder S_; S_.init(M, (N_), G_, bx_); \
        pg8::EPI E_{__VA_ARGS__}; pg8::gemm_phase<pg8::EPI, pg8::StaticOrder, GP_ALIGN, GP_SP2>(lds, g_, S_, E_, w_); } while (0)

#if STAMPS
    unsigned long long st_[6]; int sti_ = 0;
#define STAMP_AT() do { if (sti_ < 6) st_[sti_] = rt(); ++sti_; } while (0)
#else
#define STAMP_AT() do { } while (0)
#endif
    STAMP_AT();
#pragma unroll 1
    for (int rep = 0; rep < (PROBE == 1 ? 2 : 1); ++rep) {
    convert_jobs(lds, bub ? JM_PREP : JM_ALL, vcu, G, wave_s);
    if (G == 0x7fffffff) grid.sync();
    GRID_SYNC();
    }
    STAMP_AT();
#if PROBE == 8
#undef GRID_SYNC
#define GRID_SYNC() do { xcd_barrier(xbar, wave_s); xcd_barrier(xbar, wave_s); } while (0)
#endif

#pragma unroll 1
    for (int L = 0; L < 2; ++L) {
        const size_t wl = WS_W + (size_t)L * WL_STRIDE;
        const int cur = 4 * L;
#pragma unroll 1
        for (int rep = 0; rep < (PROBE == 2 ? 2 : 1); ++rep) {
        GEMM_PHASE(EpiSwiglu, WSP(WS_HB), WSP(wl + W_GU1), 2 * FF, D, (bf16_t*)WSP(WS_T), ROWSS(cur));
        if (bub && bx >= 128 && rep == 0) { if (L == 0) convert_jobs(lds, JM_B1, bwi, 128, wave_s); else convert_jobs(lds, JM_B3, bwi, 128, wave_s); }
        GRID_SYNC();
        }
        if (PROBE == 3) { GEMM_PHASE(EpiResDry, WSP(WS_T), WSP(wl + W_D1), D, FF, L == 0 ? KIN(I_X) : KOUT, KOUT, (bf16_t*)WSP(WS_HB), ROWSS(cur + 1), 0.5f); GRID_SYNC(); }
        GEMM_PHASE(EpiRes, WSP(WS_T), WSP(wl + W_D1), D, FF, L == 0 ? KIN(I_X) : KOUT, KOUT, (bf16_t*)WSP(WS_HB), ROWSS(cur + 1), 0.5f);
        GRID_SYNC();
        DBG_CP();
#pragma unroll 1
        for (int rep = 0; rep < (PROBE == 4 ? 2 : 1); ++rep) {
        if (L == 0) GEMM_PHASE(EpiMix0, WSP(WS_HB), WSP(wl + W_IN), 2560, D, ROWSS(cur + 1), (bf16_t*)WSP(WS_T), (bf16_t*)WSP(WS_T) + (size_t)M * 1024, (bf16_t*)WSP(WS_T) + (size_t)M * 1536);
        else GEMM_PHASE(EpiMix1, WSP(WS_HB), WSP(wl + W_IN), 1536, D, ROWSS(cur + 1), (bf16_t*)WSP(WS_T), (bf16_t*)WSP(WS_T) + (size_t)M * 512);
        if (bub && bx >= 128 && rep == 0) { if (L == 0) convert_jobs(lds, JM_B2, bwi, 128, wave_s); else convert_jobs(lds, JM_B4, bwi, 128, wave_s); }
        GRID_SYNC();
        }
#pragma unroll 1
        for (int rep = 0; rep < (PROBE == 5 ? 2 : 1); ++rep) {
        if (L == 0) mix0_phase(lds, vcu, G, wave_s); else mix1_phase(lds, vcu, G, wave_s);
        GRID_SYNC();
        }
        if (PROBE == 6) { GEMM_PHASE(EpiResDry, WSP(WS_Y), WSP(wl + W_OUT), D, D, KOUT, KOUT, (bf16_t*)WSP(WS_HB), ROWSS(cur + 2), 1.0f); GRID_SYNC(); }
        GEMM_PHASE(EpiRes, WSP(WS_Y), WSP(wl + W_OUT), D, D, KOUT, KOUT, (bf16_t*)WSP(WS_HB), ROWSS(cur + 2), 1.0f);
        GRID_SYNC();
        DBG_CP();
#pragma unroll 1
        for (int rep = 0; rep < (PROBE == 2 ? 2 : 1); ++rep) {
        GEMM_PHASE(EpiSwiglu, WSP(WS_HB), WSP(wl + W_GU2), 2 * FF, D, (bf16_t*)WSP(WS_T), ROWSS(cur + 2));
#pragma unroll 1
        for (int rep2 = 0; rep2 < (PROBE == 7 ? 2 : 1); ++rep2) {
            if (G == 256) { if (bx >= 128) GEMM_PHASE_X(EpiPlain, 128, bx - 128, (const bf16_t*)WSP(WS_PB) + (size_t)L * M * PLE, WSP(wl + W_UP), D, PLE, (bf16_t*)WSP(WS_Y)); }
            else GEMM_PHASE(EpiPlain, (const bf16_t*)WSP(WS_PB) + (size_t)L * M * PLE, WSP(wl + W_UP), D, PLE, (bf16_t*)WSP(WS_Y));
        }
        GRID_SYNC();
        }
        if (PROBE == 3) { GEMM_PHASE(EpiResDry, WSP(WS_T), WSP(wl + W_D2), D, FF, KOUT, KOUT, (bf16_t*)WSP(WS_HB), ROWSS(cur + 3), 0.5f); GRID_SYNC(); }
        GEMM_PHASE(EpiRes, WSP(WS_T), WSP(wl + W_D2), D, FF, KOUT, KOUT, (bf16_t*)WSP(WS_HB), ROWSS(cur + 3), 0.5f);
        GRID_SYNC();
        DBG_CP();
        if (PROBE == 6) { GEMM_PHASE(EpiPleDry, WSP(WS_HB), WSP(wl + W_GATE), D, D, ROWSS(cur + 3), (const bf16_t*)WSP(WS_Y), KOUT, L == 0 ? (bf16_t*)WSP(WS_HB) : (bf16_t*)nullptr, L == 0 ? ROWSS(cur + 4) : (float*)nullptr); GRID_SYNC(); }
        GEMM_PHASE(EpiPle, WSP(WS_HB), WSP(wl + W_GATE), D, D, ROWSS(cur + 3), (const bf16_t*)WSP(WS_Y), KOUT, L == 0 ? (bf16_t*)WSP(WS_HB) : (bf16_t*)nullptr, L == 0 ? ROWSS(cur + 4) : (float*)nullptr);
        GRID_SYNC();
        DBG_CP();
    }
    STAMP_AT();
#if STAMPS == 3
    final_phase(vcu, G, wave_s); GRID_SYNC(); STAMP_AT();
#endif
#if STAMPS
    {
#if STAMPS == 4
        if (bx == 0) { const unsigned long long d_ = *(volatile LAS unsigned*)(lds + LDSCTL_OFF + 128), t_ = rt(); while (rt() - t_ < d_) __builtin_amdgcn_s_sleep(8); }
#else
        if (bx == 0) { const unsigned long long d_ = st_[STAMPS] - st_[STAMPS - 1], t_ = rt(); while (rt() - t_ < d_) __builtin_amdgcn_s_sleep(8); }
#endif
        GRID_SYNC();
    }
#endif
    final_phase(vcu, G, wave_s);
}
}
#if DBG
namespace v0 {
constexpr int D = 1024, SEQ = 2048, BATCH = 8, PLE = 256, FF = 2816;
constexpr int WA = 512, WB = 512, WC = 512, WD = 512, CHUNK = 128;
constexpr int IN_EVEN = 2560, IN_ODD = 1536;
constexpr float RMS_EPS = 1e-6f, LN_EPS = 1e-5f;

__device__ __forceinline__ float wave_sum(float v) {
#pragma unroll
    for (int o = 1; o < 64; o <<= 1) v += __shfl_xor(v, o);
    return v;
}
__device__ __forceinline__ float sigmoidf_(float x) { return 1.0f / (1.0f + expf(-x)); }
__device__ __forceinline__ float siluf_(float x) { return x * sigmoidf_(x); }
__device__ __forceinline__ float gelu_tanh(float x) {
    const float c = 0.7978845608028654f;
    return 0.5f * x * (1.0f + tanhf(c * (x + 0.044715f * x * x * x)));
}

__global__ __launch_bounds__(256) void k_rmsnorm(const float* x, const float* gain, float* y, int rows) {
    const int row = blockIdx.x * 4 + (threadIdx.x >> 6), lane = threadIdx.x & 63;
    if (row >= rows) return;
    const float4* xr = (const float4*)(x + (size_t)row * D);
    float4 v[4]; float s = 0.f;
#pragma unroll
    for (int j = 0; j < 4; ++j) { v[j] = xr[lane + 64 * j]; s += v[j].x * v[j].x + v[j].y * v[j].y + v[j].z * v[j].z + v[j].w * v[j].w; }
    s = wave_sum(s);
    const float r = 1.0f / sqrtf(s * (1.0f / D) + RMS_EPS);
    float4* yr = (float4*)(y + (size_t)row * D);
    const float4* g4 = (const float4*)gain;
#pragma unroll
    for (int j = 0; j < 4; ++j) { const float4 g = g4[lane + 64 * j]; float4 o; o.x = v[j].x * r * g.x; o.y = v[j].y * r * g.y; o.z = v[j].z * r * g.z; o.w = v[j].w * r * g.w; yr[lane + 64 * j] = o; }
}

struct GemmP { const float* A; const float* B; float* C; int M, N, K, lda, ldb, ldc; long sA1, sB1, sC1, sA2, sB2, sC2; int nb2; int tril; };
__global__ __launch_bounds__(256) void k_gemm(GemmP p) {
    __shared__ float As[16][68];
    __shared__ float Bs[16][68];
    const int z1 = blockIdx.z / p.nb2, z2 = blockIdx.z % p.nb2;
    const float* A = p.A + z1 * p.sA1 + z2 * p.sA2;
    const float* B = p.B + z1 * p.sB1 + z2 * p.sB2;
    float* C = p.C + z1 * p.sC1 + z2 * p.sC2;
    const int t = threadIdx.x, tx = t & 15, ty = t >> 4;
    const int m0 = blockIdx.y * 64, n0 = blockIdx.x * 64;
    float acc[4][4];
#pragma unroll
    for (int i = 0; i < 4; ++i)
#pragma unroll
        for (int j = 0; j < 4; ++j) acc[i][j] = 0.f;
    const int ar = t >> 2, ak = (t & 3) * 4;
    const int bk = t >> 4, bn = (t & 15) * 4;
    for (int k0 = 0; k0 < p.K; k0 += 16) {
        float4 av = *(const float4*)(A + (size_t)(m0 + ar) * p.lda + k0 + ak);
        if (p.tril) {
            const int tt = m0 + ar, ss = k0 + ak;
            if (ss + 0 > tt) av.x = 0.f; if (ss + 1 > tt) av.y = 0.f; if (ss + 2 > tt) av.z = 0.f; if (ss + 3 > tt) av.w = 0.f;
        }
        const float4 bv = *(const float4*)(B + (size_t)(k0 + bk) * p.ldb + n0 + bn);
        As[ak + 0][ar] = av.x; As[ak + 1][ar] = av.y; As[ak + 2][ar] = av.z; As[ak + 3][ar] = av.w;
        *(float4*)&Bs[bk][bn] = bv;
        __syncthreads();
#pragma unroll
        for (int k = 0; k < 16; ++k) {
            const float4 a = *(const float4*)&As[k][ty * 4];
            const float4 b = *(const float4*)&Bs[k][tx * 4];
            const float aa[4] = {a.x, a.y, a.z, a.w}, bb[4] = {b.x, b.y, b.z, b.w};
#pragma unroll
            for (int i = 0; i < 4; ++i)
#pragma unroll
                for (int j = 0; j < 4; ++j) acc[i][j] = fmaf(aa[i], bb[j], acc[i][j]);
        }
        __syncthreads();
    }
#pragma unroll
    for (int i = 0; i < 4; ++i) {
        float4 o; o.x = acc[i][0]; o.y = acc[i][1]; o.z = acc[i][2]; o.w = acc[i][3];
        *(float4*)(C + (size_t)(m0 + ty * 4 + i) * p.ldc + n0 + tx * 4) = o;
    }
}

__global__ void k_swiglu(const float* z, float* t, int rows) {
    const size_t i = (size_t)blockIdx.x * blockDim.x + threadIdx.x;
    if (i >= (size_t)rows * FF) return;
    const size_t r = i / FF, j = i % FF;
    t[i] = siluf_(z[r * (2 * FF) + j]) * z[r * (2 * FF) + FF + j];
}
__global__ void k_add_scaled(float* h, const float* y, float sc, size_t n) {
    const size_t i = (size_t)blockIdx.x * blockDim.x + threadIdx.x;
    if (i < n) h[i] += sc * y[i];
}
__global__ __launch_bounds__(256) void k_gelu_ln(const float* z, const float* ln_g, const float* ln_b, float* u, float* vg, int rows) {
    const int wid = blockIdx.x * 4 + (threadIdx.x >> 6), lane = threadIdx.x & 63;
    const int row = wid >> 2, g = wid & 3;
    if (row >= rows) return;
    const float* zr = z + (size_t)row * IN_EVEN;
    const int c0 = g * 128 + lane * 2;
    u[(size_t)row * WA + c0] = gelu_tanh(zr[c0]); u[(size_t)row * WA + c0 + 1] = gelu_tanh(zr[c0 + 1]);
    const float v0 = gelu_tanh(zr[WA + c0]), v1 = gelu_tanh(zr[WA + c0 + 1]);
    const float mu = wave_sum(v0 + v1) * (1.0f / 128.0f);
    const float d0 = v0 - mu, d1 = v1 - mu;
    const float var = wave_sum(d0 * d0 + d1 * d1) * (1.0f / 128.0f);
    const float r = 1.0f / sqrtf(var + LN_EPS);
    vg[(size_t)row * WA + c0] = d0 * r * ln_g[c0] + ln_b[c0];
    vg[(size_t)row * WA + c0 + 1] = d1 * r * ln_g[c0 + 1] + ln_b[c0 + 1];
}
__global__ void k_gate(const float* u, const float* mixed, const float* b_s, float* ycat, int rows) {
    const size_t i = (size_t)blockIdx.x * blockDim.x + threadIdx.x;
    if (i >= (size_t)rows * WA) return;
    const int r = (int)(i / WA), c = (int)(i % WA), g = c >> 7;
    ycat[(size_t)r * D + c] = u[i] * (mixed[i] + b_s[g * CHUNK + (r % CHUNK)]);
}
__global__ void k_shortconv(const float* z, const float* w, float* ycat, int rows) {
    const size_t i = (size_t)blockIdx.x * blockDim.x + threadIdx.x;
    if (i >= (size_t)rows * WB) return;
    const int r = (int)(i / WB), c = (int)(i % WB);
    float acc = 0.f;
#pragma unroll
    for (int k = 0; k < 3; ++k) {
        const int tt = r - 2 + k;
        if (tt >= 0) { const float* zr = z + (size_t)tt * IN_EVEN + 2 * WA; acc += w[k * WB + c] * (zr[WB + c] * zr[2 * WB + c]); }
    }
    ycat[(size_t)r * D + WA + c] = z[(size_t)r * IN_EVEN + 2 * WA + c] * acc;
}
__global__ void k_pool(const float* z, float* pooled, int rows) {
    const size_t i = (size_t)blockIdx.x * blockDim.x + threadIdx.x;
    if (i >= (size_t)rows * WC) return;
    const int r = (int)(i / WC), c = (int)(i % WC), win = 2 << (c >> 7);
    const int cnt = (r + 1 < win) ? (r + 1) : win;
    float s = 0.f;
    for (int k = 0; k < cnt; ++k) s += z[(size_t)(r - k) * IN_ODD + c];
    pooled[i] = s / (float)cnt - z[(size_t)r * IN_ODD + c];
}
__global__ void k_colscale_to(const float* src, const float* sc, float* ycat, int rows) {
    const size_t i = (size_t)blockIdx.x * blockDim.x + threadIdx.x;
    if (i >= (size_t)rows * WC) return;
    const int r = (int)(i / WC), c = (int)(i % WC);
    ycat[(size_t)r * D + c] = src[i] * sc[c];
}
__global__ void k_glu(const float* z, float* s, int rows) {
    const size_t i = (size_t)blockIdx.x * blockDim.x + threadIdx.x;
    if (i >= (size_t)rows * WD) return;
    const int r = (int)(i / WD), c = (int)(i % WD);
    s[i] = z[(size_t)r * IN_ODD + WC + c] * sigmoidf_(z[(size_t)r * IN_ODD + WC + WD + c]);
}
__global__ __launch_bounds__(512) void k_conv_ln_silu(const float* s, const float* cw, const float* cb, const float* ln_g, const float* ln_b, float* ycat, int rows) {
    __shared__ float red[8];
    __shared__ float red2[8];
    const int r = blockIdx.x, c = threadIdx.x;
    float acc = cb[c];
    for (int k = 0; k < 31; ++k) { const int tt = r - 30 + k; if (tt >= 0) acc += cw[k * WD + c] * s[(size_t)tt * WD + c]; }
    float ws = wave_sum(acc);
    if ((c & 63) == 0) red[c >> 6] = ws;
    __syncthreads();
    float mu = 0.f;
#pragma unroll
    for (int i = 0; i < 8; ++i) mu += red[i];
    mu *= (1.0f / 512.0f);
    const float d = acc - mu;
    float wq = wave_sum(d * d);
    if ((c & 63) == 0) red2[c >> 6] = wq;
    __syncthreads();
    float var = 0.f;
#pragma unroll
    for (int i = 0; i < 8; ++i) var += red2[i];
    var *= (1.0f / 512.0f);
    const float y = d * (1.0f / sqrtf(var + LN_EPS)) * ln_g[c] + ln_b[c];
    ycat[(size_t)r * D + WC + c] = siluf_(y);
}
__global__ void k_ple(float* h, const float* gz, const float* pu, size_t n) {
    const size_t i = (size_t)blockIdx.x * blockDim.x + threadIdx.x;
    if (i < n) h[i] += sigmoidf_(gz[i]) * pu[i];
}


static unsigned short* g_snap = nullptr; static int g_snap_i = 0;
__global__ void k_snap(const float* h, unsigned short* o, size_t n) { const size_t i = (size_t)blockIdx.x * blockDim.x + threadIdx.x; if (i < n) { unsigned u = __float_as_uint(h[i]); u += 0x7fffu + ((u >> 16) & 1u); o[i] = (unsigned short)(u >> 16); } }
static void snap_hook(hipStream_t st, const float* h, int S) { if (!g_snap) return; const size_t n = (size_t)S * 1024; hipLaunchKernelGGL(k_snap, dim3((unsigned)((n + 255) / 256)), dim3(256), 0, st, h, g_snap + (size_t)g_snap_i * n, n); ++g_snap_i; }
struct In {
    const float *x, *p, *ffn1_norm, *ffn1_w_gu, *ffn1_w_down, *mix_norm, *ffn2_norm, *ffn2_w_gu, *ffn2_w_down, *ple_norm, *ple_w_gate, *ple_w_up,
        *ab_w_in, *gm_ln_g, *gm_ln_b, *gm_w_s, *gm_b_s, *sc_w, *ab_w_out, *cd_w_in, *pool_w, *pool_scale, *cv_w, *cv_b, *cv_ln_g, *cv_ln_b, *cd_w_out, *final_norm;
};

static void gemm(hipStream_t st, const float* A, const float* B, float* C, int M, int N, int K, int lda, int ldb, int ldc,
                 int nb1 = 1, long sA1 = 0, long sB1 = 0, long sC1 = 0, int nb2 = 1, long sA2 = 0, long sB2 = 0, long sC2 = 0, int tril = 0) {
    GemmP p{A, B, C, M, N, K, lda, ldb, ldc, sA1, sB1, sC1, sA2, sB2, sC2, nb2, tril};
    hipLaunchKernelGGL(k_gemm, dim3(N / 64, M / 64, nb1 * nb2), dim3(256), 0, st, p);
}
static inline unsigned nblk(size_t n, int b) { return (unsigned)((n + b - 1) / b); }

static void forward_slab(hipStream_t st, const In& in, const float* p_slab0, const float* p_slab1, float* h, float* out, float* tmp, int S) {
    float* xn = tmp;
    float* z = xn + (size_t)S * D;
    float* t = z + (size_t)S * 2 * FF;
    float* y = t + (size_t)S * FF;
    float* ycat = y + (size_t)S * D;
    float* gz = ycat + (size_t)S * D;
    float* b0 = gz + (size_t)S * D;
    float* b1 = b0 + (size_t)S * 512; float* b2 = b1 + (size_t)S * 512; float* b3 = b2 + (size_t)S * 512;
    const size_t nh = (size_t)S * D;
    for (int i = 0; i < 2; ++i) {
        hipLaunchKernelGGL(k_rmsnorm, dim3(S / 4), dim3(256), 0, st, h, in.ffn1_norm + i * D, xn, S);
        gemm(st, xn, in.ffn1_w_gu + (size_t)i * D * 2 * FF, z, S, 2 * FF, D, D, 2 * FF, 2 * FF);
        hipLaunchKernelGGL(k_swiglu, dim3(nblk((size_t)S * FF, 256)), dim3(256), 0, st, z, t, S);
        gemm(st, t, in.ffn1_w_down + (size_t)i * FF * D, y, S, D, FF, FF, D, D);
        hipLaunchKernelGGL(k_add_scaled, dim3(nblk(nh, 256)), dim3(256), 0, st, h, y, 0.5f, nh);
        snap_hook(st, h, S);
        hipLaunchKernelGGL(k_rmsnorm, dim3(S / 4), dim3(256), 0, st, h, in.mix_norm + i * D, xn, S);
        if (i == 0) {
            gemm(st, xn, in.ab_w_in, z, S, IN_EVEN, D, D, IN_EVEN, IN_EVEN);
            float *u = b0, *vg = b1, *mixed = b2;
            hipLaunchKernelGGL(k_gelu_ln, dim3(S), dim3(256), 0, st, z, in.gm_ln_g, in.gm_ln_b, u, vg, S);
            gemm(st, in.gm_w_s, vg, mixed, CHUNK, 128, CHUNK, CHUNK, WA, WA, S / CHUNK, 0, (long)CHUNK * WA, (long)CHUNK * WA, 4, (long)CHUNK * CHUNK, 128, 128, 1);
            hipLaunchKernelGGL(k_gate, dim3(nblk((size_t)S * WA, 256)), dim3(256), 0, st, u, mixed, in.gm_b_s, ycat, S);
            hipLaunchKernelGGL(k_shortconv, dim3(nblk((size_t)S * WB, 256)), dim3(256), 0, st, z, in.sc_w, ycat, S);
            gemm(st, ycat, in.ab_w_out, y, S, D, D, D, D, D);
        } else {
            gemm(st, xn, in.cd_w_in, z, S, IN_ODD, D, D, IN_ODD, IN_ODD);
            float *pooled = b0, *ycr = b1, *sg = b2;
            hipLaunchKernelGGL(k_pool, dim3(nblk((size_t)S * WC, 256)), dim3(256), 0, st, z, pooled, S);
            gemm(st, pooled, in.pool_w, ycr, S, 128, 128, WC, 128, WC, 4, 128, 128L * 128, 128);
            hipLaunchKernelGGL(k_colscale_to, dim3(nblk((size_t)S * WC, 256)), dim3(256), 0, st, ycr, in.pool_scale, ycat, S);
            hipLaunchKernelGGL(k_glu, dim3(nblk((size_t)S * WD, 256)), dim3(256), 0, st, z, sg, S);
            hipLaunchKernelGGL(k_conv_ln_silu, dim3(S), dim3(512), 0, st, sg, in.cv_w, in.cv_b, in.cv_ln_g, in.cv_ln_b, ycat, S);
            gemm(st, ycat, in.cd_w_out, y, S, D, D, D, D, D);
        }
        hipLaunchKernelGGL(k_add_scaled, dim3(nblk(nh, 256)), dim3(256), 0, st, h, y, 1.0f, nh);
        snap_hook(st, h, S);
        hipLaunchKernelGGL(k_rmsnorm, dim3(S / 4), dim3(256), 0, st, h, in.ffn2_norm + i * D, xn, S);
        gemm(st, xn, in.ffn2_w_gu + (size_t)i * D * 2 * FF, z, S, 2 * FF, D, D, 2 * FF, 2 * FF);
        hipLaunchKernelGGL(k_swiglu, dim3(nblk((size_t)S * FF, 256)), dim3(256), 0, st, z, t, S);
        gemm(st, t, in.ffn2_w_down + (size_t)i * FF * D, y, S, D, FF, FF, D, D);
        hipLaunchKernelGGL(k_add_scaled, dim3(nblk(nh, 256)), dim3(256), 0, st, h, y, 0.5f, nh);
        snap_hook(st, h, S);
        hipLaunchKernelGGL(k_rmsnorm, dim3(S / 4), dim3(256), 0, st, h, in.ple_norm + i * D, xn, S);
        gemm(st, xn, in.ple_w_gate + (size_t)i * D * D, gz, S, D, D, D, D, D);
        gemm(st, i == 0 ? p_slab0 : p_slab1, in.ple_w_up + (size_t)i * PLE * D, y, S, D, PLE, PLE, D, D);
        hipLaunchKernelGGL(k_ple, dim3(nblk(nh, 256)), dim3(256), 0, st, h, gz, y, nh);
        snap_hook(st, h, S);
    }
    hipLaunchKernelGGL(k_rmsnorm, dim3(S / 4), dim3(256), 0, st, h, in.final_norm, out, S);
}
}
#endif

#if DBG
__global__ void k_dbg_report(const float* res, float* out) {
    if (threadIdx.x != 0 || blockIdx.x != 0) return;
    for (int cp = 0; cp < 8; ++cp) { const float e2 = res[2 * cp], r2 = res[2 * cp + 1]; const float rel = sqrtf(e2 / fmaxf(r2, 1e-30f));
        if (!(rel < DBG_THR)) { int d = (int)(rel * 10.0f); if (d > 9 || !(rel == rel)) d = 9; if (d < 0) d = 0; out[0] = 1000.0f * (float)(cp + 1) + 100.0f * (float)d; return; } }
}
#endif

extern "C" void kernel_launch(void* const* d_in, const int* in_sizes, int n_in, void* d_out, int out_size, void* d_ws, size_t ws_size, hipStream_t stream) {
    using namespace mk;
    static int grid = 0;
    if (grid == 0) {
        const size_t need = DBG ? WS_SNAP + (size_t)8 * DBG_NT * D * 2 : WS_END;
        if (n_in != 28 || in_sizes[0] != M * D || out_size != M * D || ws_size < need) { fprintf(stderr, "kernel_launch: unexpected problem (n_in %d, in0 %d, out %d, ws %zu < %zu); nothing launched\n", n_in, n_in > 0 ? in_sizes[0] : -1, out_size, ws_size, need); grid = -1; return; }
        int dev = 0, cus = 0, per_cu = 0;
        if (hipGetDevice(&dev) != hipSuccess || hipDeviceGetAttribute(&cus, hipDeviceAttributeMultiprocessorCount, dev) != hipSuccess) { grid = -1; return; }
        if (hipFuncSetAttribute((const void*)mk_fwd, hipFuncAttributeMaxDynamicSharedMemorySize, LDS_BYTES) != hipSuccess) { fprintf(stderr, "kernel_launch: hipFuncSetAttribute failed\n"); grid = -1; return; }
        if (hipOccupancyMaxActiveBlocksPerMultiprocessor(&per_cu, (const void*)mk_fwd, NTHREADS, LDS_BYTES) != hipSuccess || per_cu < 1) { fprintf(stderr, "kernel_launch: occupancy query failed (%d)\n", per_cu); (void)hipGetLastError(); grid = -1; return; }
        grid = cus * 1;
        fprintf(stderr, "kernel_launch: grid %d (cus %d, occupancy %d/CU), ws %zu\n", grid, cus, per_cu, ws_size);
    }
    if (grid < 0) return;
    (void)hipMemsetAsync((char*)d_ws + WS_CTL, 0, CTL_BYTES, stream);
    Args a{};
    for (int i = 0; i < 28; ++i) a.in[i] = (const float*)d_in[i];
    a.out = (float*)d_out; a.ws = (unsigned char*)d_ws; a.dbg = DBG; a.pad = 0;
#if DBG
    {
        v0::In in; const float** f = (const float**)&in; for (int i = 0; i < 28; ++i) f[i] = (const float*)d_in[i];
        float* href = (float*)((char*)d_ws + WS_Y); float* tmp = (float*)((char*)d_ws + WS_T);
        (void)hipMemcpyAsync(href, in.x, (size_t)DBG_NT * D * sizeof(float), hipMemcpyDeviceToDevice, stream);
        v0::g_snap = (unsigned short*)((char*)d_ws + WS_SNAP); v0::g_snap_i = 0;
        v0::forward_slab(stream, in, in.p, in.p + (size_t)v0::BATCH * v0::SEQ * v0::PLE, href, href, tmp, DBG_NT);
    }
#endif
    void* args[] = {&a};
    const hipError_t e = hipLaunchCooperativeKernel((const void*)mk_fwd, dim3(grid), dim3(NTHREADS), args, LDS_BYTES, stream);
    if (e != hipSuccess) fprintf(stderr, "kernel_launch: cooperative launch failed: %s (grid %d)\n", hipGetErrorString(e), grid);
#if DBG
    hipLaunchKernelGGL(k_dbg_report, dim3(1), dim3(64), 0, stream, (const float*)((char*)d_ws + WS_DBG), (float*)d_out);
#endif
}
```

```cpp
#define PROBE 0
#include <hip/hip_runtime.h>
#include <hip/hip_cooperative_groups.h>
#include <cstdio>
#include <cstdint>
namespace cg = cooperative_groups;

#ifndef DBG
#define DBG 0
#endif
#ifndef GP_SP2
#define GP_SP2 true
#endif
#ifndef GP_ALIGN
#define GP_ALIGN true
#endif
#ifndef DBG_THR
#define DBG_THR 0.03f
#endif
#ifndef PROBE
#define PROBE 0
#endif
#ifndef STAMPS
#define STAMPS 0
#endif
#ifndef GP_TIME
#define GP_TIME 0
#endif
#ifndef WT_STORES
#define WT_STORES 0
#endif
#ifndef GP_BMASK
#define GP_BMASK 0x1ff
#endif

namespace pg8 {
#define PG8_LAS __attribute__((address_space(3)))
typedef unsigned short bf16_t;
typedef short bf16x8 __attribute__((ext_vector_type(8)));
typedef float f32x4 __attribute__((ext_vector_type(4)));
typedef unsigned u32x4 __attribute__((ext_vector_type(4)));
typedef unsigned u32x2 __attribute__((ext_vector_type(2)));
constexpr int BM = 256, BK = 64, HALF = 128, HTB = HALF * BK * 2  , STAGE_BYTES = 8 * HTB, NXCD = 8, WGM = 8;

__host__ __device__ __forceinline__ int lds_byte(int r, int c) { const int st = (r >> 4) * 2 + (c >> 5), rr = r & 15, cc = c & 31, ob = rr * 64 + cc * 2; return st * 1024 + (ob ^ (((ob >> 9) & 1) << 5)); }
__host__ __device__ __forceinline__ void stage_rc(int b, int& R, int& C) { const int st = b / 1024, sb = b % 1024, swz = sb ^ (((sb >> 9) & 1) << 5); R = (st >> 1) * 16 + swz / 64; C = (st & 1) * 32 + (swz % 64) / 2; }
__host__ __device__ __forceinline__ int perm32(int rho) { const int n = rho >> 4, i = rho & 15; return 8 * (i >> 2) + 4 * n + (i & 3); }

struct Unit { int pm, pn; };
struct Gemm { const bf16_t* A; const bf16_t* Bt; int M, N, K; };

struct StaticOrder {
    int nM, nN, nwg, G, c;
    __host__ __device__ void init(int M, int N, int G_, int c_) { nM = M / BM; nN = N / BM; nwg = nM * nN; G = G_; c = c_; }
    __host__ __device__ bool next(int i, Unit& u) const {
        const long L = (long)i * G + c; if (L >= nwg) return false;
        int wgid = (int)L; { const int q = nwg / NXCD, r = nwg % NXCD, xcd = wgid % NXCD, off = wgid / NXCD; wgid = (xcd < r ? xcd * (q + 1) : r * (q + 1) + (xcd - r) * q) + off; }
        const int nig = WGM * nN, gid = wgid / nig, fm = gid * WGM, gsz = (nM - fm) < WGM ? (nM - fm) : WGM;
        u.pm = fm + ((wgid % nig) % gsz); u.pn = (wgid % nig) / gsz; return true;
    }
    __device__ __forceinline__ void a_ready(const Unit&) const {}
    __device__ __forceinline__ void done(const Unit&) const {}
};

typedef __bf16 bf16x2_t __attribute__((ext_vector_type(2)));
typedef float f32x2 __attribute__((ext_vector_type(2)));
__device__ __forceinline__ unsigned cvt_pk_bf16(float lo, float hi) { const f32x2 v = {lo, hi}; const bf16x2_t b = __builtin_convertvector(v, bf16x2_t); return __builtin_bit_cast(unsigned, b); }
__device__ __forceinline__ float bf_lo(unsigned w) { return __uint_as_float(w << 16); }
__device__ __forceinline__ float bf_hi(unsigned w) { return __uint_as_float(w & 0xffff0000u); }
__device__ __forceinline__ float fsigmoid(float x) { return __builtin_amdgcn_rcpf(1.0f + __builtin_amdgcn_exp2f(-1.4426950408889634f * x)); }
__device__ __forceinline__ float fsilu(float x) { return x * fsigmoid(x); }
__device__ __forceinline__ float fgelu_tanh(float x) { return x * fsigmoid(1.5957691216057308f * (x + 0.044715f * x * x * x)); }
__device__ __forceinline__ float rstd_of(float ss) { return __builtin_amdgcn_rsqf(ss * (1.0f / 1024.0f) + 1e-6f); }
__device__ __forceinline__ f32x4 vexp2(const f32x4& x) { return (f32x4){__builtin_amdgcn_exp2f(x[0]), __builtin_amdgcn_exp2f(x[1]), __builtin_amdgcn_exp2f(x[2]), __builtin_amdgcn_exp2f(x[3])}; }
__device__ __forceinline__ f32x4 vrcp(const f32x4& x) { return (f32x4){__builtin_amdgcn_rcpf(x[0]), __builtin_amdgcn_rcpf(x[1]), __builtin_amdgcn_rcpf(x[2]), __builtin_amdgcn_rcpf(x[3])}; }
__device__ __forceinline__ f32x4 vsig_neg(const f32x4& z  ) { return vrcp(vexp2(z) + 1.0f); }
__device__ __forceinline__ f32x4 vgelu(const f32x4& x) { const f32x4 x2 = x * x; return x * vsig_neg(x * (x2 * (-0.10294324f) + (-2.30220820f))); }
#if WT_STORES
__device__ __forceinline__ void stg16(void* p, const u32x4& v) { asm volatile("global_store_dwordx4 %0, %1, off sc1\n\ts_nop 1" :: "v"(p), "v"(v) : "memory"); }
__device__ __forceinline__ void stg16(void* p, const f32x4& v) { asm volatile("global_store_dwordx4 %0, %1, off sc1\n\ts_nop 1" :: "v"(p), "v"(v) : "memory"); }
#else
__device__ __forceinline__ void stg16(void* p, const u32x4& v) { *(u32x4*)p = v; }
__device__ __forceinline__ void stg16(void* p, const f32x4& v) { *(f32x4*)p = v; }
#endif
template <int MASK> __device__ __forceinline__ float add_xor(float v) { return v + __int_as_float(__builtin_amdgcn_ds_swizzle(__float_as_int(v), (MASK << 10) | 0x1f)); }
__device__ __forceinline__ float add_xor32(float v) { const auto r = __builtin_amdgcn_permlane32_swap(__float_as_uint(v), __float_as_uint(v), false, false); return __uint_as_float(r[0]) + __uint_as_float(r[1]); }
__device__ __forceinline__ u32x4 pack8(const f32x4& a, const f32x4& b) { u32x4 w; w.x = cvt_pk_bf16(a[0], a[1]); w.y = cvt_pk_bf16(a[2], a[3]); w.z = cvt_pk_bf16(b[0], b[1]); w.w = cvt_pk_bf16(b[2], b[3]); return w; }

constexpr int DM = 1024, DFF = 2816;

struct EpiSwiglu {
    static constexpr bool PERM = true, AFTER_DRAIN = false;
    bf16_t* T; const float* rowss;
    __device__ __forceinline__ void operator()(const f32x4 (&acc)[2][2][4][2], const Unit& u, int wr, int wc, int fr, int fq) const {
        const int row0 = u.pm * BM + wr * 64 + fr, col0 = u.pn * 128 + wc * 32 + 8 * fq;
        float rs[2][4];
#pragma unroll
        for (int ai = 0; ai < 2; ++ai)
#pragma unroll
            for (int m = 0; m < 4; ++m) rs[ai][m] = rstd_of(rowss[row0 + ai * HALF + m * 16]);
#pragma unroll
        for (int ai = 0; ai < 2; ++ai)
#pragma unroll
            for (int m = 0; m < 4; ++m) {
                const int r = row0 + ai * HALF + m * 16; const float s = rs[ai][m], s2 = s * s, cs = -1.4426950408889634f * s;
                const f32x4 t0 = (acc[ai][0][m][0] * acc[ai][1][m][0] * s2) * vsig_neg(acc[ai][0][m][0] * cs);
                const f32x4 t1 = (acc[ai][0][m][1] * acc[ai][1][m][1] * s2) * vsig_neg(acc[ai][0][m][1] * cs);
                stg16(T + (size_t)r * DFF + col0, pack8(t0, t1));
            }
    }
};
template <bool DRY> struct EpiResT {
    static constexpr bool PERM = true, AFTER_DRAIN = false;
    bf16_t* hb; float* rowss_out; float scale;
    __device__ __forceinline__ void operator()(const f32x4 (&acc)[2][2][4][2], const Unit& u, int wr, int wc, int fr, int fq) const {
        const int row0 = u.pm * BM + wr * 64 + fr, col0 = u.pn * BM + wc * 32 + 8 * fq;
#pragma unroll
        for (int ai = 0; ai < 2; ++ai)
#pragma unroll
            for (int m = 0; m < 4; ++m) {
                const int r = row0 + ai * HALF + m * 16; const size_t off = (size_t)r * DM + col0;
                const u32x4 h0 = *(const u32x4*)(hb + off), h1 = *(const u32x4*)(hb + off + HALF);
                const f32x4 b00 = {bf_lo(h0.x), bf_hi(h0.x), bf_lo(h0.y), bf_hi(h0.y)}, b01 = {bf_lo(h0.z), bf_hi(h0.z), bf_lo(h0.w), bf_hi(h0.w)};
                const f32x4 b10 = {bf_lo(h1.x), bf_hi(h1.x), bf_lo(h1.y), bf_hi(h1.y)}, b11 = {bf_lo(h1.z), bf_hi(h1.z), bf_lo(h1.w), bf_hi(h1.w)};
                const f32x4 o00 = b00 + acc[ai][0][m][0] * scale, o01 = b01 + acc[ai][0][m][1] * scale, o10 = b10 + acc[ai][1][m][0] * scale, o11 = b11 + acc[ai][1][m][1] * scale;
                if (!DRY) { stg16(hb + off, pack8(o00, o01)); stg16(hb + off + HALF, pack8(o10, o11)); }
                const f32x4 sq = o00 * o00 + o01 * o01 + o10 * o10 + o11 * o11;
                float ss = (sq[0] + sq[1]) + (sq[2] + sq[3]);
                ss = add_xor32(add_xor<16>(ss));
                if (!DRY) { if (fq == 0) atomicAdd(rowss_out + r, ss); } else asm volatile("" :: "v"(ss));
            }
    }
};
typedef EpiResT<false> EpiRes; typedef EpiResT<true> EpiResDry;
template <bool DRY> struct EpiPleT {
    static constexpr bool PERM = true, AFTER_DRAIN = false;
    const float* rowss_in; const bf16_t* PU; bf16_t* hb; float* rowss_out;
    __device__ __forceinline__ void operator()(const f32x4 (&acc)[2][2][4][2], const Unit& u, int wr, int wc, int fr, int fq) const {
        const int row0 = u.pm * BM + wr * 64 + fr, col0 = u.pn * BM + wc * 32 + 8 * fq;
#pragma unroll
        for (int ai = 0; ai < 2; ++ai)
#pragma unroll
            for (int m = 0; m < 4; ++m) {
                const int r = row0 + ai * HALF + m * 16; const size_t off = (size_t)r * DM + col0;
                const float s = rstd_of(rowss_in[r]), cs = -1.4426950408889634f * s;
                const u32x4 p0 = *(const u32x4*)(PU + off), p1 = *(const u32x4*)(PU + off + HALF), h0 = *(const u32x4*)(hb + off), h1 = *(const u32x4*)(hb + off + HALF);
                const f32x4 q00 = {bf_lo(p0.x), bf_hi(p0.x), bf_lo(p0.y), bf_hi(p0.y)}, q01 = {bf_lo(p0.z), bf_hi(p0.z), bf_lo(p0.w), bf_hi(p0.w)};
                const f32x4 q10 = {bf_lo(p1.x), bf_hi(p1.x), bf_lo(p1.y), bf_hi(p1.y)}, q11 = {bf_lo(p1.z), bf_hi(p1.z), bf_lo(p1.w), bf_hi(p1.w)};
                const f32x4 b00 = {bf_lo(h0.x), bf_hi(h0.x), bf_lo(h0.y), bf_hi(h0.y)}, b01 = {bf_lo(h0.z), bf_hi(h0.z), bf_lo(h0.w), bf_hi(h0.w)};
                const f32x4 b10 = {bf_lo(h1.x), bf_hi(h1.x), bf_lo(h1.y), bf_hi(h1.y)}, b11 = {bf_lo(h1.z), bf_hi(h1.z), bf_lo(h1.w), bf_hi(h1.w)};
                const f32x4 o00 = b00 + vsig_neg(acc[ai][0][m][0] * cs) * q00, o01 = b01 + vsig_neg(acc[ai][0][m][1] * cs) * q01;
                const f32x4 o10 = b10 + vsig_neg(acc[ai][1][m][0] * cs) * q10, o11 = b11 + vsig_neg(acc[ai][1][m][1] * cs) * q11;
                if (!DRY) { stg16(hb + off, pack8(o00, o01)); stg16(hb + off + HALF, pack8(o10, o11)); }
                else asm volatile("" :: "v"(o00), "v"(o01), "v"(o10), "v"(o11));
                if (!DRY && rowss_out) {
                    const f32x4 sq = o00 * o00 + o01 * o01 + o10 * o10 + o11 * o11;
                    float ss = (sq[0] + sq[1]) + (sq[2] + sq[3]);
                    ss = add_xor32(add_xor<16>(ss));
                    if (fq == 0) atomicAdd(rowss_out + r, ss);
                }
            }
    }
};
typedef EpiPleT<false> EpiPle; typedef EpiPleT<true> EpiPleDry;
struct EpiPlain {
    static constexpr bool PERM = true, AFTER_DRAIN = false;
    bf16_t* O;
    __device__ __forceinline__ void operator()(const f32x4 (&acc)[2][2][4][2], const Unit& u, int wr, int wc, int fr, int fq) const {
        const int row0 = u.pm * BM + wr * 64 + fr, col0 = u.pn * BM + wc * 32 + 8 * fq;
#pragma unroll
        for (int ai = 0; ai < 2; ++ai)
#pragma unroll
            for (int m = 0; m < 4; ++m) {
                const size_t off = (size_t)(row0 + ai * HALF + m * 16) * DM + col0;
                stg16(O + off, pack8(acc[ai][0][m][0], acc[ai][0][m][1])); stg16(O + off + HALF, pack8(acc[ai][1][m][0], acc[ai][1][m][1]));
            }
    }
};
struct EpiMix0 {
    static constexpr bool PERM = true, AFTER_DRAIN = false;
    const float* rowss; bf16_t *UV, *Q, *BG;
    __device__ __forceinline__ void operator()(const f32x4 (&acc)[2][2][4][2], const Unit& u, int wr, int wc, int fr, int fq) const {
        const int row0 = u.pm * BM + wr * 64 + fr, cw = wc * 32 + 8 * fq;
#pragma unroll
        for (int ai = 0; ai < 2; ++ai)
#pragma unroll
            for (int m = 0; m < 4; ++m) {
                const int r = row0 + ai * HALF + m * 16; const float s = rstd_of(rowss[r]);
                if (u.pn < 4) {
                    const f32x4 a0 = vgelu(acc[ai][0][m][0] * s), a1 = vgelu(acc[ai][0][m][1] * s), b0 = vgelu(acc[ai][1][m][0] * s), b1 = vgelu(acc[ai][1][m][1] * s);
                    bf16_t* p = UV + (size_t)r * 1024 + u.pn * 256 + cw; stg16(p, pack8(a0, a1)); stg16(p + HALF, pack8(b0, b1));
                } else if (u.pn < 8) {
                    const float s2 = s * s; f32x4 q0 = acc[ai][0][m][0] * acc[ai][1][m][0] * s2, q1 = acc[ai][0][m][1] * acc[ai][1][m][1] * s2;
                    stg16(Q + (size_t)r * 512 + (u.pn - 4) * 128 + cw, pack8(q0, q1));
                } else {
                    bf16_t* p = BG + (size_t)r * 512 + (u.pn - 8) * 256 + cw;
                    stg16(p, pack8(acc[ai][0][m][0] * s, acc[ai][0][m][1] * s)); stg16(p + HALF, pack8(acc[ai][1][m][0] * s, acc[ai][1][m][1] * s));
                }
            }
    }
};
struct EpiMix1 {
    static constexpr bool PERM = true, AFTER_DRAIN = false;
    const float* rowss; bf16_t *ZC, *S;
    __device__ __forceinline__ void operator()(const f32x4 (&acc)[2][2][4][2], const Unit& u, int wr, int wc, int fr, int fq) const {
        const int row0 = u.pm * BM + wr * 64 + fr, cw = wc * 32 + 8 * fq;
#pragma unroll
        for (int ai = 0; ai < 2; ++ai)
#pragma unroll
            for (int m = 0; m < 4; ++m) {
                const int r = row0 + ai * HALF + m * 16; const float s = rstd_of(rowss[r]);
                if (u.pn < 2) {
                    bf16_t* p = ZC + (size_t)r * 512 + u.pn * 256 + cw;
                    stg16(p, pack8(acc[ai][0][m][0] * s, acc[ai][0][m][1] * s)); stg16(p + HALF, pack8(acc[ai][1][m][0] * s, acc[ai][1][m][1] * s));
                } else {
                    const float cs = -1.4426950408889634f * s;
                    const f32x4 q0 = (acc[ai][0][m][0] * s) * vsig_neg(acc[ai][1][m][0] * cs), q1 = (acc[ai][0][m][1] * s) * vsig_neg(acc[ai][1][m][1] * cs);
                    stg16(S + (size_t)r * 512 + (u.pn - 2) * 128 + cw, pack8(q0, q1));
                }
            }
    }
};

template <class Epi, class Sched, bool ALIGN_EPI = false, bool SP2 = false>
__device__ __forceinline__ void gemm_phase(PG8_LAS unsigned char* lds, const Gemm g, const Sched& S, const Epi& E, const int wave_s  ) {
    int tid_; asm volatile("v_mbcnt_lo_u32_b32 %0, -1, 0\n\tv_mbcnt_hi_u32_b32 %0, -1, %0" : "=v"(tid_)); tid_ |= wave_s << 6;
    const int tid = tid_, wid = wave_s, lane = tid & 63, wr = wid >> 2, wc = wid & 3, fr = lane & 15, fq = lane >> 4;
    const int K = g.K, nt = K / BK;
    unsigned voffA[2], voffB[2];
#pragma unroll
    for (int i = 0; i < 2; ++i) { int R, C; stage_rc(tid * 16 + i * 8192, R, C); const int Rb = Epi::PERM ? ((R & ~31) + perm32(R & 31)) : R;
        voffA[i] = (unsigned)(R * K + C) * 2u; voffB[i] = (unsigned)(Rb * K + C) * 2u; }
    const size_t kstep = (size_t)(BK * 2);
    const size_t hstep = (size_t)HALF * K * 2;
    const size_t tstep = 2 * hstep;
    const unsigned ldsw = (unsigned)wid * 1024u;
    const int aoff = lds_byte(wr * 64 + fr, fq * 8), boff = lds_byte(wc * 32 + fr, fq * 8);
#define PG8_SA(b, h) (((b) * 2 + (h)) * HTB)
#define PG8_SB(b, h) ((4 + (b) * 2 + (h)) * HTB)
#define PG8_STAGE(bufoff, gbase, voff) do { _Pragma("unroll") for (int _i = 0; _i < 2; ++_i) \
        __builtin_amdgcn_global_load_lds((const unsigned*)((const char*)(gbase) + (voff)[_i]), (PG8_LAS unsigned*)(lds + (bufoff) + ldsw + _i * 8192), 16, 0, 0); } while (0)
#define PG8_LDA(dst, b, h) do { _Pragma("unroll") for (int m = 0; m < 4; ++m) _Pragma("unroll") for (int k = 0; k < 2; ++k) dst[m][k] = *(const PG8_LAS bf16x8*)(lds + PG8_SA(b, h) + aoff + m * 2048 + k * 1024); } while (0)
#define PG8_LDB(dst, b, h) do { _Pragma("unroll") for (int n = 0; n < 2; ++n) _Pragma("unroll") for (int k = 0; k < 2; ++k) dst[n][k] = *(const PG8_LAS bf16x8*)(lds + PG8_SB(b, h) + boff + n * 2048 + k * 1024); } while (0)
#define PG8_MMA(ai, bj, At, Bt) do { __builtin_amdgcn_s_setprio(1); _Pragma("unroll") for (int m = 0; m < 4; ++m) _Pragma("unroll") for (int n = 0; n < 2; ++n) _Pragma("unroll") for (int k = 0; k < 2; ++k) \
        acc[ai][bj][m][n] = __builtin_amdgcn_mfma_f32_16x16x32_bf16(Bt[n][k], At[m][k], acc[ai][bj][m][n], 0, 0, 0); __builtin_amdgcn_s_setprio(0); } while (0)
#define PG8_WAIT_V(n) asm volatile("s_waitcnt vmcnt(" #n ")" ::: "memory")
#define PG8_WAIT_L(n) asm volatile("s_waitcnt lgkmcnt(" #n ")" ::: "memory")
#define PG8_BAR __builtin_amdgcn_s_barrier()
#define PG8_SCHED __builtin_amdgcn_sched_barrier(0)
    Unit cur, nxt; int ui = 0;
    if (!S.next(0, cur)) return;
    f32x4 acc[2][2][4][2];
#pragma unroll
    for (int a = 0; a < 2; ++a)
#pragma unroll
        for (int b = 0; b < 2; ++b)
#pragma unroll
            for (int m = 0; m < 4; ++m)
#pragma unroll
                for (int n = 0; n < 2; ++n) acc[a][b][m][n] = (f32x4){0.f, 0.f, 0.f, 0.f};
    bf16x8 At[4][2], B0[2][2], B1[2][2];
    const char* cA = (const char*)g.A + (size_t)cur.pm * tstep; const char* cB = (const char*)g.Bt + (size_t)cur.pn * tstep;
    S.a_ready(cur);
    if constexpr (SP2) {
        PG8_STAGE(PG8_SB(0, 0), cB, voffB); PG8_STAGE(PG8_SB(0, 1), cB + hstep, voffB); PG8_STAGE(PG8_SA(0, 0), cA, voffA); PG8_STAGE(PG8_SA(0, 1), cA + hstep, voffA);
        if (wr == 1) PG8_BAR;
        PG8_WAIT_V(2); PG8_BAR;
        PG8_STAGE(PG8_SB(1, 0), cB + kstep, voffB); PG8_STAGE(PG8_SA(1, 0), cA + kstep, voffA); PG8_STAGE(PG8_SB(1, 1), cB + hstep + kstep, voffB);
        PG8_WAIT_V(6); PG8_BAR;
    } else {
        PG8_STAGE(PG8_SB(0, 0), cB, voffB); PG8_STAGE(PG8_SA(0, 0), cA, voffA); PG8_STAGE(PG8_SB(0, 1), cB + hstep, voffB); PG8_STAGE(PG8_SA(0, 1), cA + hstep, voffA);
        if (wr == 1) PG8_BAR;
        PG8_WAIT_V(4); PG8_BAR;
        PG8_STAGE(PG8_SB(1, 0), cB + kstep, voffB); PG8_STAGE(PG8_SA(1, 0), cA + kstep, voffA); PG8_STAGE(PG8_SB(1, 1), cB + hstep + kstep, voffB);
        PG8_WAIT_V(6); PG8_BAR;
    }
    for (;;) {
        const bool has_next = S.next(ui + 1, nxt);
        const char* nA = has_next ? (const char*)g.A + (size_t)nxt.pm * tstep : cA; const char* nB = has_next ? (const char*)g.Bt + (size_t)nxt.pn * tstep : cB;
#if GP_TIME == 2
        const unsigned long long tk0_ = __builtin_amdgcn_s_memrealtime();
#elif GP_TIME == 3
        const unsigned long long tk0_ = __builtin_amdgcn_s_memtime();
#endif
        for (int t = 0; t < nt; t += 2) {
            const bool last = (t == nt - 2);
            const char* a1 = cA + (size_t)(t + 1) * kstep;
            const char* a2 = last ? nA : cA + (size_t)(t + 2) * kstep; const char* b2 = last ? nB : cB + (size_t)(t + 2) * kstep;
            const char* a3 = a2 + kstep; const char* b3 = b2 + kstep;
            if (last && has_next) S.a_ready(nxt);
            if constexpr (SP2) {
            PG8_LDB(B0, 0, 0); PG8_LDB(B1, 0, 1); PG8_SCHED; PG8_LDA(At, 0, 0); PG8_STAGE(PG8_SA(1, 1), a1 + hstep, voffA);
            PG8_WAIT_V(8); PG8_WAIT_L(0); PG8_BAR; PG8_MMA(0, 0, At, B0); PG8_MMA(0, 1, At, B1); PG8_BAR; PG8_SCHED;
            PG8_LDA(At, 0, 1); PG8_STAGE(PG8_SB(0, 0), b2, voffB); PG8_STAGE(PG8_SB(0, 1), b2 + hstep, voffB); PG8_STAGE(PG8_SA(0, 0), a2, voffA);
            PG8_WAIT_V(8); PG8_WAIT_L(0); PG8_BAR; PG8_MMA(1, 0, At, B0); PG8_MMA(1, 1, At, B1); PG8_BAR; PG8_SCHED;
            PG8_LDB(B0, 1, 0); PG8_LDB(B1, 1, 1); PG8_SCHED; PG8_LDA(At, 1, 0); PG8_STAGE(PG8_SA(0, 1), a2 + hstep, voffA);
            PG8_WAIT_V(8); PG8_WAIT_L(0); PG8_BAR; PG8_MMA(0, 0, At, B0); PG8_MMA(0, 1, At, B1); PG8_BAR; PG8_SCHED;
            PG8_LDA(At, 1, 1); PG8_STAGE(PG8_SB(1, 0), b3, voffB); PG8_STAGE(PG8_SB(1, 1), b3 + hstep, voffB); PG8_STAGE(PG8_SA(1, 0), a3, voffA);
            PG8_WAIT_V(8); PG8_WAIT_L(0); PG8_BAR; PG8_MMA(1, 0, At, B0); PG8_MMA(1, 1, At, B1); PG8_BAR; PG8_SCHED;
            } else {
            PG8_LDB(B0, 0, 0); PG8_SCHED; PG8_LDA(At, 0, 0); PG8_STAGE(PG8_SA(1, 1), a1 + hstep, voffA);
            PG8_WAIT_L(8); PG8_BAR; PG8_WAIT_L(0); PG8_MMA(0, 0, At, B0); PG8_BAR; PG8_SCHED;
            PG8_LDB(B1, 0, 1); PG8_STAGE(PG8_SB(0, 0), b2, voffB);
            PG8_BAR; PG8_WAIT_L(0); PG8_MMA(0, 1, At, B1); PG8_BAR;
            PG8_LDA(At, 0, 1); PG8_STAGE(PG8_SA(0, 0), a2, voffA);
            PG8_BAR; PG8_WAIT_L(0); PG8_MMA(1, 0, At, B0); PG8_BAR; PG8_SCHED;
            PG8_STAGE(PG8_SB(0, 1), b2 + hstep, voffB);
            PG8_WAIT_V(6); PG8_BAR; PG8_MMA(1, 1, At, B1); PG8_BAR;
            PG8_LDB(B0, 1, 0); PG8_SCHED; PG8_LDA(At, 1, 0); PG8_STAGE(PG8_SA(0, 1), a2 + hstep, voffA);
            PG8_WAIT_L(8); PG8_BAR; PG8_WAIT_L(0); PG8_MMA(0, 0, At, B0); PG8_BAR; PG8_SCHED;
            PG8_LDB(B1, 1, 1); PG8_STAGE(PG8_SB(1, 0), b3, voffB);
            PG8_BAR; PG8_WAIT_L(0); PG8_MMA(0, 1, At, B1); PG8_BAR;
            PG8_LDA(At, 1, 1); PG8_STAGE(PG8_SA(1, 0), a3, voffA);
            PG8_BAR; PG8_WAIT_L(0); PG8_MMA(1, 0, At, B0); PG8_BAR; PG8_SCHED;
            PG8_STAGE(PG8_SB(1, 1), b3 + hstep, voffB);
            PG8_WAIT_V(6); PG8_BAR; PG8_MMA(1, 1, At, B1); PG8_BAR;
            }
        }
#if GP_TIME == 2
        if (wid == 0) { const unsigned long long tk1_ = __builtin_amdgcn_s_memrealtime(); if ((tid & 63) == 0) *(PG8_LAS unsigned*)(lds + 131072 + 128) += (unsigned)(tk1_ - tk0_); }
#elif GP_TIME == 3
        if (wid == 0) { const unsigned long long tk1_ = __builtin_amdgcn_s_memtime(); if ((tid & 63) == 0) *(PG8_LAS unsigned*)(lds + 131072 + 128) += (unsigned)((tk1_ - tk0_) / 20); }
#endif
        if constexpr (ALIGN_EPI) { if (wr == 0) PG8_BAR; }
        if constexpr (!Epi::AFTER_DRAIN) { int l_; asm volatile("v_mbcnt_lo_u32_b32 %0, -1, 0\n\tv_mbcnt_hi_u32_b32 %0, -1, %0" : "=v"(l_));
#if GP_TIME == 1
            const unsigned long long te0_ = __builtin_amdgcn_s_memrealtime();
#endif
            E(acc, cur, wr, wc, l_ & 15, l_ >> 4); S.done(cur);
#if GP_TIME == 1
            asm volatile("s_waitcnt vmcnt(0)" ::: "memory");
            if (wid == 0) { const unsigned long long te1_ = __builtin_amdgcn_s_memrealtime(); if ((tid & 63) == 0) *(PG8_LAS unsigned*)(lds + 131072 + 128) += (unsigned)(te1_ - te0_); }
#endif
            }
        if (!has_next) break;
#pragma unroll
        for (int a = 0; a < 2; ++a)
#pragma unroll
            for (int b = 0; b < 2; ++b)
#pragma unroll
                for (int m = 0; m < 4; ++m)
#pragma unroll
                    for (int n = 0; n < 2; ++n) acc[a][b][m][n] = (f32x4){0.f, 0.f, 0.f, 0.f};
        cur = nxt; cA = nA; cB = nB; ++ui;
        if constexpr (ALIGN_EPI) { if (wr == 1) PG8_BAR; }
    }
    PG8_WAIT_V(0);
    if constexpr (!ALIGN_EPI) { if (wr == 0) PG8_BAR; }
    PG8_BAR;
    if constexpr (Epi::AFTER_DRAIN) { E.fused(acc, cur, wr, wc, fr, fq, lds, wid, lane); S.done(cur); }
#undef PG8_SA
#undef PG8_SB
#undef PG8_STAGE
#undef PG8_LDA
#undef PG8_LDB
#undef PG8_MMA
#undef PG8_WAIT_V
#undef PG8_WAIT_L
#undef PG8_BAR
#undef PG8_SCHED
}
}

namespace mk {
using pg8::bf16_t; using pg8::bf16x8; using pg8::f32x4; using pg8::u32x4; using pg8::u32x2; using pg8::cvt_pk_bf16; using pg8::bf_lo; using pg8::bf_hi;
#define LAS __attribute__((address_space(3)))
#define LDS_WAIT() asm volatile("s_waitcnt lgkmcnt(0)" ::: "memory")
constexpr int M = 16384, D = 1024, FF = 2816, SEQ = 2048, PLE = 256;
constexpr int NWAVES = 8, NTHREADS = 512;
constexpr int LDS_BYTES = 147456;
constexpr size_t MiB = 1u << 20, HM = 512u * 1024u;
constexpr size_t WS_CTL = 0, CTL_BYTES = 2 * MiB;
constexpr size_t WS_BAR = 4096;
constexpr int LDSCTL_OFF = 131072;
constexpr size_t WS_DBG = 64 * 1024;
constexpr size_t WS_ROWSS = 1 * MiB;
constexpr size_t WS_W = 2 * MiB;
constexpr size_t W_GU1 = 0, W_D1 = 22 * HM, W_GU2 = 33 * HM, W_D2 = 55 * HM, W_GATE = 66 * HM, W_UP = 70 * HM, W_OUT = 71 * HM, W_IN = 75 * HM, WL_STRIDE = 85 * HM;
constexpr size_t WS_WTRIL = WS_W + 2 * WL_STRIDE;
constexpr size_t WS_HB = 88 * MiB;
constexpr size_t WS_T = 120 * MiB;
constexpr size_t WS_Y = 208 * MiB;
constexpr size_t WS_PB = 240 * MiB;
constexpr size_t WS_END = 256 * MiB;
constexpr size_t WS_SNAP = 256 * MiB;
constexpr int DBG_NT = 384;
static_assert(WS_WTRIL + 131072 <= WS_HB && WS_T + (size_t)M * FF * 2 <= WS_Y, "ws map");

struct Args { const float* in[28]; float* out; unsigned char* ws; int dbg; int pad; };
enum { I_X = 0, I_P, I_FFN1_NORM, I_FFN1_WGU, I_FFN1_WD, I_MIX_NORM, I_FFN2_NORM, I_FFN2_WGU, I_FFN2_WD, I_PLE_NORM, I_PLE_WG, I_PLE_WU, I_AB_WIN, I_GM_LNG, I_GM_LNB, I_GM_WS, I_GM_BS,
       I_SC_W, I_AB_WOUT, I_CD_WIN, I_POOL_W, I_POOL_SCALE, I_CV_W, I_CV_B, I_CV_LNG, I_CV_LNB, I_CD_WOUT, I_FINAL_NORM };

typedef const __attribute__((address_space(4))) unsigned char* kargp_t;
__device__ __forceinline__ kargp_t kargs() { kargp_t p = (kargp_t)__builtin_amdgcn_kernarg_segment_ptr(); asm volatile("" : "+s"(p)); return p; }
#define KIN(i) (*(const float* const __attribute__((address_space(4)))*)(kargs() + 8 * (i)))
#define KOUT (*(float* const __attribute__((address_space(4)))*)(kargs() + 8 * 28))
#define KWS (*(unsigned char* const __attribute__((address_space(4)))*)(kargs() + 8 * 29))
#define WSP(off) (KWS + (off))
#define ROWSS(k) ((float*)WSP(WS_ROWSS) + (size_t)(k) * M)
__device__ __forceinline__ int lane_id() { int l; asm volatile("v_mbcnt_lo_u32_b32 %0, -1, 0\n\tv_mbcnt_hi_u32_b32 %0, -1, %0" : "=v"(l)); return l; }
__device__ __forceinline__ int opaque_tid(int wave_s) { int t = (wave_s << 6) | lane_id(); asm volatile("" : "+v"(t)); return t; }
__device__ __forceinline__ float wave_sum(float v) { using pg8::add_xor; return pg8::add_xor32(add_xor<16>(add_xor<8>(add_xor<4>(add_xor<2>(add_xor<1>(v)))))); }
__device__ __forceinline__ void unpack8(const u32x4& w, float (&f)[8]) { f[0] = bf_lo(w.x); f[1] = bf_hi(w.x); f[2] = bf_lo(w.y); f[3] = bf_hi(w.y); f[4] = bf_lo(w.z); f[5] = bf_hi(w.z); f[6] = bf_lo(w.w); f[7] = bf_hi(w.w); }
__device__ __forceinline__ u32x4 pack8f(const float (&f)[8]) { u32x4 w; w.x = cvt_pk_bf16(f[0], f[1]); w.y = cvt_pk_bf16(f[2], f[3]); w.z = cvt_pk_bf16(f[4], f[5]); w.w = cvt_pk_bf16(f[6], f[7]); return w; }

__device__ __forceinline__ unsigned long long rt() { return __builtin_amdgcn_s_memrealtime(); }
#define XB_TMO      128
#define XB_XCNT(j)  (256  + 64 * (j))
#define XB_XSUB(j)  (1280 + 64 * (j))
#define XB_XGEN(j)  (2304 + 64 * (j))
#define XB_TOP      3328
#define XB_TOPGEN   3392
#define XCD_BAR_WORDS 3456
#define XB_SPIN_CAP (1u << 18)

__device__ __forceinline__ unsigned xb_ld(unsigned* p)              { return __hip_atomic_load(p, __ATOMIC_RELAXED, __HIP_MEMORY_SCOPE_AGENT); }
__device__ __forceinline__ unsigned xb_add(unsigned* p, unsigned v) { return __hip_atomic_fetch_add(p, v, __ATOMIC_RELAXED, __HIP_MEMORY_SCOPE_AGENT); }
__device__ __forceinline__ unsigned xb_xcc_id() { return (unsigned)__builtin_amdgcn_s_getreg((3 << 11) | 20) & 0xFu; }
#define XB_SPIN(cond, bar) do { unsigned _sp = 0; while (cond) { __builtin_amdgcn_s_sleep(1); \
    if ((++_sp & 255u) == 0u) { if (xb_ld(&(bar)[XB_TMO])) break; if (_sp > XB_SPIN_CAP) { atomicAdd(&(bar)[XB_TMO], 1u); break; } } } } while (0)

struct XcdBarrier {
    unsigned* bar; unsigned x;
    volatile LAS unsigned* st;
};

__device__ __forceinline__ XcdBarrier xcd_barrier_post(unsigned* bar, volatile LAS unsigned* st, const bool tid0) {
    XcdBarrier b; b.bar = bar; b.x = xb_xcc_id(); b.st = st;
    if (tid0) (void)xb_add(&bar[XB_XCNT(b.x)], 1u);
    return b;
}
__device__ __forceinline__ void xcd_barrier_complete(unsigned* bar, unsigned x, unsigned& nloc, unsigned& nx) {
    const unsigned G = gridDim.x * gridDim.y * gridDim.z;
    unsigned sum, cnt, mine, sp = 0u;
    for (;;) {
        sum = 0u; cnt = 0u; mine = 0u;
#pragma unroll
        for (unsigned j = 0; j < 16; ++j) { const unsigned c = xb_ld(&bar[XB_XCNT(j)]); sum += c; cnt += (c > 0u) ? 1u : 0u; mine = (j == x) ? c : mine; }
        if (sum == G) break;
        __builtin_amdgcn_s_sleep(1);
        if ((++sp & 255u) == 0u) { if (xb_ld(&bar[XB_TMO])) break; if (sp > XB_SPIN_CAP) { atomicAdd(&bar[XB_TMO], 1u); break; } }
    }
    nloc = mine > 0u ? mine : 1u; nx = cnt > 0u ? cnt : 1u;
}

__device__ __forceinline__ void xcd_barrier(const XcdBarrier& b, const int wave_s) {
    asm volatile("s_waitcnt vmcnt(0)" ::: "memory");
    __syncthreads();
    if (wave_s == 0 && lane_id() == 0) {
        unsigned* bar = b.bar; unsigned xq = b.x; asm volatile("" : "+s"(xq));
        __builtin_amdgcn_s_waitcnt(0);
        unsigned nloc = b.st[0], nx = b.st[1];
        if (nloc == 0u) { xcd_barrier_complete(bar, xq, nloc, nx); b.st[0] = nloc; b.st[1] = nx; }
        const unsigned old = xb_add(&bar[XB_XSUB(xq)], 1u);
        const unsigned gen = old / nloc;
        if (old + 1u == (gen + 1u) * nloc) {
            __builtin_amdgcn_fence(__ATOMIC_RELEASE, "agent");
            asm volatile("s_waitcnt vmcnt(0)" ::: "memory");
            const unsigned og = xb_add(&bar[XB_TOP], 1u);
            const unsigned tg = og / nx;
            if (og + 1u == (tg + 1u) * nx) xb_add(&bar[XB_TOPGEN], 1u);
            else XB_SPIN(xb_ld(&bar[XB_TOPGEN]) == tg, bar);
            __builtin_amdgcn_fence(__ATOMIC_ACQUIRE, "agent");
            xb_add(&bar[XB_XGEN(xq)], 1u);
            asm volatile("s_waitcnt vmcnt(0)" ::: "memory");
        } else {
            XB_SPIN(xb_ld(&bar[XB_XGEN(xq)]) == gen, bar);
            __builtin_amdgcn_fence(__ATOMIC_ACQUIRE, "agent");
            asm volatile("s_waitcnt vmcnt(0)" ::: "memory");
        }
    }
    __syncthreads();
}

struct TrItem { const float* src; const float* gain; bf16_t* dstblk; int ldsrc, lddst, k0; };
__device__ __forceinline__ void tr_load(const TrItem& t, f32x4 (&v)[8], float (&gn)[8], int lane) {
    const int r8 = lane >> 3, c4 = (lane & 7) * 4;
#pragma unroll
    for (int i = 0; i < 8; ++i) { v[i] = *(const f32x4*)(t.src + (size_t)(t.k0 + 8 * i + r8) * t.ldsrc + c4); gn[i] = t.gain ? t.gain[t.k0 + 8 * i + r8] : 1.0f; }
}
__device__ __forceinline__ void tr_store(const TrItem& t, const f32x4 (&v)[8], const float (&gn)[8], LAS float* scr, int lane) {
    const int r8 = lane >> 3, c4 = (lane & 7) * 4;
#pragma unroll
    for (int i = 0; i < 8; ++i) { LAS float* s = scr + (8 * i + r8) * 33 + c4; const f32x4 x = v[i] * gn[i]; s[0] = x[0]; s[1] = x[1]; s[2] = x[2]; s[3] = x[3]; }
    LDS_WAIT(); asm volatile("" ::: "memory");
    const int c = lane & 7;
#pragma unroll
    for (int j = 0; j < 4; ++j) { const int n = (lane >> 3) + 8 * j; const LAS float* s = scr + (8 * c) * 33 + n;
        u32x4 o; o.x = cvt_pk_bf16(s[0 * 33], s[1 * 33]); o.y = cvt_pk_bf16(s[2 * 33], s[3 * 33]); o.z = cvt_pk_bf16(s[4 * 33], s[5 * 33]); o.w = cvt_pk_bf16(s[6 * 33], s[7 * 33]);
        *(u32x4*)(t.dstblk + (size_t)n * t.lddst + t.k0 + 8 * c) = o; }
    LDS_WAIT(); asm volatile("" ::: "memory");
}
__device__ __forceinline__ int map_col(int map, int R) {
    if (map == 0) return R;
    if (map == 1) { const int pn = R >> 8, w = R & 255; return w < 128 ? 128 * pn + w : 2816 + 128 * pn + (w - 128); }
    if (map == 2) { if (R < 1024) return R; if (R < 2048) { const int t = (R - 1024) >> 8, w = (R - 1024) & 255; return w < 128 ? 1536 + 128 * t + w : 2048 + 128 * t + (w - 128); } return 1024 + (R - 2048); }
    if (R < 512) return R; { const int t = (R - 512) >> 8, w = (R - 512) & 255; return w < 128 ? 512 + 128 * t + w : 1024 + 128 * t + (w - 128); }
}
__device__ __forceinline__ void fold_item(LAS unsigned char* lds, int item, int tid) {
    const int g = item >> 5, nt = item & 31;
    const float* pw = KIN(I_POOL_W) + (size_t)g * 16384; const float* sc = KIN(I_POOL_SCALE) + 128 * g; const float* wo = KIN(I_CD_WOUT) + (size_t)(128 * g) * D + 32 * nt;
    bf16_t* dst = (bf16_t*)WSP(WS_W + WL_STRIDE + W_OUT);
    LAS float* Ps = (LAS float*)lds;
    {
        const int c = tid >> 2, d0 = (tid & 3) * 32;
#pragma unroll
        for (int j = 0; j < 8; ++j) { const f32x4 v = *(const f32x4*)(pw + c * 128 + d0 + 4 * j), s4 = *(const f32x4*)(sc + d0 + 4 * j);
#pragma unroll
            for (int e = 0; e < 4; ++e) Ps[(d0 + 4 * j + e) * 128 + c] = v[e] * s4[e]; }
    }
    __syncthreads();
    {
        const int n = tid & 31, cb = (tid >> 5) * 8; float acc[8];
#pragma unroll
        for (int e = 0; e < 8; ++e) acc[e] = 0.f;
#pragma unroll 8
        for (int d = 0; d < 128; ++d) { const float wv = wo[(size_t)d * D + n]; const LAS f32x4* pp = (const LAS f32x4*)(Ps + d * 128 + cb); const f32x4 p0 = pp[0], p1 = pp[1];
#pragma unroll
            for (int e = 0; e < 4; ++e) { acc[e] = fmaf(p0[e], wv, acc[e]); acc[4 + e] = fmaf(p1[e], wv, acc[4 + e]); } }
        *(u32x4*)(dst + (size_t)(32 * nt + n) * D + 128 * g + cb) = pack8f(acc);
    }
    __syncthreads();
}
enum : unsigned { JB_GU1 = 1u, JB_D1 = 2u, JB_GU2 = 4u, JB_D2 = 8u, JB_GATE = 16u, JB_UP = 32u, JB_OUT = 64u, JB_IN = 128u, JB_TRIL = 1u << 16, JB_FOLD = 1u << 17, JB_PB0 = 1u << 18, JB_PB1 = 1u << 19, JB_XHB = 1u << 20 };
__device__ __forceinline__ int job_items(int j) {
    const int L = j >> 3, k = j & 7;
    return k == 0 || k == 2 ? 16 * 176 : k == 1 || k == 3 ? 44 * 32 : k == 4 ? 16 * 32 : k == 5 ? 4 * 32 : k == 6 ? (L == 0 ? 16 * 32 : 8 * 32) : (L == 0 ? 16 * 80 : 16 * 48);
}
__device__ __forceinline__ void convert_jobs(LAS unsigned char* lds, const unsigned mask, int wi, int nw, int wave) {
    asm volatile("" : "+s"(wi), "+s"(nw), "+s"(wave));
    const int tid = opaque_tid(wave), lane = tid & 63;
    if (mask & JB_FOLD) for (int item = wi; item < 128; item += nw) fold_item(lds, item, tid);
    LAS float* scr = (LAS float*)(lds + wave * 16384);
    const int gw = wi * NWAVES + wave, NGW = nw * NWAVES;
    int total = 0;
#pragma unroll
    for (int j = 0; j < 16; ++j) if (mask & (1u << j)) total += job_items(j);
#define TR_DECODE(it_, T_) do { int r = (it_), j = 0; \
        _Pragma("unroll") for (int jj = 0; jj < 16; ++jj) if (mask & (1u << jj)) { const int n = job_items(jj); if (r >= 0 && r < n) { j = jj; r -= 0x40000000; } else if (r >= 0) r -= n; } \
        r += 0x40000000; \
        const int L = j >> 3, k = j & 7; const size_t wl = WS_W + (size_t)L * WL_STRIDE; \
        const float* src; const float* gain = nullptr; bf16_t* dst; int ldsrc, lddst, nblk, map = 0; \
        if (k == 0) { src = KIN(I_FFN1_WGU) + (size_t)L * D * 2 * FF; gain = KIN(I_FFN1_NORM) + L * D; dst = (bf16_t*)WSP(wl + W_GU1); ldsrc = 2 * FF; lddst = D; nblk = 176; map = 1; } \
        else if (k == 1) { src = KIN(I_FFN1_WD) + (size_t)L * FF * D; dst = (bf16_t*)WSP(wl + W_D1); ldsrc = D; lddst = FF; nblk = 32; } \
        else if (k == 2) { src = KIN(I_FFN2_WGU) + (size_t)L * D * 2 * FF; gain = KIN(I_FFN2_NORM) + L * D; dst = (bf16_t*)WSP(wl + W_GU2); ldsrc = 2 * FF; lddst = D; nblk = 176; map = 1; } \
        else if (k == 3) { src = KIN(I_FFN2_WD) + (size_t)L * FF * D; dst = (bf16_t*)WSP(wl + W_D2); ldsrc = D; lddst = FF; nblk = 32; } \
        else if (k == 4) { src = KIN(I_PLE_WG) + (size_t)L * D * D; gain = KIN(I_PLE_NORM) + L * D; dst = (bf16_t*)WSP(wl + W_GATE); ldsrc = D; lddst = D; nblk = 32; } \
        else if (k == 5) { src = KIN(I_PLE_WU) + (size_t)L * PLE * D; dst = (bf16_t*)WSP(wl + W_UP); ldsrc = D; lddst = PLE; nblk = 32; } \
        else if (k == 6) { if (L == 0) { src = KIN(I_AB_WOUT); dst = (bf16_t*)WSP(wl + W_OUT); } else { src = KIN(I_CD_WOUT) + (size_t)512 * D; dst = (bf16_t*)WSP(wl + W_OUT) + 512; }   \
                           ldsrc = D; lddst = D; nblk = 32; } \
        else { if (L == 0) { src = KIN(I_AB_WIN); ldsrc = 2560; nblk = 80; map = 2; } else { src = KIN(I_CD_WIN); ldsrc = 1536; nblk = 48; map = 3; } \
               gain = KIN(I_MIX_NORM) + L * D; dst = (bf16_t*)WSP(wl + W_IN); lddst = D; } \
        const int kb = r / nblk, nb = r - kb * nblk, R = 32 * nb; \
        T_.src = src + map_col(map, R); T_.gain = gain; T_.dstblk = dst + (size_t)R * lddst; T_.ldsrc = ldsrc; T_.lddst = lddst; T_.k0 = 64 * kb; } while (0)
    if (gw < total) {
        TrItem ta, tb; f32x4 va[8], vb[8]; float ga[8], gb[8];
        int it = gw; const int last = total - 1;
        TR_DECODE(it, ta); tr_load(ta, va, ga, lane);
        for (;;) {
            { const int nx = it + NGW < total ? it + NGW : last; TR_DECODE(nx, tb); tr_load(tb, vb, gb, lane); }
            tr_store(ta, va, ga, scr, lane);
            it += NGW; if (it >= total) break;
            { const int nx = it + NGW < total ? it + NGW : last; TR_DECODE(nx, ta); tr_load(ta, va, ga, lane); }
            tr_store(tb, vb, gb, scr, lane);
            it += NGW; if (it >= total) break;
        }
    }
#undef TR_DECODE
    if (mask & JB_XHB) {
        const float* x = KIN(I_X); bf16_t* hb = (bf16_t*)WSP(WS_HB); float* rowss0 = (float*)WSP(WS_ROWSS);
        for (int row = 2 * gw; row < M; row += 2 * NGW) {
            const f32x4* xr = (const f32x4*)(x + (size_t)row * D) + lane; u32x2* o = (u32x2*)(hb + (size_t)row * D) + lane; f32x4 v[8];
#pragma unroll
            for (int j = 0; j < 8; ++j) v[j] = xr[64 * j];
            float ss0 = 0.f, ss1 = 0.f;
#pragma unroll
            for (int j = 0; j < 4; ++j) { ss0 += v[j][0] * v[j][0] + v[j][1] * v[j][1] + v[j][2] * v[j][2] + v[j][3] * v[j][3]; ss1 += v[4 + j][0] * v[4 + j][0] + v[4 + j][1] * v[4 + j][1] + v[4 + j][2] * v[4 + j][2] + v[4 + j][3] * v[4 + j][3]; }
#pragma unroll
            for (int j = 0; j < 8; ++j) { u32x2 w; w.x = cvt_pk_bf16(v[j][0], v[j][1]); w.y = cvt_pk_bf16(v[j][2], v[j][3]); o[64 * j] = w; }
            ss0 = wave_sum(ss0); ss1 = wave_sum(ss1);
            if (lane == 0) { rowss0[row] = ss0; rowss0[row + 1] = ss1; }
        }
    }
    const int gt = gw * 64 + lane, NGT = NGW * 64;
#pragma unroll
    for (int L = 0; L < 2; ++L) if (mask & (L == 0 ? JB_PB0 : JB_PB1)) {
        const float* p = KIN(I_P) + (size_t)L * M * PLE; bf16_t* pb = (bf16_t*)WSP(WS_PB) + (size_t)L * M * PLE; constexpr int Q4 = M * PLE / 32;
        for (int t = gt; t < Q4; t += NGT) { f32x4 v[8];
#pragma unroll
            for (int j = 0; j < 4; ++j) { const size_t e = ((size_t)t + (size_t)j * Q4) * 8; v[2 * j] = *(const f32x4*)(p + e); v[2 * j + 1] = *(const f32x4*)(p + e + 4); }
#pragma unroll
            for (int j = 0; j < 4; ++j) { const size_t e = ((size_t)t + (size_t)j * Q4) * 8; *(u32x4*)(pb + e) = pg8::pack8(v[2 * j], v[2 * j + 1]); } }
    }
    if (mask & JB_TRIL) {
        const float* w = KIN(I_GM_WS); bf16_t* wt = (bf16_t*)WSP(WS_WTRIL);
        for (int t = gt; t < 4 * 128 * 128 / 8; t += NGT) { const int e0 = t * 8, tt = (e0 >> 7) & 127, s0 = e0 & 127; float f[8];
#pragma unroll
            for (int j = 0; j < 8; ++j) f[j] = (s0 + j <= tt) ? w[e0 + j] : 0.f;
            *(u32x4*)(wt + e0) = pack8f(f); }
    }
    __syncthreads();
}
constexpr unsigned JM_ALL = 0xffffu | JB_TRIL | JB_FOLD | JB_PB0 | JB_PB1 | JB_XHB;
constexpr unsigned JM_PREP = JB_XHB | JB_GU1 | (JB_GU1 << 8);
constexpr unsigned JM_B1 = JB_D1 | JB_IN | JB_OUT | JB_TRIL | JB_D2 | JB_GATE;
constexpr unsigned JM_B2 = JB_GU2 | JB_UP | JB_PB0;
constexpr unsigned JM_B3 = ((JB_D1 | JB_IN | JB_OUT | JB_D2 | JB_GATE) << 8) | JB_FOLD;
constexpr unsigned JM_B4 = ((JB_GU2 | JB_UP) << 8) | JB_PB1;
static_assert((JM_PREP | JM_B1 | JM_B2 | JM_B3 | JM_B4) == JM_ALL && (JM_PREP & JM_B1) == 0 && ((JM_PREP | JM_B1) & JM_B2) == 0 && ((JM_PREP | JM_B1 | JM_B2) & JM_B3) == 0 && ((JM_PREP | JM_B1 | JM_B2 | JM_B3) & JM_B4) == 0, "every job exactly once");

__device__ __forceinline__ void mix0_phase(LAS unsigned char* lds, int vcu, int G, int wave) {
    asm volatile("" : "+s"(vcu), "+s"(G), "+s"(wave));
    const int tid = opaque_tid(wave), lane = tid & 63;
    unsigned char* ws = KWS;
    const bf16_t* UV = (const bf16_t*)(ws + WS_T); const bf16_t* Q = UV + (size_t)M * 1024; const bf16_t* BG = Q + (size_t)M * 512;
    bf16_t* Y = (bf16_t*)(ws + WS_Y); const bf16_t* Wtril = (const bf16_t*)(ws + WS_WTRIL);
    LAS bf16_t* vgT = (LAS bf16_t*)lds;
    const int fr = lane & 15, fq = lane >> 4;
    for (int item = vcu; item < 512; item += G) {
        const int c = item >> 2, g = item & 3;
        {
            const int tok = tid >> 2, qt = tid & 3;
            const u32x4* src = (const u32x4*)(UV + (size_t)(c * 128 + tok) * 1024 + 512 + g * 128 + qt * 32);
            float v[32];
#pragma unroll
            for (int j = 0; j < 4; ++j) { const u32x4 w = src[j]; float f[8]; unpack8(w, f);
#pragma unroll
                for (int e = 0; e < 8; ++e) v[8 * j + e] = f[e]; }
            float s = 0.f;
#pragma unroll
            for (int i = 0; i < 32; ++i) s += v[i];
            s = pg8::add_xor<2>(pg8::add_xor<1>(s));
            const float mean = s * (1.0f / 128.0f); float q = 0.f;
#pragma unroll
            for (int i = 0; i < 32; ++i) { v[i] -= mean; q += v[i] * v[i]; }
            q = pg8::add_xor<2>(pg8::add_xor<1>(q));
            const float rstd = __builtin_amdgcn_rsqf(q * (1.0f / 128.0f) + 1e-5f);
            const float* lg = KIN(I_GM_LNG) + g * 128 + qt * 32; const float* lb = KIN(I_GM_LNB) + g * 128 + qt * 32;
#pragma unroll
            for (int i = 0; i < 32; ++i) { const float val = v[i] * rstd * lg[i] + lb[i]; vgT[(qt * 32 + i) * 136 + tok] = (bf16_t)(cvt_pk_bf16(val, 0.f) & 0xffffu); }
        }
        __syncthreads();
        {
            f32x4 acc[8];
#pragma unroll
            for (int nt = 0; nt < 8; ++nt) acc[nt] = (f32x4){0.f, 0.f, 0.f, 0.f};
            const int nks = ((16 * wave + 15) >> 5) + 1;
            const bf16_t* wrow = Wtril + (size_t)g * 16384 + (16 * wave + fr) * 128 + 8 * fq;
            for (int ks = 0; ks < nks; ++ks) {
                const bf16x8 wf = *(const bf16x8*)(wrow + 32 * ks);
#pragma unroll
                for (int nt = 0; nt < 8; ++nt) { const bf16x8 vf = *(const LAS bf16x8*)(vgT + (16 * nt + fr) * 136 + 32 * ks + 8 * fq);
                    acc[nt] = __builtin_amdgcn_mfma_f32_16x16x32_bf16(vf, wf, acc[nt], 0, 0, 0); }
            }
            const int t = 16 * wave + fr; const size_t row = (size_t)c * 128 + t; const float bias = KIN(I_GM_BS)[g * 128 + t];
#pragma unroll
            for (int nt = 0; nt < 8; ++nt) { const int d = 16 * nt + 4 * fq; const u32x2 uu = *(const u32x2*)(UV + row * 1024 + g * 128 + d);
                u32x2 o; o.x = cvt_pk_bf16(bf_lo(uu.x) * (acc[nt][0] + bias), bf_hi(uu.x) * (acc[nt][1] + bias)); o.y = cvt_pk_bf16(bf_lo(uu.y) * (acc[nt][2] + bias), bf_hi(uu.y) * (acc[nt][3] + bias));
                *(u32x2*)(Y + row * 1024 + g * 128 + d) = o; }
        }
        __syncthreads();
    }
    for (int wi = vcu * NWAVES + wave; wi < M / 8; wi += G * NWAVES) {
        const int r0 = wi * 8, pos0 = r0 & (SEQ - 1);
        const float* sw = KIN(I_SC_W) + 8 * lane; float w0[8], w1[8], w2[8];
#pragma unroll
        for (int e = 0; e < 8; ++e) { w0[e] = sw[e]; w1[e] = sw[512 + e]; w2[e] = sw[1024 + e]; }
        float qm2[8], qm1[8];
#pragma unroll
        for (int e = 0; e < 8; ++e) { qm2[e] = 0.f; qm1[e] = 0.f; }
        if (pos0 != 0) { unpack8(*(const u32x4*)(Q + (size_t)(r0 - 2) * 512 + 8 * lane), qm2); unpack8(*(const u32x4*)(Q + (size_t)(r0 - 1) * 512 + 8 * lane), qm1); }
#pragma unroll
        for (int t = 0; t < 8; ++t) { float qv[8], bg[8], y[8]; unpack8(*(const u32x4*)(Q + (size_t)(r0 + t) * 512 + 8 * lane), qv); unpack8(*(const u32x4*)(BG + (size_t)(r0 + t) * 512 + 8 * lane), bg);
#pragma unroll
            for (int e = 0; e < 8; ++e) { y[e] = bg[e] * (w0[e] * qm2[e] + w1[e] * qm1[e] + w2[e] * qv[e]); qm2[e] = qm1[e]; qm1[e] = qv[e]; }
            *(u32x4*)(Y + (size_t)(r0 + t) * 1024 + 512 + 8 * lane) = pack8f(y); }
    }
}

__device__ __forceinline__ void mix1_phase(LAS unsigned char* lds, int vcu, int G, int wave) {
    asm volatile("" : "+s"(vcu), "+s"(G), "+s"(wave));
    const int tid = opaque_tid(wave), lane = tid & 63;
    unsigned char* ws = KWS;
    const bf16_t* ZC = (const bf16_t*)(ws + WS_T); const bf16_t* S = ZC + (size_t)M * 512; bf16_t* Y = (bf16_t*)(ws + WS_Y);
    for (int r = vcu * NWAVES + wave; r < M; r += G * NWAVES) {
        const int pos = r & (SEQ - 1), win = 2 << (lane >> 4), cnt = (pos + 1 < win) ? pos + 1 : win;
        float sum[8], x0[8];
        unpack8(*(const u32x4*)(ZC + (size_t)r * 512 + 8 * lane), x0);
#pragma unroll
        for (int e = 0; e < 8; ++e) sum[e] = x0[e];
        for (int k = 1; k < 16; ++k) { if (k < cnt) { float f[8]; unpack8(*(const u32x4*)(ZC + (size_t)(r - k) * 512 + 8 * lane), f);
#pragma unroll
                for (int e = 0; e < 8; ++e) sum[e] += f[e]; } }
        const float inv = 1.0f / (float)cnt; float y[8];
#pragma unroll
        for (int e = 0; e < 8; ++e) y[e] = sum[e] * inv - x0[e];
        *(u32x4*)(Y + (size_t)r * 1024 + 8 * lane) = pack8f(y);
    }
    LAS unsigned char* sl = lds;
    LAS float* hbuf = (LAS float*)(lds + 62 * 1024);
    const int cp = tid & 255, half = tid >> 8;
    float cw[31][2];
#pragma unroll
    for (int k = 0; k < 31; ++k) { cw[k][0] = KIN(I_CV_W)[k * 512 + 2 * cp]; cw[k][1] = KIN(I_CV_W)[k * 512 + 2 * cp + 1]; }
    const float cb0 = KIN(I_CV_B)[2 * cp], cb1 = KIN(I_CV_B)[2 * cp + 1];
    for (int item = vcu; item < M / 32; item += G) {
        const int t0 = item * 32, pos0 = t0 & (SEQ - 1);
#pragma unroll
        for (int ps = 0; ps < 8; ++ps) { const int row = ps * 8 + (tid >> 6);
            if (row < 62) { u32x4 v = (u32x4){0u, 0u, 0u, 0u}; if (pos0 - 30 + row >= 0) v = *(const u32x4*)(S + (size_t)(t0 - 30 + row) * 512 + 8 * (tid & 63));
                *(LAS u32x4*)(sl + row * 1024 + (tid & 63) * 16) = v; } }
        __syncthreads();
#pragma unroll
        for (int run = 0; run < 2; ++run) {
            const int tl = half * 16 + run * 8;
            float acc[8][2];
#pragma unroll
            for (int o = 0; o < 8; ++o) { acc[o][0] = cb0; acc[o][1] = cb1; }
#pragma unroll
            for (int i = 0; i < 38; ++i) { const unsigned w = *(const LAS unsigned*)(sl + (tl + i) * 1024 + cp * 4); const float x0 = bf_lo(w), x1 = bf_hi(w);
#pragma unroll
                for (int o = 0; o < 8; ++o) { const int k = i - o; if (k >= 0 && k < 31) { acc[o][0] = fmaf(cw[k][0], x0, acc[o][0]); acc[o][1] = fmaf(cw[k][1], x1, acc[o][1]); } } }
#pragma unroll
            for (int o = 0; o < 8; ++o) { typedef float f32x2v __attribute__((ext_vector_type(2))); *(LAS f32x2v*)(hbuf + (tl + o) * 512 + 2 * cp) = (f32x2v){acc[o][0], acc[o][1]}; }
        }
        __syncthreads();
#pragma unroll
        for (int tt = 0; tt < 4; ++tt) { const int tl = wave * 4 + tt; const LAS f32x4* hp = (const LAS f32x4*)(hbuf + tl * 512 + 8 * lane); const f32x4 h0 = hp[0], h1 = hp[1];
            float s = (h0[0] + h0[1]) + (h0[2] + h0[3]) + (h1[0] + h1[1]) + (h1[2] + h1[3]); s = wave_sum(s);
            const float mean = s * (1.0f / 512.0f); const f32x4 d0 = h0 - mean, d1 = h1 - mean;
            float q = (d0[0] * d0[0] + d0[1] * d0[1]) + (d0[2] * d0[2] + d0[3] * d0[3]) + (d1[0] * d1[0] + d1[1] * d1[1]) + (d1[2] * d1[2] + d1[3] * d1[3]); q = wave_sum(q);
            const float rstd = __builtin_amdgcn_rsqf(q * (1.0f / 512.0f) + 1e-5f);
            const f32x4 g0 = *(const f32x4*)(KIN(I_CV_LNG) + 8 * lane), g1 = *(const f32x4*)(KIN(I_CV_LNG) + 8 * lane + 4), b0 = *(const f32x4*)(KIN(I_CV_LNB) + 8 * lane), b1 = *(const f32x4*)(KIN(I_CV_LNB) + 8 * lane + 4);
            float y[8];
#pragma unroll
            for (int e = 0; e < 4; ++e) { y[e] = pg8::fsilu(d0[e] * rstd * g0[e] + b0[e]); y[4 + e] = pg8::fsilu(d1[e] * rstd * g1[e] + b1[e]); }
            *(u32x4*)(Y + (size_t)(t0 + tl) * 1024 + 512 + 8 * lane) = pack8f(y); }
        __syncthreads();
    }
}

__device__ __forceinline__ void final_phase(int vcu, int G, int wave) {
    asm volatile("" : "+s"(vcu), "+s"(G), "+s"(wave));
    const int tid = opaque_tid(wave), lane = tid & 63;
    const int gw = vcu * NWAVES + wave, NGW = G * NWAVES;
    const bf16_t* hb = (const bf16_t*)WSP(WS_HB); float* out = KOUT; const f32x4* g4 = (const f32x4*)KIN(I_FINAL_NORM);
    for (int row = gw; row < M; row += NGW) {
        const u32x4 w0 = *(const u32x4*)(hb + (size_t)row * D + 8 * lane), w1 = *(const u32x4*)(hb + (size_t)row * D + 512 + 8 * lane);
        float a[8], b[8]; unpack8(w0, a); unpack8(w1, b); float ss = 0.f;
#pragma unroll
        for (int e = 0; e < 8; ++e) ss += a[e] * a[e] + b[e] * b[e];
        ss = wave_sum(ss); const float r = pg8::rstd_of(ss);
        const f32x4 ga0 = g4[2 * lane], ga1 = g4[2 * lane + 1], gb0 = g4[128 + 2 * lane], gb1 = g4[128 + 2 * lane + 1];
        f32x4* o = (f32x4*)(out + (size_t)row * D + 8 * lane);
        o[0] = (f32x4){a[0], a[1], a[2], a[3]} * r * ga0; o[1] = (f32x4){a[4], a[5], a[6], a[7]} * r * ga1;
        o[128] = (f32x4){b[0], b[1], b[2], b[3]} * r * gb0; o[129] = (f32x4){b[4], b[5], b[6], b[7]} * r * gb1; }
}

#if DBG
__device__ __forceinline__ void dbg_compare(int cp, int vcu, int G, int wave) {
    asm volatile("" : "+s"(vcu), "+s"(G), "+s"(wave));
    const int tid = opaque_tid(wave), lane = tid & 63;
    const bf16_t* snap = (const bf16_t*)(KWS + WS_SNAP) + (size_t)cp * DBG_NT * D; float* res = (float*)(KWS + WS_DBG);
    for (int row = vcu * NWAVES + wave; row < DBG_NT; row += G * NWAVES) { float e2 = 0.f, r2 = 0.f;
        for (int j = 0; j < 16; ++j) { const int c = lane + 64 * j; const float hv = __uint_as_float((unsigned)((const bf16_t*)WSP(WS_HB))[(size_t)row * D + c] << 16); const float sv = __uint_as_float((unsigned)snap[(size_t)row * D + c] << 16); e2 += (hv - sv) * (hv - sv); r2 += sv * sv; }
        e2 = wave_sum(e2); r2 = wave_sum(r2);
        if (lane == 0) { atomicAdd(res + 2 * cp, e2); atomicAdd(res + 2 * cp + 1, r2); } }
}
#endif

__global__ void __launch_bounds__(NTHREADS, 2) mk_fwd(Args a_unused) {
    extern __shared__ __attribute__((aligned(16))) unsigned char lds_raw[];
    LAS unsigned char* lds = (LAS unsigned char*)lds_raw;
    cg::grid_group grid = cg::this_grid();
    const int wave_s = __builtin_amdgcn_readfirstlane(threadIdx.x >> 6);
    const int G = gridDim.x, bx = blockIdx.x;
    const int vcu = (G % 8 == 0) ? (bx % 8) * (G / 8) + bx / 8 : bx;
    const bool bub = (G == 256);
    const int bwi = (bx & 7) * 16 + ((bx >> 3) - 16);
    for (int u = threadIdx.x; u < 64; u += NTHREADS) ((LAS unsigned*)(lds + LDSCTL_OFF))[u] = 0u;
    __syncthreads();
    const XcdBarrier xbar = xcd_barrier_post((unsigned*)WSP(WS_BAR), (volatile LAS unsigned*)(lds + LDSCTL_OFF + 32), threadIdx.x == 0);
#if GP_TIME == 4
    int bari_ = 0;
#define GRID_SYNC() do { const unsigned long long tb0_ = rt(); xcd_barrier(xbar, wave_s); if (((GP_BMASK) >> (bari_ == 0 ? 8 : (bari_ - 1) % 8)) & 1) { if (wave_s == 0 && lane_id() == 0) *(volatile LAS unsigned*)(lds + LDSCTL_OFF + 128) += (unsigned)(rt() - tb0_); } ++bari_; } while (0)
#else
#define GRID_SYNC() xcd_barrier(xbar, wave_s)
#endif
#if DBG
    int dcp = 0;
#define DBG_CP() do { dbg_compare(dcp, vcu, G, wave_s); ++dcp; GRID_SYNC(); } while (0)
#else
#define DBG_CP() do { } while (0)
#endif
#define GEMM_PHASE(EPI, A_, B_, N_, K_, ...) GEMM_PHASE_X(EPI, G, bx, A_, B_, N_, K_, __VA_ARGS__)
#define GEMM_PHASE_X(EPI, GX_, CX_, A_, B_, N_, K_, ...) do { int G_ = (GX_), bx_ = (CX_), w_ = wave_s; asm volatile("" : "+s"(G_), "+s"(bx_), "+s"(w_));     \
        pg8::Gemm g_{(const bf16_t*)(A_), (const bf16_t*)(B_), M, (N_), (K_)}; pg8::StaticOrder S_; S_.init(M, (N_), G_, bx_); \
        pg8::EPI E_{__VA_ARGS__}; pg8::gemm_phase<pg8::EPI, pg8::StaticOrder, GP_ALIGN, GP_SP2>(lds, g_, S_, E_, w_); } while (0)

#if STAMPS
    unsigned long long st_[6]; int sti_ = 0;
#define STAMP_AT() do { if (sti_ < 6) st_[sti_] = rt(); ++sti_; } while (0)
#else
#define STAMP_AT() do { } while (0)
#endif
    STAMP_AT();
#pragma unroll 1
    for (int rep = 0; rep < (PROBE == 1 ? 2 : 1); ++rep) {
    convert_jobs(lds, bub ? JM_PREP : JM_ALL, vcu, G, wave_s);
    if (G == 0x7fffffff) grid.sync();
    GRID_SYNC();
    }
    STAMP_AT();
#if PROBE == 8
#undef GRID_SYNC
#define GRID_SYNC() do { xcd_barrier(xbar, wave_s); xcd_barrier(xbar, wave_s); } while (0)
#endif

#pragma unroll 1
    for (int L = 0; L < 2; ++L) {
        const size_t wl = WS_W + (size_t)L * WL_STRIDE;
        const int cur = 4 * L;
#pragma unroll 1
        for (int rep = 0; rep < (PROBE == 2 ? 2 : 1); ++rep) {
        GEMM_PHASE(EpiSwiglu, WSP(WS_HB), WSP(wl + W_GU1), 2 * FF, D, (bf16_t*)WSP(WS_T), ROWSS(cur));
        if (bub && bx >= 128 && rep == 0) { if (L == 0) convert_jobs(lds, JM_B1, bwi, 128, wave_s); else convert_jobs(lds, JM_B3, bwi, 128, wave_s); }
        GRID_SYNC();
        }
        if (PROBE == 3) { GEMM_PHASE(EpiResDry, WSP(WS_T), WSP(wl + W_D1), D, FF, (bf16_t*)WSP(WS_HB), ROWSS(cur + 1), 0.5f); GRID_SYNC(); }
        GEMM_PHASE(EpiRes, WSP(WS_T), WSP(wl + W_D1), D, FF, (bf16_t*)WSP(WS_HB), ROWSS(cur + 1), 0.5f);
        GRID_SYNC();
        DBG_CP();
#pragma unroll 1
        for (int rep = 0; rep < (PROBE == 4 ? 2 : 1); ++rep) {
        if (L == 0) GEMM_PHASE(EpiMix0, WSP(WS_HB), WSP(wl + W_IN), 2560, D, ROWSS(cur + 1), (bf16_t*)WSP(WS_T), (bf16_t*)WSP(WS_T) + (size_t)M * 1024, (bf16_t*)WSP(WS_T) + (size_t)M * 1536);
        else GEMM_PHASE(EpiMix1, WSP(WS_HB), WSP(wl + W_IN), 1536, D, ROWSS(cur + 1), (bf16_t*)WSP(WS_T), (bf16_t*)WSP(WS_T) + (size_t)M * 512);
        if (bub && bx >= 128 && rep == 0) { if (L == 0) convert_jobs(lds, JM_B2, bwi, 128, wave_s); else convert_jobs(lds, JM_B4, bwi, 128, wave_s); }
        GRID_SYNC();
        }
#pragma unroll 1
        for (int rep = 0; rep < (PROBE == 5 ? 2 : 1); ++rep) {
        if (L == 0) mix0_phase(lds, vcu, G, wave_s); else mix1_phase(lds, vcu, G, wave_s);
        GRID_SYNC();
        }
        if (PROBE == 6) { GEMM_PHASE(EpiResDry, WSP(WS_Y), WSP(wl + W_OUT), D, D, (bf16_t*)WSP(WS_HB), ROWSS(cur + 2), 1.0f); GRID_SYNC(); }
        GEMM_PHASE(EpiRes, WSP(WS_Y), WSP(wl + W_OUT), D, D, (bf16_t*)WSP(WS_HB), ROWSS(cur + 2), 1.0f);
        GRID_SYNC();
        DBG_CP();
#pragma unroll 1
        for (int rep = 0; rep < (PROBE == 2 ? 2 : 1); ++rep) {
        GEMM_PHASE(EpiSwiglu, WSP(WS_HB), WSP(wl + W_GU2), 2 * FF, D, (bf16_t*)WSP(WS_T), ROWSS(cur + 2));
#pragma unroll 1
        for (int rep2 = 0; rep2 < (PROBE == 7 ? 2 : 1); ++rep2) {
            if (G == 256) { if (bx >= 128) GEMM_PHASE_X(EpiPlain, 128, bx - 128, (const bf16_t*)WSP(WS_PB) + (size_t)L * M * PLE, WSP(wl + W_UP), D, PLE, (bf16_t*)WSP(WS_Y)); }
            else GEMM_PHASE(EpiPlain, (const bf16_t*)WSP(WS_PB) + (size_t)L * M * PLE, WSP(wl + W_UP), D, PLE, (bf16_t*)WSP(WS_Y));
        }
        GRID_SYNC();
        }
        if (PROBE == 3) { GEMM_PHASE(EpiResDry, WSP(WS_T), WSP(wl + W_D2), D, FF, (bf16_t*)WSP(WS_HB), ROWSS(cur + 3), 0.5f); GRID_SYNC(); }
        GEMM_PHASE(EpiRes, WSP(WS_T), WSP(wl + W_D2), D, FF, (bf16_t*)WSP(WS_HB), ROWSS(cur + 3), 0.5f);
        GRID_SYNC();
        DBG_CP();
        if (PROBE == 6) { GEMM_PHASE(EpiPleDry, WSP(WS_HB), WSP(wl + W_GATE), D, D, ROWSS(cur + 3), (const bf16_t*)WSP(WS_Y), (bf16_t*)WSP(WS_HB), L == 0 ? ROWSS(cur + 4) : (float*)nullptr); GRID_SYNC(); }
        GEMM_PHASE(EpiPle, WSP(WS_HB), WSP(wl + W_GATE), D, D, ROWSS(cur + 3), (const bf16_t*)WSP(WS_Y), (bf16_t*)WSP(WS_HB), L == 0 ? ROWSS(cur + 4) : (float*)nullptr);
        GRID_SYNC();
        DBG_CP();
    }
    STAMP_AT();
#if STAMPS == 3
    final_phase(vcu, G, wave_s); GRID_SYNC(); STAMP_AT();
#endif
#if STAMPS
    {
#if STAMPS == 4
        if (bx == 0) { const unsigned long long d_ = *(volatile LAS unsigned*)(lds + LDSCTL_OFF + 128), t_ = rt(); while (rt() - t_ < d_) __builtin_amdgcn_s_sleep(8); }
#else
        if (bx == 0) { const unsigned long long d_ = st_[STAMPS] - st_[STAMPS - 1], t_ = rt(); while (rt() - t_ < d_) __builtin_amdgcn_s_sleep(8); }
#endif
        GRID_SYNC();
    }
#endif
    final_phase(vcu, G, wave_s);
}
}
#if DBG
namespace v0 {
constexpr int D = 1024, SEQ = 2048, BATCH = 8, PLE = 256, FF = 2816;
constexpr int WA = 512, WB = 512, WC = 512, WD = 512, CHUNK = 128;
constexpr int IN_EVEN = 2560, IN_ODD = 1536;
constexpr float RMS_EPS = 1e-6f, LN_EPS = 1e-5f;

__device__ __forceinline__ float wave_sum(float v) {
#pragma unroll
    for (int o = 1; o < 64; o <<= 1) v += __shfl_xor(v, o);
    return v;
}
__device__ __forceinline__ float sigmoidf_(float x) { return 1.0f / (1.0f + expf(-x)); }
__device__ __forceinline__ float siluf_(float x) { return x * sigmoidf_(x); }
__device__ __forceinline__ float gelu_tanh(float x) {
    const float c = 0.7978845608028654f;
    return 0.5f * x * (1.0f + tanhf(c * (x + 0.044715f * x * x * x)));
}

__global__ __launch_bounds__(256) void k_rmsnorm(const float* x, const float* gain, float* y, int rows) {
    const int row = blockIdx.x * 4 + (threadIdx.x >> 6), lane = threadIdx.x & 63;
    if (row >= rows) return;
    const float4* xr = (const float4*)(x + (size_t)row * D);
    float4 v[4]; float s = 0.f;
#pragma unroll
    for (int j = 0; j < 4; ++j) { v[j] = xr[lane + 64 * j]; s += v[j].x * v[j].x + v[j].y * v[j].y + v[j].z * v[j].z + v[j].w * v[j].w; }
    s = wave_sum(s);
    const float r = 1.0f / sqrtf(s * (1.0f / D) + RMS_EPS);
    float4* yr = (float4*)(y + (size_t)row * D);
    const float4* g4 = (const float4*)gain;
#pragma unroll
    for (int j = 0; j < 4; ++j) { const float4 g = g4[lane + 64 * j]; float4 o; o.x = v[j].x * r * g.x; o.y = v[j].y * r * g.y; o.z = v[j].z * r * g.z; o.w = v[j].w * r * g.w; yr[lane + 64 * j] = o; }
}

struct GemmP { const float* A; const float* B; float* C; int M, N, K, lda, ldb, ldc; long sA1, sB1, sC1, sA2, sB2, sC2; int nb2; int tril; };
__global__ __launch_bounds__(256) void k_gemm(GemmP p) {
    __shared__ float As[16][68];
    __shared__ float Bs[16][68];
    const int z1 = blockIdx.z / p.nb2, z2 = blockIdx.z % p.nb2;
    const float* A = p.A + z1 * p.sA1 + z2 * p.sA2;
    const float* B = p.B + z1 * p.sB1 + z2 * p.sB2;
    float* C = p.C + z1 * p.sC1 + z2 * p.sC2;
    const int t = threadIdx.x, tx = t & 15, ty = t >> 4;
    const int m0 = blockIdx.y * 64, n0 = blockIdx.x * 64;
    float acc[4][4];
#pragma unroll
    for (int i = 0; i < 4; ++i)
#pragma unroll
        for (int j = 0; j < 4; ++j) acc[i][j] = 0.f;
    const int ar = t >> 2, ak = (t & 3) * 4;
    const int bk = t >> 4, bn = (t & 15) * 4;
    for (int k0 = 0; k0 < p.K; k0 += 16) {
        float4 av = *(const float4*)(A + (size_t)(m0 + ar) * p.lda + k0 + ak);
        if (p.tril) {
            const int tt = m0 + ar, ss = k0 + ak;
            if (ss + 0 > tt) av.x = 0.f; if (ss + 1 > tt) av.y = 0.f; if (ss + 2 > tt) av.z = 0.f; if (ss + 3 > tt) av.w = 0.f;
        }
        const float4 bv = *(const float4*)(B + (size_t)(k0 + bk) * p.ldb + n0 + bn);
        As[ak + 0][ar] = av.x; As[ak + 1][ar] = av.y; As[ak + 2][ar] = av.z; As[ak + 3][ar] = av.w;
        *(float4*)&Bs[bk][bn] = bv;
        __syncthreads();
#pragma unroll
        for (int k = 0; k < 16; ++k) {
            const float4 a = *(const float4*)&As[k][ty * 4];
            const float4 b = *(const float4*)&Bs[k][tx * 4];
            const float aa[4] = {a.x, a.y, a.z, a.w}, bb[4] = {b.x, b.y, b.z, b.w};
#pragma unroll
            for (int i = 0; i < 4; ++i)
#pragma unroll
                for (int j = 0; j < 4; ++j) acc[i][j] = fmaf(aa[i], bb[j], acc[i][j]);
        }
        __syncthreads();
    }
#pragma unroll
    for (int i = 0; i < 4; ++i) {
        float4 o; o.x = acc[i][0]; o.y = acc[i][1]; o.z = acc[i][2]; o.w = acc[i][3];
        *(float4*)(C + (size_t)(m0 + ty * 4 + i) * p.ldc + n0 + tx * 4) = o;
    }
}

__global__ void k_swiglu(const float* z, float* t, int rows) {
    const size_t i = (size_t)blockIdx.x * blockDim.x + threadIdx.x;
    if (i >= (size_t)rows * FF) return;
    const size_t r = i / FF, j = i % FF;
    t[i] = siluf_(z[r * (2 * FF) + j]) * z[r * (2 * FF) + FF + j];
}
__global__ void k_add_scaled(float* h, const float* y, float sc, size_t n) {
    const size_t i = (size_t)blockIdx.x * blockDim.x + threadIdx.x;
    if (i < n) h[i] += sc * y[i];
}
__global__ __launch_bounds__(256) void k_gelu_ln(const float* z, const float* ln_g, const float* ln_b, float* u, float* vg, int rows) {
    const int wid = blockIdx.x * 4 + (threadIdx.x >> 6), lane = threadIdx.x & 63;
    const int row = wid >> 2, g = wid & 3;
    if (row >= rows) return;
    const float* zr = z + (size_t)row * IN_EVEN;
    const int c0 = g * 128 + lane * 2;
    u[(size_t)row * WA + c0] = gelu_tanh(zr[c0]); u[(size_t)row * WA + c0 + 1] = gelu_tanh(zr[c0 + 1]);
    const float v0 = gelu_tanh(zr[WA + c0]), v1 = gelu_tanh(zr[WA + c0 + 1]);
    const float mu = wave_sum(v0 + v1) * (1.0f / 128.0f);
    const float d0 = v0 - mu, d1 = v1 - mu;
    const float var = wave_sum(d0 * d0 + d1 * d1) * (1.0f / 128.0f);
    const float r = 1.0f / sqrtf(var + LN_EPS);
    vg[(size_t)row * WA + c0] = d0 * r * ln_g[c0] + ln_b[c0];
    vg[(size_t)row * WA + c0 + 1] = d1 * r * ln_g[c0 + 1] + ln_b[c0 + 1];
}
__global__ void k_gate(const float* u, const float* mixed, const float* b_s, float* ycat, int rows) {
    const size_t i = (size_t)blockIdx.x * blockDim.x + threadIdx.x;
    if (i >= (size_t)rows * WA) return;
    const int r = (int)(i / WA), c = (int)(i % WA), g = c >> 7;
    ycat[(size_t)r * D + c] = u[i] * (mixed[i] + b_s[g * CHUNK + (r % CHUNK)]);
}
__global__ void k_shortconv(const float* z, const float* w, float* ycat, int rows) {
    const size_t i = (size_t)blockIdx.x * blockDim.x + threadIdx.x;
    if (i >= (size_t)rows * WB) return;
    const int r = (int)(i / WB), c = (int)(i % WB);
    float acc = 0.f;
#pragma unroll
    for (int k = 0; k < 3; ++k) {
        const int tt = r - 2 + k;
        if (tt >= 0) { const float* zr = z + (size_t)tt * IN_EVEN + 2 * WA; acc += w[k * WB + c] * (zr[WB + c] * zr[2 * WB + c]); }
    }
    ycat[(size_t)r * D + WA + c] = z[(size_t)r * IN_EVEN + 2 * WA + c] * acc;
}
__global__ void k_pool(const float* z, float* pooled, int rows) {
    const size_t i = (size_t)blockIdx.x * blockDim.x + threadIdx.x;
    if (i >= (size_t)rows * WC) return;
    const int r = (int)(i / WC), c = (int)(i % WC), win = 2 << (c >> 7);
    const int cnt = (r + 1 < win) ? (r + 1) : win;
    float s = 0.f;
    for (int k = 0; k < cnt; ++k) s += z[(size_t)(r - k) * IN_ODD + c];
    pooled[i] = s / (float)cnt - z[(size_t)r * IN_ODD + c];
}
__global__ void k_colscale_to(const float* src, const float* sc, float* ycat, int rows) {
    const size_t i = (size_t)blockIdx.x * blockDim.x + threadIdx.x;
    if (i >= (size_t)rows * WC) return;
    const int r = (int)(i / WC), c = (int)(i % WC);
    ycat[(size_t)r * D + c] = src[i] * sc[c];
}
__global__ void k_glu(const float* z, float* s, int rows) {
    const size_t i = (size_t)blockIdx.x * blockDim.x + threadIdx.x;
    if (i >= (size_t)rows * WD) return;
    const int r = (int)(i / WD), c = (int)(i % WD);
    s[i] = z[(size_t)r * IN_ODD + WC + c] * sigmoidf_(z[(size_t)r * IN_ODD + WC + WD + c]);
}
__global__ __launch_bounds__(512) void k_conv_ln_silu(const float* s, const float* cw, const float* cb, const float* ln_g, const float* ln_b, float* ycat, int rows) {
    __shared__ float red[8];
    __shared__ float red2[8];
    const int r = blockIdx.x, c = threadIdx.x;
    float acc = cb[c];
    for (int k = 0; k < 31; ++k) { const int tt = r - 30 + k; if (tt >= 0) acc += cw[k * WD + c] * s[(size_t)tt * WD + c]; }
    float ws = wave_sum(acc);
    if ((c & 63) == 0) red[c >> 6] = ws;
    __syncthreads();
    float mu = 0.f;
#pragma unroll
    for (int i = 0; i < 8; ++i) mu += red[i];
    mu *= (1.0f / 512.0f);
    const float d = acc - mu;
    float wq = wave_sum(d * d);
    if ((c & 63) == 0) red2[c >> 6] = wq;
    __syncthreads();
    float var = 0.f;
#pragma unroll
    for (int i = 0; i < 8; ++i) var += red2[i];
    var *= (1.0f / 512.0f);
    const float y = d * (1.0f / sqrtf(var + LN_EPS)) * ln_g[c] + ln_b[c];
    ycat[(size_t)r * D + WC + c] = siluf_(y);
}
__global__ void k_ple(float* h, const float* gz, const float* pu, size_t n) {
    const size_t i = (size_t)blockIdx.x * blockDim.x + threadIdx.x;
    if (i < n) h[i] += sigmoidf_(gz[i]) * pu[i];
}


static unsigned short* g_snap = nullptr; static int g_snap_i = 0;
__global__ void k_snap(const float* h, unsigned short* o, size_t n) { const size_t i = (size_t)blockIdx.x * blockDim.x + threadIdx.x; if (i < n) { unsigned u = __float_as_uint(h[i]); u += 0x7fffu + ((u >> 16) & 1u); o[i] = (unsigned short)(u >> 16); } }
static void snap_hook(hipStream_t st, const float* h, int S) { if (!g_snap) return; const size_t n = (size_t)S * 1024; hipLaunchKernelGGL(k_snap, dim3((unsigned)((n + 255) / 256)), dim3(256), 0, st, h, g_snap + (size_t)g_snap_i * n, n); ++g_snap_i; }
struct In {
    const float *x, *p, *ffn1_norm, *ffn1_w_gu, *ffn1_w_down, *mix_norm, *ffn2_norm, *ffn2_w_gu, *ffn2_w_down, *ple_norm, *ple_w_gate, *ple_w_up,
        *ab_w_in, *gm_ln_g, *gm_ln_b, *gm_w_s, *gm_b_s, *sc_w, *ab_w_out, *cd_w_in, *pool_w, *pool_scale, *cv_w, *cv_b, *cv_ln_g, *cv_ln_b, *cd_w_out, *final_norm;
};

static void gemm(hipStream_t st, const float* A, const float* B, float* C, int M, int N, int K, int lda, int ldb, int ldc,
                 int nb1 = 1, long sA1 = 0, long sB1 = 0, long sC1 = 0, int nb2 = 1, long sA2 = 0, long sB2 = 0, long sC2 = 0, int tril = 0) {
    GemmP p{A, B, C, M, N, K, lda, ldb, ldc, sA1, sB1, sC1, sA2, sB2, sC2, nb2, tril};
    hipLaunchKernelGGL(k_gemm, dim3(N / 64, M / 64, nb1 * nb2), dim3(256), 0, st, p);
}
static inline unsigned nblk(size_t n, int b) { return (unsigned)((n + b - 1) / b); }

static void forward_slab(hipStream_t st, const In& in, const float* p_slab0, const float* p_slab1, float* h, float* out, float* tmp, int S) {
    float* xn = tmp;
    float* z = xn + (size_t)S * D;
    float* t = z + (size_t)S * 2 * FF;
    float* y = t + (size_t)S * FF;
    float* ycat = y + (size_t)S * D;
    float* gz = ycat + (size_t)S * D;
    float* b0 = gz + (size_t)S * D;
    float* b1 = b0 + (size_t)S * 512; float* b2 = b1 + (size_t)S * 512; float* b3 = b2 + (size_t)S * 512;
    const size_t nh = (size_t)S * D;
    for (int i = 0; i < 2; ++i) {
        hipLaunchKernelGGL(k_rmsnorm, dim3(S / 4), dim3(256), 0, st, h, in.ffn1_norm + i * D, xn, S);
        gemm(st, xn, in.ffn1_w_gu + (size_t)i * D * 2 * FF, z, S, 2 * FF, D, D, 2 * FF, 2 * FF);
        hipLaunchKernelGGL(k_swiglu, dim3(nblk((size_t)S * FF, 256)), dim3(256), 0, st, z, t, S);
        gemm(st, t, in.ffn1_w_down + (size_t)i * FF * D, y, S, D, FF, FF, D, D);
        hipLaunchKernelGGL(k_add_scaled, dim3(nblk(nh, 256)), dim3(256), 0, st, h, y, 0.5f, nh);
        snap_hook(st, h, S);
        hipLaunchKernelGGL(k_rmsnorm, dim3(S / 4), dim3(256), 0, st, h, in.mix_norm + i * D, xn, S);
        if (i == 0) {
            gemm(st, xn, in.ab_w_in, z, S, IN_EVEN, D, D, IN_EVEN, IN_EVEN);
            float *u = b0, *vg = b1, *mixed = b2;
            hipLaunchKernelGGL(k_gelu_ln, dim3(S), dim3(256), 0, st, z, in.gm_ln_g, in.gm_ln_b, u, vg, S);
            gemm(st, in.gm_w_s, vg, mixed, CHUNK, 128, CHUNK, CHUNK, WA, WA, S / CHUNK, 0, (long)CHUNK * WA, (long)CHUNK * WA, 4, (long)CHUNK * CHUNK, 128, 128, 1);
            hipLaunchKernelGGL(k_gate, dim3(nblk((size_t)S * WA, 256)), dim3(256), 0, st, u, mixed, in.gm_b_s, ycat, S);
            hipLaunchKernelGGL(k_shortconv, dim3(nblk((size_t)S * WB, 256)), dim3(256), 0, st, z, in.sc_w, ycat, S);
            gemm(st, ycat, in.ab_w_out, y, S, D, D, D, D, D);
        } else {
            gemm(st, xn, in.cd_w_in, z, S, IN_ODD, D, D, IN_ODD, IN_ODD);
            float *pooled = b0, *ycr = b1, *sg = b2;
            hipLaunchKernelGGL(k_pool, dim3(nblk((size_t)S * WC, 256)), dim3(256), 0, st, z, pooled, S);
            gemm(st, pooled, in.pool_w, ycr, S, 128, 128, WC, 128, WC, 4, 128, 128L * 128, 128);
            hipLaunchKernelGGL(k_colscale_to, dim3(nblk((size_t)S * WC, 256)), dim3(256), 0, st, ycr, in.pool_scale, ycat, S);
            hipLaunchKernelGGL(k_glu, dim3(nblk((size_t)S * WD, 256)), dim3(256), 0, st, z, sg, S);
            hipLaunchKernelGGL(k_conv_ln_silu, dim3(S), dim3(512), 0, st, sg, in.cv_w, in.cv_b, in.cv_ln_g, in.cv_ln_b, ycat, S);
            gemm(st, ycat, in.cd_w_out, y, S, D, D, D, D, D);
        }
        hipLaunchKernelGGL(k_add_scaled, dim3(nblk(nh, 256)), dim3(256), 0, st, h, y, 1.0f, nh);
        snap_hook(st, h, S);
        hipLaunchKernelGGL(k_rmsnorm, dim3(S / 4), dim3(256), 0, st, h, in.ffn2_norm + i * D, xn, S);
        gemm(st, xn, in.ffn2_w_gu + (size_t)i * D * 2 * FF, z, S, 2 * FF, D, D, 2 * FF, 2 * FF);
        hipLaunchKernelGGL(k_swiglu, dim3(nblk((size_t)S * FF, 256)), dim3(256), 0, st, z, t, S);
        gemm(st, t, in.ffn2_w_down + (size_t)i * FF * D, y, S, D, FF, FF, D, D);
        hipLaunchKernelGGL(k_add_scaled, dim3(nblk(nh, 256)), dim3(256), 0, st, h, y, 0.5f, nh);
        snap_hook(st, h, S);
        hipLaunchKernelGGL(k_rmsnorm, dim3(S / 4), dim3(256), 0, st, h, in.ple_norm + i * D, xn, S);
        gemm(st, xn, in.ple_w_gate + (size_t)i * D * D, gz, S, D, D, D, D, D);
        gemm(st, i == 0 ? p_slab0 : p_slab1, in.ple_w_up + (size_t)i * PLE * D, y, S, D, PLE, PLE, D, D);
        hipLaunchKernelGGL(k_ple, dim3(nblk(nh, 256)), dim3(256), 0, st, h, gz, y, nh);
        snap_hook(st, h, S);
    }
    hipLaunchKernelGGL(k_rmsnorm, dim3(S / 4), dim3(256), 0, st, h, in.final_norm, out, S);
}
}
#endif

#if DBG
__global__ void k_dbg_report(const float* res, float* out) {
    if (threadIdx.x != 0 || blockIdx.x != 0) return;
    for (int cp = 0; cp < 8; ++cp) { const float e2 = res[2 * cp], r2 = res[2 * cp + 1]; const float rel = sqrtf(e2 / fmaxf(r2, 1e-30f));
        if (!(rel < DBG_THR)) { int d = (int)(rel * 10.0f); if (d > 9 || !(rel == rel)) d = 9; if (d < 0) d = 0; out[0] = 1000.0f * (float)(cp + 1) + 100.0f * (float)d; return; } }
}
#endif

extern "C" void kernel_launch(void* const* d_in, const int* in_sizes, int n_in, void* d_out, int out_size, void* d_ws, size_t ws_size, hipStream_t stream) {
    using namespace mk;
    static int grid = 0;
    if (grid == 0) {
        const size_t need = DBG ? WS_SNAP + (size_t)8 * DBG_NT * D * 2 : WS_END;
        if (n_in != 28 || in_sizes[0] != M * D || out_size != M * D || ws_size < need) { fprintf(stderr, "kernel_launch: unexpected problem (n_in %d, in0 %d, out %d, ws %zu < %zu); nothing launched\n", n_in, n_in > 0 ? in_sizes[0] : -1, out_size, ws_size, need); grid = -1; return; }
        int dev = 0, cus = 0, per_cu = 0;
        if (hipGetDevice(&dev) != hipSuccess || hipDeviceGetAttribute(&cus, hipDeviceAttributeMultiprocessorCount, dev) != hipSuccess) { grid = -1; return; }
        if (hipFuncSetAttribute((const void*)mk_fwd, hipFuncAttributeMaxDynamicSharedMemorySize, LDS_BYTES) != hipSuccess) { fprintf(stderr, "kernel_launch: hipFuncSetAttribute failed\n"); grid = -1; return; }
        if (hipOccupancyMaxActiveBlocksPerMultiprocessor(&per_cu, (const void*)mk_fwd, NTHREADS, LDS_BYTES) != hipSuccess || per_cu < 1) { fprintf(stderr, "kernel_launch: occupancy query failed (%d)\n", per_cu); (void)hipGetLastError(); grid = -1; return; }
        grid = cus * 1;
        fprintf(stderr, "kernel_launch: grid %d (cus %d, occupancy %d/CU), ws %zu\n", grid, cus, per_cu, ws_size);
    }
    if (grid < 0) return;
    (void)hipMemsetAsync((char*)d_ws + WS_CTL, 0, CTL_BYTES, stream);
    Args a{};
    for (int i = 0; i < 28; ++i) a.in[i] = (const float*)d_in[i];
    a.out = (float*)d_out; a.ws = (unsigned char*)d_ws; a.dbg = DBG; a.pad = 0;
#if DBG
    {
        v0::In in; const float** f = (const float**)&in; for (int i = 0; i < 28; ++i) f[i] = (const float*)d_in[i];
        float* href = (float*)((char*)d_ws + WS_Y); float* tmp = (float*)((char*)d_ws + WS_T);
        (void)hipMemcpyAsync(href, in.x, (size_t)DBG_NT * D * sizeof(float), hipMemcpyDeviceToDevice, stream);
        v0::g_snap = (unsigned short*)((char*)d_ws + WS_SNAP); v0::g_snap_i = 0;
        v0::forward_slab(stream, in, in.p, in.p + (size_t)v0::BATCH * v0::SEQ * v0::PLE, href, href, tmp, DBG_NT);
    }
#endif
    void* args[] = {&a};
    const hipError_t e = hipLaunchCooperativeKernel((const void*)mk_fwd, dim3(grid), dim3(NTHREADS), args, LDS_BYTES, stream);
    if (e != hipSuccess) fprintf(stderr, "kernel_launch: cooperative launch failed: %s (grid %d)\n", hipGetErrorString(e), grid);
#if DBG
    hipLaunchKernelGGL(k_dbg_report, dim3(1), dim3(64), 0, stream, (const float*)((char*)d_ws + WS_DBG), (float*)d_out);
#endif
}
```
